# Optimizing an MI355X kernel written in HIP

```python
import math
import jax, jax.numpy as jnp
from jax import lax
import numpy as np

D_MODEL = 1024
BATCH = 4
SEQ = 4096
DEPTH = 2

CHUNK = 64
PLE_DIM = 256
RMS_EPS = 1e-6

LRU_WIDTH = D_MODEL // 2
LRU_BLOCKS = 8
LRU_BLOCK = LRU_WIDTH // LRU_BLOCKS
CONV_WIDTH = 4
LRU_C = 8.0

ATT_HEADS = 8
ATT_HEAD_DIM = 64
ATT_WIDTH = ATT_HEADS * ATT_HEAD_DIM
IDX_HEADS = 8
IDX_DIM = 64
MAX_TOP_K = 256
Q_BLOCK = 128

N_BUCKETS = 32
MAX_DISTANCE = 128

EV_SPLIT = (LRU_WIDTH, LRU_WIDTH, ATT_WIDTH, ATT_WIDTH, ATT_WIDTH, IDX_HEADS * IDX_DIM, IDX_DIM, IDX_HEADS)
EV_IN = LRU_WIDTH * 2 + ATT_WIDTH * 3 + IDX_HEADS * IDX_DIM + IDX_DIM + IDX_HEADS
EV_OUT = LRU_WIDTH + ATT_WIDTH

RET_HEADS = 8
RET_QK_DIM = D_MODEL // RET_HEADS
RET_V_DIM = 2 * D_MODEL // RET_HEADS
RET_QK_WIDTH = RET_HEADS * RET_QK_DIM
RET_V_WIDTH = RET_HEADS * RET_V_DIM
OD_SPLIT = (RET_QK_WIDTH, RET_QK_WIDTH, RET_V_WIDTH, RET_V_WIDTH)
OD_IN = 2 * RET_QK_WIDTH + 2 * RET_V_WIDTH
ROPE_BASE = 10000.0
GN_EPS = 1e-5

N_GROUPS = 4
EXPERTS_PER_GROUP = 8
N_EXPERTS = N_GROUPS * EXPERTS_PER_GROUP
TOP_K_EXPERTS = 2
EXPERT_FF = D_MODEL // 2

kernel_name = "hybrid_rglru_dsa_retention_hmoe"


def rms_norm(x, g):
    xf = x.astype(jnp.float32)
    y = xf * lax.rsqrt(jnp.mean(xf * xf, axis=-1, keepdims=True) + RMS_EPS)
    return (y * g.astype(jnp.float32)).astype(x.dtype)


def _split(z, sizes):
    offs = []
    acc = 0
    for s in sizes[:-1]:
        acc += s
        offs.append(acc)
    return jnp.split(z, offs, axis=-1)


def t5_bucket(rel):
    half = N_BUCKETS // 2
    max_exact = half // 2
    ret = (rel > 0).astype(jnp.int32) * half
    n = jnp.abs(rel)
    nf = jnp.maximum(n, 1).astype(jnp.float32)
    large = max_exact + (jnp.log(nf / max_exact) / math.log(MAX_DISTANCE / max_exact) * (half - max_exact)).astype(jnp.int32)
    large = jnp.minimum(large, half - 1)
    return ret + jnp.where(n < max_exact, n, large)


def causal_depthwise_conv(x, w, b):
    c = x.shape[-1]
    y = lax.conv_general_dilated(x, w[:, None, :].astype(x.dtype), window_strides=(1,), padding=[(CONV_WIDTH - 1, 0)], dimension_numbers=("NWC", "WIO", "NWC"), feature_group_count=c)
    return y + b.astype(x.dtype)


def rglru_mixer(xa, ga, conv_w, conv_b, wa, ba, wx, bx, lam):
    b_, s_, _ = xa.shape
    xc = causal_depthwise_conv(xa, conv_w, conv_b)
    xb = xc.reshape(b_, s_, LRU_BLOCKS, LRU_BLOCK)
    r = jax.nn.sigmoid((jnp.einsum("bshi,hij->bshj", xb, wa).reshape(b_, s_, LRU_WIDTH) + ba).astype(jnp.float32))
    gi = jax.nn.sigmoid((jnp.einsum("bshi,hij->bshj", xb, wx).reshape(b_, s_, LRU_WIDTH) + bx).astype(jnp.float32))
    log_a = -LRU_C * r * jax.nn.softplus(-lam.astype(jnp.float32))
    a = jnp.exp(log_a)
    u = jnp.sqrt(-jnp.expm1(2.0 * log_a)) * (gi * xc.astype(jnp.float32))

    def combine(left, right):
        a1, b1 = left
        a2, b2 = right
        return a1 * a2, a2 * b1 + b2

    _, hseq = lax.associative_scan(combine, (a, u), axis=1)
    y = hseq * jax.nn.gelu(ga.astype(jnp.float32))
    return y.astype(xa.dtype)


def dsa_mixer(q, k, v, iq, ik, iw, q_g, k_g, rel_bias):
    b_, s_ = q.shape[:2]
    top_k = min(MAX_TOP_K, s_ // 4)
    nb = s_ // Q_BLOCK
    q = rms_norm(q, q_g)
    k = rms_norm(k, k_g)
    iw = iw * (IDX_HEADS ** -0.5) * (IDX_DIM ** -0.5)
    key_chunk = jnp.arange(s_, dtype=jnp.int32) // CHUNK
    scale = ATT_HEAD_DIM ** -0.5

    def to_blocks(t):
        return jnp.moveaxis(t.reshape(b_, nb, Q_BLOCK, *t.shape[2:]), 1, 0)

    def block_fn(args):
        blk, qb, iqb, iwb = args
        qpos = blk * Q_BLOCK + jnp.arange(Q_BLOCK, dtype=jnp.int32)
        qchunk = qpos // CHUNK
        admissible = key_chunk[None, :] <= qchunk[:, None]
        dots = jnp.einsum("bqhd,bsd->bqsh", iqb, ik)
        score = jnp.einsum("bqsh,bqh->bqs", jax.nn.relu(dots).astype(jnp.float32), iwb.astype(jnp.float32))
        score = jnp.where(admissible[None], score, -jnp.inf)
        _, idx = lax.top_k(score, top_k)
        kg = jax.vmap(lambda kk, ii: kk[ii])(k, idx)
        vg = jax.vmap(lambda vv, ii: vv[ii])(v, idx)
        valid = (idx // CHUNK) <= qchunk[None, :, None]
        bias = rel_bias[t5_bucket(idx - qpos[None, :, None])]
        logits = jnp.einsum("bqhd,bqkhd->bqhk", qb, kg).astype(jnp.float32) * scale + jnp.moveaxis(bias, -1, 2).astype(jnp.float32)
        logits = jnp.where(valid[:, :, None, :], logits, -jnp.inf)
        probs = jax.nn.softmax(logits, axis=-1).astype(v.dtype)
        return jnp.einsum("bqhk,bqkhd->bqhd", probs, vg)

    out = lax.map(block_fn, (jnp.arange(nb, dtype=jnp.int32), to_blocks(q), to_blocks(iq), to_blocks(iw)))
    return jnp.moveaxis(out, 0, 1).reshape(b_, s_, ATT_WIDTH)


def apply_rotary(x):
    s_, d = x.shape[1], x.shape[-1]
    half = d // 2
    inv = ROPE_BASE ** (-jnp.arange(half, dtype=jnp.float32) / half)
    ang = jnp.arange(s_, dtype=jnp.float32)[:, None] * inv[None, :]
    cos = jnp.cos(ang)[None, :, None, :]
    sin = jnp.sin(ang)[None, :, None, :]
    x1, x2 = x[..., :half], x[..., half:]
    return jnp.concatenate([x1 * cos - x2 * sin, x2 * cos + x1 * sin], axis=-1)


def retention_mixer(q, k, v, g, gn_g):
    b_, s_, h_, dk = q.shape
    dv = v.shape[-1]
    nc = s_ // CHUNK
    qf = apply_rotary(q.astype(jnp.float32))
    kf = apply_rotary(k.astype(jnp.float32)) * (dk ** -0.5)
    vf = v.astype(jnp.float32)
    log_g = jnp.log(1.0 - 2.0 ** (-5.0 - jnp.arange(h_, dtype=jnp.float32)))
    pos = jnp.arange(CHUNK, dtype=jnp.float32)
    diff = pos[:, None] - pos[None, :]
    causal = diff >= 0
    decay_intra = jnp.where(causal[None], jnp.exp(jnp.where(causal, diff, 0.0)[None] * log_g[:, None, None]), 0.0)
    q_decay = jnp.exp((pos + 1.0)[:, None] * log_g[None, :])
    k_decay = jnp.exp((CHUNK - 1.0 - pos)[:, None] * log_g[None, :])
    chunk_decay = jnp.exp(CHUNK * log_g)

    def chunks(t):
        return jnp.moveaxis(t.reshape(b_, nc, CHUNK, *t.shape[2:]), 1, 0)

    def step(state, inp):
        qc, kc, vc = inp
        inner = jnp.einsum("bihd,bjhd->bhij", qc, kc) * decay_intra[None]
        o_inner = jnp.einsum("bhij,bjhe->bihe", inner, vc)
        o_cross = jnp.einsum("bihd,bhde->bihe", qc * q_decay[None, :, :, None], state)
        new_state = state * chunk_decay[None, :, None, None] + jnp.einsum("bjhd,bjhe->bhde", kc * k_decay[None, :, :, None], vc)
        return new_state, o_inner + o_cross

    state0 = jnp.zeros((b_, h_, dk, dv), jnp.float32)
    _, o = lax.scan(step, state0, (chunks(qf), chunks(kf), chunks(vf)))
    o = jnp.moveaxis(o, 0, 1).reshape(b_, s_, h_, dv)
    mu = jnp.mean(o, axis=-1, keepdims=True)
    var = jnp.mean(jnp.square(o - mu), axis=-1, keepdims=True)
    o = ((o - mu) * lax.rsqrt(var + GN_EPS)).reshape(b_, s_, h_ * dv) * gn_g.astype(jnp.float32)
    y = jax.nn.silu(g.astype(jnp.float32)) * o
    return y.astype(g.dtype)


def hier_moe(x, w_group, w_expert, w_gate, w_up, w_down):
    b_, s_, d = x.shape
    n = b_ * s_
    xf = x.reshape(n, d)
    group_logits = (xf @ w_group).astype(jnp.float32)
    group_probs = jax.nn.softmax(group_logits, axis=-1)
    g_sel = jnp.argmax(group_logits, axis=-1)
    g_weight = jnp.take_along_axis(group_probs, g_sel[:, None], axis=1)
    expert_logits = (xf @ w_expert).astype(jnp.float32).reshape(n, N_GROUPS, EXPERTS_PER_GROUP)
    within = jnp.take_along_axis(expert_logits, g_sel[:, None, None], axis=1)[:, 0]
    top_vals, top_idx = lax.top_k(within, TOP_K_EXPERTS)
    top_w = jax.nn.softmax(top_vals, axis=-1) * g_weight
    expert_ids = g_sel[:, None] * EXPERTS_PER_GROUP + top_idx
    combine = jnp.einsum("nke,nk->ne", jax.nn.one_hot(expert_ids, N_EXPERTS, dtype=jnp.float32), top_w)
    out = jnp.zeros((n, d), jnp.float32)
    for e in range(N_EXPERTS):
        hid = jax.nn.silu(xf @ w_gate[e]) * (xf @ w_up[e])
        out = out + combine[:, e:e + 1] * (hid @ w_down[e]).astype(jnp.float32)
    return out.reshape(b_, s_, d).astype(x.dtype)


def setup_inputs(seed: int = 0) -> dict:
    key = jax.random.key(seed)
    ks = iter(jax.random.split(key, 40))
    ne = (DEPTH + 1) // 2
    no = DEPTH // 2
    f32 = jnp.float32

    def nrm(shape, fan_in):
        return jax.random.normal(next(ks), shape, f32) * (fan_in ** -0.5)

    def gain(shape):
        return 1.0 + 0.05 * jax.random.normal(next(ks), shape, f32)

    def small(shape, s=0.02):
        return s * jax.random.normal(next(ks), shape, f32)

    u = jax.random.uniform(next(ks), (ne, LRU_WIDTH), f32, 0.9, 0.999)
    a0 = u ** (1.0 / LRU_C)
    lam = jnp.log(a0) - jnp.log1p(-a0)
    return {
        "x": jax.random.normal(next(ks), (BATCH, SEQ, D_MODEL), f32),
        "p": jax.random.normal(next(ks), (DEPTH, BATCH, SEQ, PLE_DIM), f32),
        "rel_bias": small((N_BUCKETS, ATT_HEADS), 0.2),
        "mix_norm_g": gain((DEPTH, D_MODEL)),
        "ffn_norm_g": gain((DEPTH, D_MODEL)),
        "ple_norm_g": gain((DEPTH, D_MODEL)),
        "ev_w_in": nrm((ne, D_MODEL, EV_IN), D_MODEL),
        "ev_conv_w": nrm((ne, CONV_WIDTH, LRU_WIDTH), CONV_WIDTH),
        "ev_conv_b": small((ne, LRU_WIDTH)),
        "ev_lru_wa": nrm((ne, LRU_BLOCKS, LRU_BLOCK, LRU_BLOCK), LRU_BLOCK),
        "ev_lru_ba": small((ne, LRU_WIDTH)),
        "ev_lru_wx": nrm((ne, LRU_BLOCKS, LRU_BLOCK, LRU_BLOCK), LRU_BLOCK),
        "ev_lru_bx": small((ne, LRU_WIDTH)),
        "ev_lru_lambda": lam,
        "ev_q_norm_g": gain((ne, ATT_HEAD_DIM)),
        "ev_k_norm_g": gain((ne, ATT_HEAD_DIM)),
        "ev_w_out": nrm((ne, EV_OUT, D_MODEL), EV_OUT),
        "od_w_in": nrm((no, D_MODEL, OD_IN), D_MODEL),
        "od_gn_g": gain((no, RET_V_WIDTH)),
        "od_w_out": nrm((no, RET_V_WIDTH, D_MODEL), RET_V_WIDTH),
        "moe_w_group": nrm((DEPTH, D_MODEL, N_GROUPS), D_MODEL),
        "moe_w_expert": nrm((DEPTH, D_MODEL, N_EXPERTS), D_MODEL),
        "moe_w_gate": nrm((DEPTH, N_EXPERTS, D_MODEL, EXPERT_FF), D_MODEL),
        "moe_w_up": nrm((DEPTH, N_EXPERTS, D_MODEL, EXPERT_FF), D_MODEL),
        "moe_w_down": nrm((DEPTH, N_EXPERTS, EXPERT_FF, D_MODEL), EXPERT_FF),
        "ple_w_up": nrm((DEPTH, PLE_DIM, D_MODEL), PLE_DIM),
        "ple_w_gate": nrm((DEPTH, D_MODEL, D_MODEL), D_MODEL),
    }


def reference(x, p, rel_bias, mix_norm_g, ffn_norm_g, ple_norm_g, ev_w_in, ev_conv_w, ev_conv_b, ev_lru_wa, ev_lru_ba, ev_lru_wx, ev_lru_bx, ev_lru_lambda, ev_q_norm_g, ev_k_norm_g, ev_w_out, od_w_in, od_gn_g, od_w_out, moe_w_group, moe_w_expert, moe_w_gate, moe_w_up, moe_w_down, ple_w_up, ple_w_gate):
    b_, s_, _ = x.shape
    h = x
    for i in range(DEPTH):
        j = i // 2
        hn = rms_norm(h, mix_norm_g[i])
        if i % 2 == 0:
            z = hn @ ev_w_in[j]
            xa, ga, q, k, v, iq, ik, iw = _split(z, EV_SPLIT)
            ya = rglru_mixer(xa, ga, ev_conv_w[j], ev_conv_b[j], ev_lru_wa[j], ev_lru_ba[j], ev_lru_wx[j], ev_lru_bx[j], ev_lru_lambda[j])
            yb = dsa_mixer(q.reshape(b_, s_, ATT_HEADS, ATT_HEAD_DIM), k.reshape(b_, s_, ATT_HEADS, ATT_HEAD_DIM), v.reshape(b_, s_, ATT_HEADS, ATT_HEAD_DIM), iq.reshape(b_, s_, IDX_HEADS, IDX_DIM), ik, iw, ev_q_norm_g[j], ev_k_norm_g[j], rel_bias)
            mix = jnp.concatenate([ya, yb], axis=-1) @ ev_w_out[j]
        else:
            z = hn @ od_w_in[j]
            q, k, v, g = _split(z, OD_SPLIT)
            yc = retention_mixer(q.reshape(b_, s_, RET_HEADS, RET_QK_DIM), k.reshape(b_, s_, RET_HEADS, RET_QK_DIM), v.reshape(b_, s_, RET_HEADS, RET_V_DIM), g, od_gn_g[j])
            mix = yc @ od_w_out[j]
        h = h + mix
        h = h + hier_moe(rms_norm(h, ffn_norm_g[i]), moe_w_group[i], moe_w_expert[i], moe_w_gate[i], moe_w_up[i], moe_w_down[i])
        e = rms_norm(p[i] @ ple_w_up[i], ple_norm_g[i])
        h = h + e * jax.nn.sigmoid(h @ ple_w_gate[i])
    return h
```

```cpp
#include <hip/hip_runtime.h>
#include <cstdio>
#include <cstdint>

#define GAS __attribute__((address_space(1)))
#define LAS __attribute__((address_space(3)))
#ifndef MK_N_LAUNCHES
#define MK_N_LAUNCHES 1
#endif

constexpr int D = 1024, BATCH = 4, SEQ = 4096, M = BATCH * SEQ, PLE = 256;
constexpr int EV_IN = 3144, EV_INP = 3328;
constexpr int OD_IN = 6144;
constexpr int ZC_XA = 0, ZC_GA = 512, ZC_Q = 1024, ZC_K = 1536, ZC_V = 2048, ZC_IQ = 2560, ZC_IK = 3072, ZC_IW = 3136;
constexpr int NEXP = 32, FF = 512;
constexpr int MOE_ROWS = 40960, MOE_TILES = 160;
constexpr float RMS_EPS = 1e-6f, GN_EPS = 1e-5f;
constexpr float LOG2E = 1.4426950408889634f;

constexpr size_t MiB = 1u << 20;
constexpr size_t WS_CTL = 0, CTL_ZERO_BYTES = 1 * MiB;
constexpr size_t WS_RT = 1 * MiB;
constexpr size_t WS_ROPE = 2 * MiB;
constexpr size_t WS_W_EVIN = 4 * MiB;
constexpr size_t WS_W_EVOUT = 11 * MiB;
constexpr size_t WS_W_ODIN = 13 * MiB;
constexpr size_t WS_W_ODOUT = 25 * MiB;
constexpr size_t WS_W_PLEUP = 29 * MiB;
constexpr size_t WS_W_PLEGATE = 30 * MiB;
constexpr size_t WS_W_GU = 34 * MiB;
constexpr size_t WS_W_DN = 98 * MiB;
constexpr size_t WS_XN = 130 * MiB;
constexpr size_t WS_PB = 162 * MiB;
constexpr size_t WS_ERAW = 178 * MiB;
constexpr size_t WS_MISC = 210 * MiB;
constexpr size_t WS_MASK = 214 * MiB;
constexpr size_t WS_Y = 222 * MiB;
constexpr size_t WS_Z = 286 * MiB;
constexpr size_t WS_XS = WS_Z, WS_YD = WS_Z + 80 * MiB;
constexpr size_t WS_HLOC = WS_Z + 104 * MiB, WS_PCUM = WS_HLOC + 32 * MiB;
constexpr size_t WS_END = 478 * MiB;
constexpr size_t MS_ESS = WS_MISC, MS_ERSTD = WS_MISC + 1 * MiB, MS_RE = MS_ERSTD + 65536, MS_RW = MS_RE + 65536, MS_SLOT = MS_RW + 131072, MS_CNT = MS_SLOT + 131072,
                 MS_TILEE = MS_CNT + 32768, MS_SUMA = MS_TILEE + 4096, MS_SUMH = MS_SUMA + 524288;
static_assert(MS_SUMH + 524288 <= WS_MASK, "misc map");
constexpr int CW_BAR = 4096;

constexpr int LDS_BYTES = 147456;
constexpr int LDS_MISC_OFF = 144 * 1024 - 256;

typedef unsigned short bf16_t;
typedef short bf16x8 __attribute__((ext_vector_type(8)));
typedef short s16x4 __attribute__((ext_vector_type(4)));
typedef float f32x4 __attribute__((ext_vector_type(4)));
typedef float f32x2 __attribute__((ext_vector_type(2)));
typedef unsigned u32x4 __attribute__((ext_vector_type(4)));
typedef unsigned u32x2 __attribute__((ext_vector_type(2)));
typedef LAS unsigned char* ldsp;
namespace pg8 {
#define PG8_LAS __attribute__((address_space(3)))
typedef unsigned short bf16_t;
typedef short bf16x8 __attribute__((ext_vector_type(8)));
typedef float f32x4 __attribute__((ext_vector_type(4)));
typedef unsigned u32x4 __attribute__((ext_vector_type(4)));
constexpr int BM = 256, BK = 64, HALF = 128, HTB = HALF * BK * 2  , STAGE_BYTES = 8 * HTB, NXCD = 8, WGM = 8;

__host__ __device__ __forceinline__ int lds_byte(int r, int c) { const int st = (r >> 4) * 2 + (c >> 5), rr = r & 15, cc = c & 31, ob = rr * 64 + cc * 2; return st * 1024 + (ob ^ (((ob >> 9) & 1) << 5)); }
__host__ __device__ __forceinline__ void stage_rc(int b, int& R, int& C) { const int st = b / 1024, sb = b % 1024, swz = sb ^ (((sb >> 9) & 1) << 5); R = (st >> 1) * 16 + swz / 64; C = (st & 1) * 32 + (swz % 64) / 2; }
__host__ __device__ __forceinline__ int perm32(int rho) { const int n = rho >> 4, i = rho & 15; return 8 * (i >> 2) + 4 * n + (i & 3); }

struct Unit { int pm, pn; };
struct Gemm { const bf16_t* A; const bf16_t* Bt; int M, N, K; };

struct StaticOrder {
    int nM, nN, nwg, G, c;
    __host__ __device__ void init(int M, int N, int G_, int c_) { nM = M / BM; nN = N / BM; nwg = nM * nN; G = G_; c = c_; }
    __host__ __device__ bool next(int i, Unit& u) const {
        const long L = (long)i * G + c; if (L >= nwg) return false;
        int wgid = (int)L; { const int q = nwg / NXCD, r = nwg % NXCD, xcd = wgid % NXCD, off = wgid / NXCD; wgid = (xcd < r ? xcd * (q + 1) : r * (q + 1) + (xcd - r) * q) + off; }
        const int nig = WGM * nN, gid = wgid / nig, fm = gid * WGM, gsz = (nM - fm) < WGM ? (nM - fm) : WGM;
        u.pm = fm + ((wgid % nig) % gsz); u.pn = (wgid % nig) / gsz; return true;
    }
    __device__ __forceinline__ void a_ready(const Unit&) const {}
    __device__ __forceinline__ void done(const Unit&) const {}
};
__device__ __forceinline__ unsigned cvt_pk_bf16(float lo, float hi) { unsigned r; asm volatile("v_cvt_pk_bf16_f32 %0, %1, %2" : "=v"(r) : "v"(lo), "v"(hi)); return r; }
template <class Epi, class Sched, bool STAMP = false>
__device__ __forceinline__ void gemm_phase(PG8_LAS unsigned char* lds, const Gemm g, const Sched& S, const Epi& E, unsigned long long* stamps) {
    const int tid = threadIdx.x, wid = __builtin_amdgcn_readfirstlane(tid >> 6), lane = tid & 63, wr = wid >> 2, wc = wid & 3, fr = lane & 15, fq = lane >> 4;
    const int K = g.K, nt = K / BK;
    int ts_lo = 0, ts_hi = 0, nts = 0; const unsigned long long rt_entry = STAMP ? (unsigned long long)wall_clock64() : 0ull;
#define PG8_STAMP() do { if (STAMP && wid == 0 && nts < 64) { const unsigned long long _c = (unsigned long long)clock64(); \
        ts_lo = (lane == nts) ? (int)(unsigned)_c : ts_lo; ts_hi = (lane == nts) ? (int)(unsigned)(_c >> 32) : ts_hi; ++nts; } } while (0)
    PG8_STAMP();
    unsigned voffA[2], voffB[2];
#pragma unroll
    for (int i = 0; i < 2; ++i) { int R, C; stage_rc(tid * 16 + i * 8192, R, C); const int Rb = Epi::PERM ? ((R & ~31) + perm32(R & 31)) : R;
        voffA[i] = (unsigned)(R * K + C) * 2u; voffB[i] = (unsigned)(Rb * K + C) * 2u; }
    const size_t kstep = (size_t)(BK * 2);
    const size_t hstep = (size_t)HALF * K * 2;
    const size_t tstep = 2 * hstep;
    const unsigned ldsw = (unsigned)wid * 1024u;
    const int aoff = lds_byte(wr * 64 + fr, fq * 8), boff = lds_byte(wc * 32 + fr, fq * 8);
#define PG8_SA(b, h) (((b) * 2 + (h)) * HTB)
#define PG8_SB(b, h) ((4 + (b) * 2 + (h)) * HTB)
#define PG8_STAGE(bufoff, gbase, voff) do { _Pragma("unroll") for (int _i = 0; _i < 2; ++_i) \
        __builtin_amdgcn_global_load_lds((const unsigned*)((const char*)(gbase) + (voff)[_i]), (PG8_LAS unsigned*)(lds + (bufoff) + ldsw + _i * 8192), 16, 0, 0); } while (0)
#define PG8_LDA(dst, b, h) do { _Pragma("unroll") for (int m = 0; m < 4; ++m) _Pragma("unroll") for (int k = 0; k < 2; ++k) dst[m][k] = *(const PG8_LAS bf16x8*)(lds + PG8_SA(b, h) + aoff + m * 2048 + k * 1024); } while (0)
#define PG8_LDB(dst, b, h) do { _Pragma("unroll") for (int n = 0; n < 2; ++n) _Pragma("unroll") for (int k = 0; k < 2; ++k) dst[n][k] = *(const PG8_LAS bf16x8*)(lds + PG8_SB(b, h) + boff + n * 2048 + k * 1024); } while (0)
#define PG8_MMA(ai, bj, At, Bt) do { __builtin_amdgcn_s_setprio(1); _Pragma("unroll") for (int m = 0; m < 4; ++m) _Pragma("unroll") for (int n = 0; n < 2; ++n) _Pragma("unroll") for (int k = 0; k < 2; ++k) \
        acc[ai][bj][m][n] = __builtin_amdgcn_mfma_f32_16x16x32_bf16(Bt[n][k], At[m][k], acc[ai][bj][m][n], 0, 0, 0); __builtin_amdgcn_s_setprio(0); } while (0)
#define PG8_WAIT_V(n) asm volatile("s_waitcnt vmcnt(" #n ")" ::: "memory")
#define PG8_WAIT_L(n) asm volatile("s_waitcnt lgkmcnt(" #n ")" ::: "memory")
#define PG8_BAR __builtin_amdgcn_s_barrier()
#define PG8_SCHED __builtin_amdgcn_sched_barrier(0)
    Unit cur, nxt; int ui = 0;
    if (!S.next(0, cur)) return;
    f32x4 acc[2][2][4][2];
#pragma unroll
    for (int a = 0; a < 2; ++a)
#pragma unroll
        for (int b = 0; b < 2; ++b)
#pragma unroll
            for (int m = 0; m < 4; ++m)
#pragma unroll
                for (int n = 0; n < 2; ++n) acc[a][b][m][n] = (f32x4){0.f, 0.f, 0.f, 0.f};
    bf16x8 At[4][2], B0[2][2], B1[2][2];
    const char* cA = (const char*)g.A + (size_t)cur.pm * tstep; const char* cB = (const char*)g.Bt + (size_t)cur.pn * tstep;
    S.a_ready(cur);
    PG8_STAGE(PG8_SB(0, 0), cB, voffB); PG8_STAGE(PG8_SA(0, 0), cA, voffA); PG8_STAGE(PG8_SB(0, 1), cB + hstep, voffB); PG8_STAGE(PG8_SA(0, 1), cA + hstep, voffA);
    if (wr == 1) PG8_BAR;
    PG8_WAIT_V(4); PG8_BAR;
    PG8_STAGE(PG8_SB(1, 0), cB + kstep, voffB); PG8_STAGE(PG8_SA(1, 0), cA + kstep, voffA); PG8_STAGE(PG8_SB(1, 1), cB + hstep + kstep, voffB);
    PG8_WAIT_V(6); PG8_BAR;
    PG8_STAMP();
    for (;;) {
        const bool has_next = S.next(ui + 1, nxt);
        const char* nA = has_next ? (const char*)g.A + (size_t)nxt.pm * tstep : cA; const char* nB = has_next ? (const char*)g.Bt + (size_t)nxt.pn * tstep : cB;
        for (int t = 0; t < nt; t += 2) {
            const bool last = (t == nt - 2);
            const char* a1 = cA + (size_t)(t + 1) * kstep;
            const char* a2 = last ? nA : cA + (size_t)(t + 2) * kstep; const char* b2 = last ? nB : cB + (size_t)(t + 2) * kstep;
            const char* a3 = a2 + kstep; const char* b3 = b2 + kstep;
            if (last && has_next) S.a_ready(nxt);
            PG8_LDB(B0, 0, 0); PG8_SCHED; PG8_LDA(At, 0, 0); PG8_STAGE(PG8_SA(1, 1), a1 + hstep, voffA);
            PG8_WAIT_L(8); PG8_BAR; PG8_WAIT_L(0); PG8_MMA(0, 0, At, B0); PG8_BAR; PG8_SCHED;
            PG8_LDB(B1, 0, 1); PG8_STAGE(PG8_SB(0, 0), b2, voffB);
            PG8_BAR; PG8_WAIT_L(0); PG8_MMA(0, 1, At, B1); PG8_BAR;
            PG8_LDA(At, 0, 1); PG8_STAGE(PG8_SA(0, 0), a2, voffA);
            PG8_BAR; PG8_WAIT_L(0); PG8_MMA(1, 0, At, B0); PG8_BAR; PG8_SCHED;
            PG8_STAGE(PG8_SB(0, 1), b2 + hstep, voffB);
            PG8_WAIT_V(6); PG8_BAR; PG8_MMA(1, 1, At, B1); PG8_BAR;
            PG8_LDB(B0, 1, 0); PG8_SCHED; PG8_LDA(At, 1, 0); PG8_STAGE(PG8_SA(0, 1), a2 + hstep, voffA);
            PG8_WAIT_L(8); PG8_BAR; PG8_WAIT_L(0); PG8_MMA(0, 0, At, B0); PG8_BAR; PG8_SCHED;
            PG8_LDB(B1, 1, 1); PG8_STAGE(PG8_SB(1, 0), b3, voffB);
            PG8_BAR; PG8_WAIT_L(0); PG8_MMA(0, 1, At, B1); PG8_BAR;
            PG8_LDA(At, 1, 1); PG8_STAGE(PG8_SA(1, 0), a3, voffA);
            PG8_BAR; PG8_WAIT_L(0); PG8_MMA(1, 0, At, B0); PG8_BAR; PG8_SCHED;
            PG8_STAGE(PG8_SB(1, 1), b3 + hstep, voffB);
            PG8_WAIT_V(6); PG8_BAR; PG8_MMA(1, 1, At, B1); PG8_BAR;
        }
        PG8_STAMP();
        if constexpr (!Epi::AFTER_DRAIN) { E(acc, cur, wr, wc, fr, fq); S.done(cur); }
        PG8_STAMP();
        if (!has_next) break;
#pragma unroll
        for (int a = 0; a < 2; ++a)
#pragma unroll
            for (int b = 0; b < 2; ++b)
#pragma unroll
                for (int m = 0; m < 4; ++m)
#pragma unroll
                    for (int n = 0; n < 2; ++n) acc[a][b][m][n] = (f32x4){0.f, 0.f, 0.f, 0.f};
        cur = nxt; cA = nA; cB = nB; ++ui;
    }
    PG8_WAIT_V(0);
    if (wr == 0) PG8_BAR;
    PG8_BAR;
    if constexpr (Epi::AFTER_DRAIN) { E.fused(acc, cur, wr, wc, fr, fq, lds, wid, lane); S.done(cur); }
    PG8_STAMP();
    if (STAMP && wid == 0) { stamps[lane] = lane < nts ? (((unsigned long long)(unsigned)ts_hi << 32) | (unsigned)ts_lo) : 0ull;
        if (lane == 62) stamps[62] = rt_entry; if (lane == 63) stamps[63] = (unsigned long long)wall_clock64(); }
#undef PG8_STAMP
#undef PG8_SA
#undef PG8_SB
#undef PG8_STAGE
#undef PG8_LDA
#undef PG8_LDB
#undef PG8_MMA
#undef PG8_WAIT_V
#undef PG8_WAIT_L
#undef PG8_BAR
#undef PG8_SCHED
}
}
#define XB_TMO      128
#define XB_XCNT(j)  (256  + 64 * (j))
#define XB_XSUB(j)  (1280 + 64 * (j))
#define XB_XGEN(j)  (2304 + 64 * (j))
#define XB_TOP      3328
#define XB_TOPGEN   3392
#define XCD_BAR_WORDS 3456
#define XB_SPIN_CAP (1u << 18)
__device__ __forceinline__ unsigned xb_ld(unsigned* p)              { return __hip_atomic_load(p, __ATOMIC_RELAXED, __HIP_MEMORY_SCOPE_AGENT); }
__device__ __forceinline__ unsigned xb_add(unsigned* p, unsigned v) { return __hip_atomic_fetch_add(p, v, __ATOMIC_RELAXED, __HIP_MEMORY_SCOPE_AGENT); }
__device__ __forceinline__ unsigned xb_xcc_id() { return (unsigned)__builtin_amdgcn_s_getreg((3 << 11) | 20) & 0xFu; }
#define XB_SPIN(cond, bar) do { unsigned _sp = 0; while (cond) { __builtin_amdgcn_s_sleep(1); \
    if ((++_sp & 255u) == 0u) { if (xb_ld(&(bar)[XB_TMO])) break; if (_sp > XB_SPIN_CAP) { atomicAdd(&(bar)[XB_TMO], 1u); break; } } } } while (0)

struct XcdBarrier {
    unsigned* bar; unsigned x;
    volatile LAS unsigned* st;
};

__device__ __forceinline__ XcdBarrier xcd_barrier_post(unsigned* bar, volatile LAS unsigned* st) {
    XcdBarrier b; b.bar = bar; b.x = xb_xcc_id(); b.st = st;
    if (threadIdx.x == 0) (void)xb_add(&bar[XB_XCNT(b.x)], 1u);
    return b;
}
__device__ __forceinline__ void xcd_barrier_complete(unsigned* bar, unsigned x, unsigned& nloc, unsigned& nx) {
    const unsigned G = gridDim.x * gridDim.y * gridDim.z;
    unsigned sum, cnt, mine, sp = 0u;
    for (;;) {
        sum = 0u; cnt = 0u; mine = 0u;
#pragma unroll
        for (unsigned j = 0; j < 16; ++j) { const unsigned c = xb_ld(&bar[XB_XCNT(j)]); sum += c; cnt += (c > 0u) ? 1u : 0u; mine = (j == x) ? c : mine; }
        if (sum == G) break;
        __builtin_amdgcn_s_sleep(1);
        if ((++sp & 255u) == 0u) { if (xb_ld(&bar[XB_TMO])) break; if (sp > XB_SPIN_CAP) { atomicAdd(&bar[XB_TMO], 1u); break; } }
    }
    nloc = mine > 0u ? mine : 1u; nx = cnt > 0u ? cnt : 1u;
}

__device__ __forceinline__ void xcd_barrier(const XcdBarrier& b) {
    asm volatile("s_waitcnt vmcnt(0)" ::: "memory");
    __syncthreads();
    if (threadIdx.x == 0) {
        unsigned* bar = b.bar;
        __builtin_amdgcn_s_waitcnt(0);
        unsigned nloc = b.st[0], nx = b.st[1];
        if (nloc == 0u) { xcd_barrier_complete(bar, b.x, nloc, nx); b.st[0] = nloc; b.st[1] = nx; }
        const unsigned old = xb_add(&bar[XB_XSUB(b.x)], 1u);
        const unsigned gen = old / nloc;
        if (old + 1u == (gen + 1u) * nloc) {
            __builtin_amdgcn_fence(__ATOMIC_RELEASE, "agent");
            asm volatile("s_waitcnt vmcnt(0)" ::: "memory");
            const unsigned og = xb_add(&bar[XB_TOP], 1u);
            const unsigned tg = og / nx;
            if (og + 1u == (tg + 1u) * nx) xb_add(&bar[XB_TOPGEN], 1u);
            else XB_SPIN(xb_ld(&bar[XB_TOPGEN]) == tg, bar);
            __builtin_amdgcn_fence(__ATOMIC_ACQUIRE, "agent");
            xb_add(&bar[XB_XGEN(b.x)], 1u);
            asm volatile("s_waitcnt vmcnt(0)" ::: "memory");
        } else {
            XB_SPIN(xb_ld(&bar[XB_XGEN(b.x)]) == gen, bar);
            __builtin_amdgcn_fence(__ATOMIC_ACQUIRE, "agent");
            asm volatile("s_waitcnt vmcnt(0)" ::: "memory");
        }
    }
    __syncthreads();
}
typedef short v4i16_t __attribute__((ext_vector_type(4)));
__device__ __forceinline__ unsigned cvt_pk_bf16(float lo, float hi) { return pg8::cvt_pk_bf16(lo, hi); }
__device__ __forceinline__ float bf_lo(unsigned u) { return __uint_as_float(u << 16); }
__device__ __forceinline__ float bf_hi(unsigned u) { return __uint_as_float(u & 0xffff0000u); }
__device__ __forceinline__ float bf2f(bf16_t b) { return __uint_as_float(((unsigned)b) << 16); }
__device__ __forceinline__ float wave_sum(float v) {
#pragma unroll
    for (int o = 1; o < 64; o <<= 1) v += __shfl_xor(v, o);
    return v;
}
__device__ __forceinline__ float sigmoidf_(float x) { return 1.0f / (1.0f + __expf(-x)); }
__device__ __forceinline__ float siluf_(float x) { return x / (1.0f + __expf(-x)); }
__device__ __forceinline__ float gelu_tanh_(float x) { const float y = 0.7978845608028654f * (x + 0.044715f * x * x * x); const float t = 1.0f - 2.0f / (1.0f + __expf(2.0f * y)); return 0.5f * x * (1.0f + t); }
__device__ __forceinline__ s16x4 vtr(const LAS bf16_t* p) { return __builtin_bit_cast(s16x4, __builtin_amdgcn_ds_read_tr16_b64_v4i16((LAS v4i16_t*)p)); }
__device__ __forceinline__ bf16x8 frag_tr(const LAS bf16_t* tile, int pitch, int k0, int n0, int lane) {
    const int i16 = lane & 15, g = lane >> 4;
    const LAS bf16_t* a = tile + (k0 + 4 * g + (i16 >> 2)) * pitch + n0 + 4 * (i16 & 3);
    const s16x4 lo = vtr(a), hi = vtr(a + 16 * pitch);
    bf16x8 r; r[0] = lo[0]; r[1] = lo[1]; r[2] = lo[2]; r[3] = lo[3]; r[4] = hi[0]; r[5] = hi[1]; r[6] = hi[2]; r[7] = hi[3]; return r;
}
__device__ __forceinline__ bf16x8 pack_frag(const f32x4 a, const f32x4 b) {
    u32x4 w; w.x = cvt_pk_bf16(a[0], a[1]); w.y = cvt_pk_bf16(a[2], a[3]); w.z = cvt_pk_bf16(b[0], b[1]); w.w = cvt_pk_bf16(b[2], b[3]);
    return __builtin_bit_cast(bf16x8, w);
}
#define MFMA16(a, b, c) __builtin_amdgcn_mfma_f32_16x16x32_bf16((a), (b), (c), 0, 0, 0)

typedef const f32x4 (&AccRef)[2][2][4][2];
#define EPI_ROWS() _Pragma("unroll") for (int ai = 0; ai < 2; ++ai) _Pragma("unroll") for (int m = 0; m < 4; ++m)
#define EPI_BJ() _Pragma("unroll") for (int bj = 0; bj < 2; ++bj)

template <int LDC, int NTN> struct EpiPlainBf16 {
    static constexpr bool PERM = true, AFTER_DRAIN = false; static constexpr int ldc = LDC, ntn = NTN;
    bf16_t* O;
    __device__ __forceinline__ void operator()(AccRef acc, const pg8::Unit& u, int wr, int wc, int fr, int fq) const {
        const int row0 = u.pm * 256 + wr * 64 + fr, col0 = (u.pn % ntn) * 256 + wc * 32 + 8 * fq;
        EPI_ROWS() { bf16_t* rowp = O + (size_t)(row0 + ai * 128 + m * 16) * ldc + col0;
            EPI_BJ() { const f32x4 v0 = acc[ai][bj][m][0], v1 = acc[ai][bj][m][1];
                u32x4 w; w.x = cvt_pk_bf16(v0[0], v0[1]); w.y = cvt_pk_bf16(v0[2], v0[3]); w.z = cvt_pk_bf16(v1[0], v1[1]); w.w = cvt_pk_bf16(v1[2], v1[3]);
                *(u32x4*)(rowp + bj * 128) = w; } }
    }
};
struct EpiPleUp {
    static constexpr bool PERM = true, AFTER_DRAIN = false;
    bf16_t* O; float* ess;
    __device__ __forceinline__ void operator()(AccRef acc, const pg8::Unit& u, int wr, int wc, int fr, int fq) const {
        const int row0 = u.pm * 256 + wr * 64 + fr, col0 = u.pn * 256 + wc * 32 + 8 * fq;
        EPI_ROWS() { const int row = row0 + ai * 128 + m * 16; bf16_t* rowp = O + (size_t)row * D + col0; float s = 0.f;
            EPI_BJ() { const f32x4 v0 = acc[ai][bj][m][0], v1 = acc[ai][bj][m][1];
                s += (v0[0] * v0[0] + v0[1] * v0[1]) + (v0[2] * v0[2] + v0[3] * v0[3]) + (v1[0] * v1[0] + v1[1] * v1[1]) + (v1[2] * v1[2] + v1[3] * v1[3]);
                u32x4 w; w.x = cvt_pk_bf16(v0[0], v0[1]); w.y = cvt_pk_bf16(v0[2], v0[3]); w.z = cvt_pk_bf16(v1[0], v1[1]); w.w = cvt_pk_bf16(v1[2], v1[3]);
                *(u32x4*)(rowp + bj * 128) = w; }
            s += __shfl_xor(s, 16); s += __shfl_xor(s, 32);
            if (fq == 0) ess[(size_t)row * 16 + u.pn * 4 + wc] = s; }
    }
};
struct EpiResid {
    static constexpr bool PERM = false, AFTER_DRAIN = false;
    const float* base; float* out;
    __device__ __forceinline__ void operator()(AccRef acc, const pg8::Unit& u, int wr, int wc, int fr, int fq) const {
        const int row0 = u.pm * 256 + wr * 64 + fr, col0 = u.pn * 256 + wc * 32 + 4 * fq;
        EPI_ROWS() { const size_t ro = (size_t)(row0 + ai * 128 + m * 16) * D + col0;
            EPI_BJ()
#pragma unroll
                for (int n = 0; n < 2; ++n) { const size_t o = ro + bj * 128 + n * 16; const f32x4 b = *(const f32x4*)(base + o); *(f32x4*)(out + o) = b + acc[ai][bj][m][n]; } }
    }
};
struct EpiSwiglu {
    static constexpr bool PERM = true, AFTER_DRAIN = false;
    bf16_t* H;
    __device__ __forceinline__ void operator()(AccRef acc, const pg8::Unit& u, int wr, int wc, int fr, int fq) const {
        const int row0 = u.pm * 256 + wr * 64 + fr, ct = u.pn & 3;
        EPI_ROWS() { bf16_t* rowp = H + (size_t)(row0 + ai * 128 + m * 16) * FF;
            EPI_BJ() { const f32x4 g = acc[ai][bj][m][0], up = acc[ai][bj][m][1]; const int ff = 128 * ct + 64 * bj + 16 * wc + 4 * fq;
                u32x2 w; w.x = cvt_pk_bf16(siluf_(g[0]) * up[0], siluf_(g[1]) * up[1]); w.y = cvt_pk_bf16(siluf_(g[2]) * up[2], siluf_(g[3]) * up[3]);
                *(u32x2*)(rowp + ff) = w; } }
    }
};
struct EpiPleGate {
    static constexpr bool PERM = false, AFTER_DRAIN = false;
    float* h; const bf16_t* eraw; const float* erstd; const float* gple;
    __device__ __forceinline__ void operator()(AccRef acc, const pg8::Unit& u, int wr, int wc, int fr, int fq) const {
        const int row0 = u.pm * 256 + wr * 64 + fr, col0 = u.pn * 256 + wc * 32 + 4 * fq;
        EPI_ROWS() { const int row = row0 + ai * 128 + m * 16; const float rs = erstd[row]; const size_t ro = (size_t)row * D + col0;
            EPI_BJ()
#pragma unroll
                for (int n = 0; n < 2; ++n) { const size_t o = ro + bj * 128 + n * 16; const int c = col0 + bj * 128 + n * 16;
                    const f32x4 hv = *(const f32x4*)(h + o); const f32x4 gv = *(const f32x4*)(gple + c); const u32x2 ew = *(const u32x2*)(eraw + o); const f32x4 a = acc[ai][bj][m][n];
                    f32x4 r; r[0] = hv[0] + bf_lo(ew.x) * rs * gv[0] * sigmoidf_(a[0]); r[1] = hv[1] + bf_hi(ew.x) * rs * gv[1] * sigmoidf_(a[1]);
                    r[2] = hv[2] + bf_lo(ew.y) * rs * gv[2] * sigmoidf_(a[2]); r[3] = hv[3] + bf_hi(ew.y) * rs * gv[3] * sigmoidf_(a[3]);
                    *(f32x4*)(h + o) = r; } }
    }
};
struct EpiRet {
    static constexpr bool PERM = true, AFTER_DRAIN = false;
    bf16_t* Z; const float* rope;
    __device__ __forceinline__ void operator()(AccRef acc, const pg8::Unit& u, int wr, int wc, int fr, int fq) const {
        const int row0 = u.pm * 256 + wr * 64 + fr;
        const bool rot = u.pn < 8;
        const float sc = (rot && u.pn >= 4) ? 0.08838834764831845f : 1.0f;
        const int i0 = 4 * (4 * wc + fq);
        const int ca = rot ? (2 * u.pn) * 128 + i0 : u.pn * 256 + wc * 32 + 8 * fq, dcb = rot ? 64 : 4;
        EPI_ROWS() { const int row = row0 + ai * 128 + m * 16; const int pos = row & (SEQ - 1);
            f32x4 cs = (f32x4){1.f, 1.f, 1.f, 1.f}, sn = (f32x4){0.f, 0.f, 0.f, 0.f};
            if (rot) { cs = *(const f32x4*)(rope + (size_t)pos * 64 + i0); sn = *(const f32x4*)(rope + (size_t)SEQ * 64 + (size_t)pos * 64 + i0); }
            bf16_t* rowp = Z + (size_t)row * OD_IN + ca;
            EPI_BJ() { const f32x4 x1 = acc[ai][bj][m][0], x2 = acc[ai][bj][m][1];
                u32x2 a, b;
                a.x = cvt_pk_bf16((x1[0] * cs[0] - x2[0] * sn[0]) * sc, (x1[1] * cs[1] - x2[1] * sn[1]) * sc); a.y = cvt_pk_bf16((x1[2] * cs[2] - x2[2] * sn[2]) * sc, (x1[3] * cs[3] - x2[3] * sn[3]) * sc);
                b.x = cvt_pk_bf16((x2[0] * cs[0] + x1[0] * sn[0]) * sc, (x2[1] * cs[1] + x1[1] * sn[1]) * sc); b.y = cvt_pk_bf16((x2[2] * cs[2] + x1[2] * sn[2]) * sc, (x2[3] * cs[3] + x1[3] * sn[3]) * sc);
                *(u32x2*)(rowp + bj * 128) = a; *(u32x2*)(rowp + bj * 128 + dcb) = b; }
            asm volatile("" ::: "memory"); }
    }
};
struct MoeOrder {
    const int* tile_e; int ntiles, G, c;
    __device__ __forceinline__ void init(const int* te, int G_, int c_) { tile_e = te; ntiles = te[MOE_TILES]; G = G_; c = c_; }
    __device__ __forceinline__ bool next(int i, pg8::Unit& u) const {
        const int L = i * G + c; if (L >= ntiles * 4) return false;
        const int rt = L >> 2; u.pm = rt; u.pn = tile_e[rt] * 4 + (L & 3); return true;
    }
    __device__ __forceinline__ void a_ready(const pg8::Unit&) const {}
    __device__ __forceinline__ void done(const pg8::Unit&) const {}
};
template <int MODE>
__device__ __forceinline__ void tr_item(const float* W, const float* W2, int K, int Nsrc, bf16_t* WT, int r0, int k0, LAS float* scr, int lane) {
    const int kr = lane >> 4, c4 = lane & 15, r = r0 + 4 * c4;
    const float* src = W; int col = r; bool ok = true;
    if (MODE == 0) { ok = r < Nsrc; }
    if (MODE == 1) { if (r < 2048) { const int hh = r >> 7, w = r & 127, w8 = w >> 3, rr = w & 7; col = hh * 128 + ((rr < 4) ? 4 * w8 : 64 + 4 * w8); } }
    if (MODE == 2) { const int w8 = r >> 3; src = ((r >> 2) & 1) ? W2 : W; col = 4 * w8; }
#pragma unroll 4
    for (int i = 0; i < 16; ++i) { const int k = kr + 4 * i;
        f32x4 v = (f32x4){0.f, 0.f, 0.f, 0.f};
        if (ok) v = *(const f32x4*)(src + (size_t)(k0 + k) * Nsrc + col);
        LAS float* d = scr + k * 65 + 4 * c4; d[0] = v[0]; d[1] = v[1]; d[2] = v[2]; d[3] = v[3]; }
    asm volatile("s_waitcnt lgkmcnt(0)" ::: "memory");
    const int c = lane & 7;
#pragma unroll
    for (int j = 0; j < 8; ++j) { const int n = (lane >> 3) + 8 * j; const LAS float* s = scr + (8 * c) * 65 + n;
        u32x4 o; o.x = cvt_pk_bf16(s[0 * 65], s[1 * 65]); o.y = cvt_pk_bf16(s[2 * 65], s[3 * 65]); o.z = cvt_pk_bf16(s[4 * 65], s[5 * 65]); o.w = cvt_pk_bf16(s[6 * 65], s[7 * 65]);
        *(u32x4*)(WT + (size_t)(r0 + n) * K + k0 + 8 * c) = o; }
    asm volatile("s_waitcnt lgkmcnt(0)" ::: "memory");
}
template <int MODE>
__device__ __forceinline__ void tr_matrix(const float* W, const float* W2, int K, int Nsrc, bf16_t* WT, int rows, LAS float* scr, int lane, int gw, int ngw) {
    const int nkb = K / 64, nitems = (rows / 64) * nkb;
    for (int it = gw; it < nitems; it += ngw) { const int rb = it / nkb, kb = it % nkb; tr_item<MODE>(W, W2, K, Nsrc, WT, rb * 64, kb * 64, scr, lane); }
}
__device__ __forceinline__ void convert_moe_layer(const float* wg, const float* wu, const float* wd, bf16_t* GU, bf16_t* DN, LAS float* scr, int lane, int gw, int ngw) {
    const int n_gu = NEXP * 256, n_dn = NEXP * 128;
    for (int it = gw; it < n_gu + n_dn; it += ngw) {
        if (it < n_gu) { const int e = it >> 8, r = it & 255, rb = r >> 4, kb = r & 15;
            tr_item<2>(wg + (size_t)e * D * FF, wu + (size_t)e * D * FF, D, FF, GU + (size_t)e * 1024 * D, rb * 64, kb * 64, scr, lane); }
        else { const int q = it - n_gu, e = q >> 7, r = q & 127, rb = r >> 3, kb = r & 7;
            tr_item<0>(wd + (size_t)e * FF * D, nullptr, FF, D, DN + (size_t)e * 1024 * FF, rb * 64, kb * 64, scr, lane); }
    }
}
__device__ __forceinline__ void rms_row_to_bf16(const float* xrow, const float* gain, bf16_t* orow, int lane) {
    const f32x4* xr = (const f32x4*)xrow + lane; const f32x4* gr = (const f32x4*)gain + lane;
    f32x4 v[4]; float s = 0.f;
#pragma unroll
    for (int j = 0; j < 4; ++j) { v[j] = xr[64 * j]; s += (v[j][0] * v[j][0] + v[j][1] * v[j][1]) + (v[j][2] * v[j][2] + v[j][3] * v[j][3]); }
    const float rstd = 1.0f / sqrtf(wave_sum(s) * (1.0f / D) + RMS_EPS);
    u32x2* o8 = (u32x2*)orow + lane;
#pragma unroll
    for (int j = 0; j < 4; ++j) { const f32x4 g = gr[64 * j]; u32x2 w; w.x = cvt_pk_bf16(v[j][0] * rstd * g[0], v[j][1] * rstd * g[1]); w.y = cvt_pk_bf16(v[j][2] * rstd * g[2], v[j][3] * rstd * g[3]); o8[64 * j] = w; }
}
__device__ __forceinline__ void lru_local_unit(const bf16_t* Z0, const float* conv_w, const float* conv_b, const float* wa, const float* ba, const float* wx, const float* bx, const float* lam,
                                               float* HLOC, float* PCUM, float* SUMA, float* SUMH, ldsp lds, int b, int c, int tid) {
    const int ch = tid, lane = tid & 63, blk = __builtin_amdgcn_readfirstlane(tid >> 6), i16 = lane & 15, g = lane >> 4;
    LAS bf16_t* Xc = (LAS bf16_t*)(lds + blk * 17408); LAS float* GB = (LAS float*)(lds + blk * 17408 + 9216);
    const float w0 = conv_w[ch], w1 = conv_w[512 + ch], w2 = conv_w[1024 + ch], w3 = conv_w[1536 + ch], cb = conv_b[ch];
    const float bav = ba[ch], bxv = bx[ch];
    const float l = lam[ch]; const float z = __expf(-l);
    const float sp = (z < 0.02f) ? z * (1.0f - z * (0.5f - z * (0.33333334f - 0.25f * z))) : __logf(1.0f + z);
    const float c8 = -8.0f * sp;
    const size_t tok0 = (size_t)b * SEQ + (size_t)c * 64;
    float xm3 = 0.f, xm2 = 0.f, xm1 = 0.f;
    if (c > 0) { xm3 = bf2f(Z0[(tok0 - 3) * EV_INP + ZC_XA + ch]); xm2 = bf2f(Z0[(tok0 - 2) * EV_INP + ZC_XA + ch]); xm1 = bf2f(Z0[(tok0 - 1) * EV_INP + ZC_XA + ch]); }
    bf16x8 bfa[2][4], bfx[2][4];
#pragma unroll
    for (int ks = 0; ks < 2; ++ks)
#pragma unroll
        for (int nt = 0; nt < 4; ++nt) { const float* pa = wa + (size_t)blk * 4096 + (32 * ks + 8 * g) * 64 + 16 * nt + i16; const float* px = wx + (size_t)blk * 4096 + (32 * ks + 8 * g) * 64 + 16 * nt + i16;
            u32x4 ua, ux; ua.x = cvt_pk_bf16(pa[0], pa[64]); ua.y = cvt_pk_bf16(pa[128], pa[192]); ua.z = cvt_pk_bf16(pa[256], pa[320]); ua.w = cvt_pk_bf16(pa[384], pa[448]);
            ux.x = cvt_pk_bf16(px[0], px[64]); ux.y = cvt_pk_bf16(px[128], px[192]); ux.z = cvt_pk_bf16(px[256], px[320]); ux.w = cvt_pk_bf16(px[384], px[448]);
            bfa[ks][nt] = __builtin_bit_cast(bf16x8, ua); bfx[ks][nt] = __builtin_bit_cast(bf16x8, ux); }
    float xc[64];
#pragma unroll
    for (int t = 0; t < 64; ++t) { const float xt = bf2f(Z0[(tok0 + t) * EV_INP + ZC_XA + ch]);
        xc[t] = w0 * xm3 + w1 * xm2 + w2 * xm1 + w3 * xt + cb; xm3 = xm2; xm2 = xm1; xm1 = xt;
        Xc[t * 72 + lane] = (bf16_t)(cvt_pk_bf16(xc[t], 0.f) & 0xffffu); }
    float h = 0.f, P = 1.f;
#pragma unroll
    for (int mt = 0; mt < 4; ++mt) {
        const bf16x8 a0 = *(const LAS bf16x8*)(Xc + (16 * mt + i16) * 72 + 8 * g), a1 = *(const LAS bf16x8*)(Xc + (16 * mt + i16) * 72 + 32 + 8 * g);
#pragma unroll
        for (int nt = 0; nt < 4; ++nt) { f32x4 ca = (f32x4){0.f, 0.f, 0.f, 0.f}, cx = (f32x4){0.f, 0.f, 0.f, 0.f};
            ca = MFMA16(a0, bfa[0][nt], ca); ca = MFMA16(a1, bfa[1][nt], ca); cx = MFMA16(a0, bfx[0][nt], cx); cx = MFMA16(a1, bfx[1][nt], cx);
#pragma unroll
            for (int i = 0; i < 4; ++i) { GB[(4 * g + i) * 128 + 16 * nt + i16] = ca[i]; GB[(4 * g + i) * 128 + 64 + 16 * nt + i16] = cx[i]; } }
#pragma unroll
        for (int t = 0; t < 16; ++t) {
            const float r = sigmoidf_(GB[t * 128 + lane] + bav), gi = sigmoidf_(GB[t * 128 + 64 + lane] + bxv);
            const float log_a = c8 * r; const float a = __expf(log_a);
            const float y2 = 2.0f * log_a;
            const float om = (y2 > -0.3f) ? -y2 * (1.0f + y2 * (0.5f + y2 * (0.16666667f + y2 * (0.041666668f + y2 * (0.008333334f + y2 * 0.0013888889f))))) : 1.0f - a * a;
            const float u = sqrtf(fmaxf(om, 0.f)) * (gi * xc[16 * mt + t]);
            h = a * h + u; P *= a;
            const size_t o = (tok0 + 16 * mt + t) * 512 + ch;
            HLOC[o] = h; PCUM[o] = P;
        }
    }
    SUMA[((size_t)b * 64 + c) * 512 + ch] = P; SUMH[((size_t)b * 64 + c) * 512 + ch] = h;
}
__device__ __forceinline__ void lru_fix_unit(const bf16_t* Z0, const float* HLOC, const float* PCUM, const float* SUMA, const float* SUMH, bf16_t* Y0, int b, int c, int tid) {
    const int ch = tid; float hin = 0.f;
    for (int cc = 0; cc < c; ++cc) { const size_t o = ((size_t)b * 64 + cc) * 512 + ch; hin = SUMA[o] * hin + SUMH[o]; }
    const size_t tok0 = (size_t)b * SEQ + (size_t)c * 64;
#pragma unroll 8
    for (int t = 0; t < 64; ++t) { const size_t tok = tok0 + t;
        const float hv = HLOC[tok * 512 + ch] + PCUM[tok * 512 + ch] * hin; const float ga = bf2f(Z0[tok * EV_INP + ZC_GA + ch]);
        Y0[tok * D + ch] = (bf16_t)(cvt_pk_bf16(hv * gelu_tanh_(ga), 0.f) & 0xffffu); }
}
__device__ __forceinline__ void dsa_prep_token(bf16_t* Z0, const float* qg, const float* kg, size_t tok, int lane) {
    const int d0 = (lane & 7) * 8;
#pragma unroll
    for (int which = 0; which < 2; ++which) {
        bf16_t* p = Z0 + tok * EV_INP + (which ? ZC_K : ZC_Q) + lane * 8; const float* g = (which ? kg : qg) + d0;
        const u32x4 w = *(const u32x4*)p; float v[8] = {bf_lo(w.x), bf_hi(w.x), bf_lo(w.y), bf_hi(w.y), bf_lo(w.z), bf_hi(w.z), bf_lo(w.w), bf_hi(w.w)};
        float s = 0.f;
#pragma unroll
        for (int i = 0; i < 8; ++i) s += v[i] * v[i];
        s += __shfl_xor(s, 1); s += __shfl_xor(s, 2); s += __shfl_xor(s, 4);
        const float rstd = 1.0f / sqrtf(s * (1.0f / 64.0f) + RMS_EPS);
        u32x4 o; o.x = cvt_pk_bf16(v[0] * rstd * g[0], v[1] * rstd * g[1]); o.y = cvt_pk_bf16(v[2] * rstd * g[2], v[3] * rstd * g[3]);
        o.z = cvt_pk_bf16(v[4] * rstd * g[4], v[5] * rstd * g[5]); o.w = cvt_pk_bf16(v[6] * rstd * g[6], v[7] * rstd * g[7]);
        *(u32x4*)p = o;
    }
}
__device__ __forceinline__ unsigned f2key(float f) { const unsigned u = __float_as_uint(f); return (u & 0x80000000u) ? ~u : (u | 0x80000000u); }
__device__ __forceinline__ void dsa_select_unit(const bf16_t* Z0, unsigned* MASK, ldsp lds, int b, int qt, int tid) {
    const int lane = tid & 63, w = __builtin_amdgcn_readfirstlane(tid >> 6), i16 = lane & 15, g = lane >> 4;
    LAS unsigned* hist = (LAS unsigned*)lds; LAS unsigned* GE = (LAS unsigned*)(lds + 8192); LAS unsigned* pref = (LAS unsigned*)(lds + 16384); LAS unsigned* kneed = pref + 8; LAS unsigned* eqcnt = pref + 16;
    const int c = qt >> 2, nt = 4 * (c + 1);
    const size_t tok0 = (size_t)b * SEQ + (size_t)qt * 16;
    bf16x8 qf[8][2];
#pragma unroll
    for (int h = 0; h < 8; ++h)
#pragma unroll
        for (int ks = 0; ks < 2; ++ks) qf[h][ks] = *(const bf16x8*)(Z0 + (tok0 + i16) * EV_INP + ZC_IQ + h * 64 + 32 * ks + 8 * g);
    const unsigned loff = (unsigned)(i16 * EV_INP + ZC_IK + 8 * g) * 2u;
    const bf16_t* kbase = Z0 + ((size_t)b * SEQ + (size_t)w * 16) * EV_INP;
#pragma unroll 1
    for (int half = 0; half < 2; ++half) {
        float wq0[8], wq1[8];
        { const u32x4 wa4 = *(const u32x4*)(Z0 + (tok0 + 4 * g + 2 * half) * EV_INP + ZC_IW), wb4 = *(const u32x4*)(Z0 + (tok0 + 4 * g + 2 * half + 1) * EV_INP + ZC_IW);
          const float k0 = 0.04419417382415922f;
          wq0[0] = bf_lo(wa4.x) * k0; wq0[1] = bf_hi(wa4.x) * k0; wq0[2] = bf_lo(wa4.y) * k0; wq0[3] = bf_hi(wa4.y) * k0; wq0[4] = bf_lo(wa4.z) * k0; wq0[5] = bf_hi(wa4.z) * k0; wq0[6] = bf_lo(wa4.w) * k0; wq0[7] = bf_hi(wa4.w) * k0;
          wq1[0] = bf_lo(wb4.x) * k0; wq1[1] = bf_hi(wb4.x) * k0; wq1[2] = bf_lo(wb4.y) * k0; wq1[3] = bf_hi(wb4.y) * k0; wq1[4] = bf_lo(wb4.z) * k0; wq1[5] = bf_hi(wb4.z) * k0; wq1[6] = bf_lo(wb4.w) * k0; wq1[7] = bf_hi(wb4.w) * k0; }
        u32x2 ky[32];
#pragma unroll
        for (int tt = 0; tt < 32; ++tt) {
            const int t = w + 8 * tt;
            ky[tt] = (u32x2){0u, 0u};
            if ((tt & 3) == 0) asm volatile("" ::: "memory");
            if (t < nt) {
                unsigned long long kb64 = (unsigned long long)kbase; asm volatile("" : "+s"(kb64));
                const char* kp = (const char*)(kb64 + (unsigned long long)tt * 128ull * EV_INP * 2ull);
                unsigned lo2 = loff; asm volatile("" : "+v"(lo2));
                const bf16x8 k0f = *(const bf16x8*)(kp + lo2), k1f = *(const bf16x8*)(kp + lo2 + 64);
                float s0 = 0.f, s1 = 0.f;
#pragma unroll
                for (int h = 0; h < 8; ++h) { f32x4 acc = (f32x4){0.f, 0.f, 0.f, 0.f}; acc = MFMA16(qf[h][0], k0f, acc); acc = MFMA16(qf[h][1], k1f, acc);
                    const float v0 = half ? acc[2] : acc[0], v1 = half ? acc[3] : acc[1];
                    s0 += fmaxf(v0, 0.f) * wq0[h]; s1 += fmaxf(v1, 0.f) * wq1[h]; }
                ky[tt] = (u32x2){f2key(s0), f2key(s1)};
            }
        }
        for (int i = tid; i < 2048; i += 512) GE[i] = 0u;
        if (tid < 8) { pref[tid] = 0u; kneed[tid] = 256u; eqcnt[tid] = 0u; }
        __syncthreads();
        if (nt > 16) {
#pragma unroll 1
            for (int pass = 0; pass < 4; ++pass) {
                const int shift = 24 - 8 * pass;
                for (int i = tid; i < 2048; i += 512) hist[i] = 0u;
                __syncthreads();
                const unsigned pf0 = pref[2 * g], pf1 = pref[2 * g + 1];
#pragma unroll
                for (int tt = 0; tt < 32; ++tt) { const int t = w + 8 * tt;
                    if (t < nt) {
                        const unsigned ka = ky[tt].x, kb = ky[tt].y;
                        if ((pass == 0) || ((ka >> ((shift + 8) & 31)) == pf0)) __hip_atomic_fetch_add(hist + (2 * g) * 256 + ((ka >> shift) & 255u), 1u, __ATOMIC_RELAXED, __HIP_MEMORY_SCOPE_WORKGROUP);
                        if ((pass == 0) || ((kb >> ((shift + 8) & 31)) == pf1)) __hip_atomic_fetch_add(hist + (2 * g + 1) * 256 + ((kb >> shift) & 255u), 1u, __ATOMIC_RELAXED, __HIP_MEMORY_SCOPE_WORKGROUP); } }
                __syncthreads();
                { const int row = w;
                    const u32x4 cn = *(const LAS u32x4*)(hist + row * 256 + 4 * lane);
                    const unsigned s = cn.x + cn.y + cn.z + cn.w; unsigned v = s;
#pragma unroll
                    for (int off = 1; off < 64; off <<= 1) { const unsigned t2 = __shfl_down(v, off); if (lane + off < 64) v += t2; }
                    const unsigned ex = v - s;
                    const unsigned kn = kneed[row], pr = pref[row];
                    const unsigned a3 = ex, a2 = ex + cn.w, a1 = a2 + cn.z, a0 = a1 + cn.y;
                    int bin = -1; unsigned ab = 0, cb = 0;
                    if (a3 < kn && kn <= a3 + cn.w) { bin = 4 * lane + 3; ab = a3; cb = cn.w; }
                    else if (a2 < kn && kn <= a2 + cn.z) { bin = 4 * lane + 2; ab = a2; cb = cn.z; }
                    else if (a1 < kn && kn <= a1 + cn.y) { bin = 4 * lane + 1; ab = a1; cb = cn.y; }
                    else if (a0 < kn && kn <= a0 + cn.x) { bin = 4 * lane; ab = a0; cb = cn.x; }
                    if (bin >= 0) { pref[row] = (pr << 8) | (unsigned)bin; kneed[row] = kn - ab; eqcnt[row] = cb; }
                }
                __syncthreads();
            }
        }
        {
            const unsigned T0 = pref[2 * g], T1 = pref[2 * g + 1];
#pragma unroll
            for (int tt = 0; tt < 32; ++tt) { const int t = w + 8 * tt;
                if (t < nt) {
                    const bool sel = nt > 16;
                    const unsigned long long gt0 = __ballot(sel ? ky[tt].x > T0 : true), eq0 = __ballot(sel ? ky[tt].x == T0 : false);
                    const unsigned long long gt1 = __ballot(sel ? ky[tt].y > T1 : true), eq1 = __ballot(sel ? ky[tt].y == T1 : false);
                    if (lane < 4) { GE[(2 * lane) * 256 + t] = (unsigned)((gt0 >> (16 * lane)) & 0xffffull) | ((unsigned)((eq0 >> (16 * lane)) & 0xffffull) << 16);
                                    GE[(2 * lane + 1) * 256 + t] = (unsigned)((gt1 >> (16 * lane)) & 0xffffull) | ((unsigned)((eq1 >> (16 * lane)) & 0xffffull) << 16); }
                } }
        }
        __syncthreads();
        if (tid < 8 && nt > 16) { const int q = tid; unsigned rem = kneed[q];
            if (rem < eqcnt[q]) {
                for (int t = 0; t < nt; ++t) { unsigned x = GE[q * 256 + t]; unsigned e = x >> 16; const unsigned pc = __popc(e);
                    if (pc <= rem) rem -= pc;
                    else { unsigned keep = 0; while (rem) { const unsigned low = e & (0u - e); keep |= low; e ^= low; --rem; } x = (x & 0xffffu) | (keep << 16); GE[q * 256 + t] = x; } } } }
        __syncthreads();
        for (int i = tid; i < 1024; i += 512) { const int r8 = i >> 7, t2 = i & 127; const int q = 4 * (r8 >> 1) + 2 * half + (r8 & 1);
            const unsigned x0 = GE[r8 * 256 + 2 * t2], x1 = GE[r8 * 256 + 2 * t2 + 1];
            const unsigned m0 = (x0 | (x0 >> 16)) & 0xffffu, m1 = (x1 | (x1 >> 16)) & 0xffffu;
            MASK[(tok0 + q) * 128 + t2] = m0 | (m1 << 16); }
        __syncthreads();
    }
}
__device__ __forceinline__ int t5_bucket(int rel) {
    const int n = rel < 0 ? -rel : rel; const int ret = rel > 0 ? 16 : 0;
    int v;
    if (n < 8) v = n; else { const int val = n < 12 ? 0 : n < 16 ? 1 : n < 23 ? 2 : n < 32 ? 3 : n < 46 ? 4 : n < 64 ? 5 : n < 91 ? 6 : 7; v = 8 + val; if (v > 15) v = 15; }
    return ret + v;
}
__device__ __forceinline__ void dsa_attn_unit(const bf16_t* Z0, const unsigned* MASK, const float* rel_bias, bf16_t* Y0, ldsp lds, int b, int h, int qt, int tid) {
    const int lane = tid & 63, w = __builtin_amdgcn_readfirstlane(tid >> 6), qcol = lane & 15, g = lane >> 4;
    LAS bf16_t* Ks = (LAS bf16_t*)lds; LAS bf16_t* Vs = (LAS bf16_t*)(lds + 9216); LAS float* lut = (LAS float*)(lds + 18432);
    __syncthreads();
    if (tid < 192) lut[tid] = rel_bias[t5_bucket(tid - 128) * 8 + h] * LOG2E;
    const int qpos = qt * 128 + w * 16 + qcol; const size_t tokq = (size_t)b * SEQ + qpos;
    bf16x8 qf[2];
#pragma unroll
    for (int ks = 0; ks < 2; ++ks) qf[ks] = *(const bf16x8*)(Z0 + tokq * EV_INP + ZC_Q + h * 64 + 32 * ks + 8 * g);
    const unsigned long long* mrow = (const unsigned long long*)(MASK + tokq * 128);
    const int nkb = 2 * qt + 2;
    float mrun = -1e30f, lsum = 0.f; f32x4 o[4];
#pragma unroll
    for (int dt = 0; dt < 4; ++dt) o[dt] = (f32x4){0.f, 0.f, 0.f, 0.f};
    const float scale = 0.125f * LOG2E;
    const int srow = tid >> 3, sch = tid & 7;
    for (int kb = 0; kb < nkb; ++kb) {
        __syncthreads();
        { const bf16_t* src = Z0 + ((size_t)b * SEQ + (size_t)kb * 64 + srow) * EV_INP + h * 64 + sch * 8;
          *(LAS u32x4*)(Ks + srow * 72 + sch * 8) = *(const u32x4*)(src + ZC_K); *(LAS u32x4*)(Vs + srow * 72 + sch * 8) = *(const u32x4*)(src + ZC_V); }
        __syncthreads();
        const unsigned long long mw = mrow[kb];
        f32x4 s[4];
#pragma unroll
        for (int kt = 0; kt < 4; ++kt) { f32x4 acc = (f32x4){0.f, 0.f, 0.f, 0.f};
#pragma unroll
            for (int ks = 0; ks < 2; ++ks) { const bf16x8 a = *(const LAS bf16x8*)(Ks + (kt * 16 + qcol) * 72 + 32 * ks + 8 * g); acc = MFMA16(a, qf[ks], acc); }
            s[kt] = acc; }
        const bool far = (kb * 64 + 63 + 128 <= qt * 128);
        const float bfar = lut[0];
        float mx = -INFINITY;
#pragma unroll
        for (int kt = 0; kt < 4; ++kt)
#pragma unroll
            for (int i = 0; i < 4; ++i) { const int kk = kt * 16 + 4 * g + i; const int key = kb * 64 + kk;
                float bias = bfar;
                if (!far) { int idx = key - qpos; idx = idx < -128 ? -128 : idx; bias = lut[idx + 128]; }
                float x = s[kt][i] * scale + bias;
                x = ((mw >> kk) & 1ull) ? x : -INFINITY;
                s[kt][i] = x; mx = fmaxf(mx, x); }
        mx = fmaxf(mx, __shfl_xor(mx, 16)); mx = fmaxf(mx, __shfl_xor(mx, 32));
        const float mnew = fmaxf(mrun, mx); const float alpha = exp2f(mrun - mnew); mrun = mnew;
        float ps = 0.f;
#pragma unroll
        for (int kt = 0; kt < 4; ++kt)
#pragma unroll
            for (int i = 0; i < 4; ++i) { const float p = exp2f(s[kt][i] - mnew); s[kt][i] = p; ps += p; }
        lsum = lsum * alpha + ps;
#pragma unroll
        for (int dt = 0; dt < 4; ++dt) o[dt] = o[dt] * alpha;
        const bf16x8 pb0 = pack_frag(s[0], s[1]), pb1 = pack_frag(s[2], s[3]);
#pragma unroll
        for (int dt = 0; dt < 4; ++dt) { o[dt] = MFMA16(frag_tr(Vs, 72, 0, 16 * dt, lane), pb0, o[dt]); o[dt] = MFMA16(frag_tr(Vs, 72, 32, 16 * dt, lane), pb1, o[dt]); }
    }
    lsum += __shfl_xor(lsum, 16); lsum += __shfl_xor(lsum, 32);
    const float inv = 1.0f / lsum;
#pragma unroll
    for (int dt = 0; dt < 4; ++dt) { u32x2 wv; wv.x = cvt_pk_bf16(o[dt][0] * inv, o[dt][1] * inv); wv.y = cvt_pk_bf16(o[dt][2] * inv, o[dt][3] * inv);
        *(u32x2*)(Y0 + tokq * D + 512 + h * 64 + 16 * dt + 4 * g) = wv; }
}
__device__ __forceinline__ void moe_route_block(const float* hbuf, const float* gain, const float* RT  , bf16_t* XN, unsigned* RE, f32x2* RW, unsigned* CNT, ldsp lds, int vb, int tid) {
    const int lane = tid & 63, w = __builtin_amdgcn_readfirstlane(tid >> 6);
    LAS unsigned* lcnt = (LAS unsigned*)lds;
    __syncthreads();
    if (tid < 32) lcnt[tid] = 0u;
    __syncthreads();
    f32x4 gv[4];
#pragma unroll
    for (int j = 0; j < 4; ++j) gv[j] = *((const f32x4*)gain + lane + 64 * j);
#pragma unroll 1
    for (int it = 0; it < 2; ++it) {
        const size_t tok0 = (size_t)vb * 64 + w * 8 + it * 4;
        f32x4 y[4][4];
#pragma unroll
        for (int t = 0; t < 4; ++t) { const f32x4* xr = (const f32x4*)(hbuf + (tok0 + t) * D) + lane; float s = 0.f;
#pragma unroll
            for (int j = 0; j < 4; ++j) { y[t][j] = xr[64 * j]; s += (y[t][j][0] * y[t][j][0] + y[t][j][1] * y[t][j][1]) + (y[t][j][2] * y[t][j][2] + y[t][j][3] * y[t][j][3]); }
            const float rstd = 1.0f / sqrtf(wave_sum(s) * (1.0f / D) + RMS_EPS);
            u32x2* o8 = (u32x2*)(XN + (tok0 + t) * D) + lane;
#pragma unroll
            for (int j = 0; j < 4; ++j) { y[t][j] = y[t][j] * rstd * gv[j]; u32x2 wv; wv.x = cvt_pk_bf16(y[t][j][0], y[t][j][1]); wv.y = cvt_pk_bf16(y[t][j][2], y[t][j][3]); o8[64 * j] = wv; } }
        float lg[4] = {0.f, 0.f, 0.f, 0.f};
#pragma unroll 2
        for (int o = 0; o < 36; ++o) { f32x4 wv[4];
#pragma unroll
            for (int j = 0; j < 4; ++j) wv[j] = *((const f32x4*)(RT + (size_t)o * D) + lane + 64 * j);
#pragma unroll
            for (int t = 0; t < 4; ++t) { float d = 0.f;
#pragma unroll
                for (int j = 0; j < 4; ++j) d += (y[t][j][0] * wv[j][0] + y[t][j][1] * wv[j][1]) + (y[t][j][2] * wv[j][2] + y[t][j][3] * wv[j][3]);
                d = wave_sum(d); if (lane == o) lg[t] = d; } }
#pragma unroll
        for (int t = 0; t < 4; ++t) {
            float gl[4];
#pragma unroll
            for (int i = 0; i < 4; ++i) gl[i] = __shfl(lg[t], i);
            int gs = 0; float gm = gl[0];
#pragma unroll
            for (int i = 1; i < 4; ++i) if (gl[i] > gm) { gm = gl[i]; gs = i; }
            float den = 0.f;
#pragma unroll
            for (int i = 0; i < 4; ++i) den += __expf(gl[i] - gm);
            const float gw = 1.0f / den;
            float el[8];
#pragma unroll
            for (int i = 0; i < 8; ++i) el[i] = __shfl(lg[t], 4 + gs * 8 + i);
            int i1 = 0; float v1 = el[0];
#pragma unroll
            for (int i = 1; i < 8; ++i) if (el[i] > v1) { v1 = el[i]; i1 = i; }
            int i2 = -1; float v2 = -INFINITY;
#pragma unroll
            for (int i = 0; i < 8; ++i) if (i != i1 && el[i] > v2) { v2 = el[i]; i2 = i; }
            const float e2 = __expf(v2 - v1); const float w1 = gw / (1.0f + e2), w2 = gw * e2 / (1.0f + e2);
            const unsigned ex1 = gs * 8 + i1, ex2 = gs * 8 + i2;
            if (lane == 0) { RE[tok0 + t] = ex1 | (ex2 << 8); RW[tok0 + t] = (f32x2){w1, w2};
                __hip_atomic_fetch_add(lcnt + ex1, 1u, __ATOMIC_RELAXED, __HIP_MEMORY_SCOPE_WORKGROUP); __hip_atomic_fetch_add(lcnt + ex2, 1u, __ATOMIC_RELAXED, __HIP_MEMORY_SCOPE_WORKGROUP); }
        }
    }
    __syncthreads();
    if (tid < 32) CNT[vb * 32 + tid] = lcnt[tid];
}
__device__ __forceinline__ void moe_scatter_block(const unsigned* RE, const unsigned* CNT, const bf16_t* XN, bf16_t* XS, unsigned* SLOT, int* TILEE, ldsp lds, int vb, int tid) {
    const int lane = tid & 63, w = __builtin_amdgcn_readfirstlane(tid >> 6);
    LAS unsigned* part = (LAS unsigned*)lds; LAS unsigned* tot = (LAS unsigned*)(lds + 4096); LAS unsigned* bef = tot + 32; LAS unsigned* base = tot + 64;
    LAS unsigned* ent = (LAS unsigned*)(lds + 4608); LAS unsigned* slots = (LAS unsigned*)(lds + 5120);
    __syncthreads();
    { const int e = tid & 31, pt = tid >> 5; unsigned st = 0, sb = 0;
        for (int i = 0; i < 16; ++i) { const int v = pt * 16 + i; const unsigned cval = CNT[v * 32 + e]; st += cval; if (v < vb) sb += cval; }
        part[(pt * 32 + e) * 2] = st; part[(pt * 32 + e) * 2 + 1] = sb; }
    if (tid < 128) { const unsigned r = RE[(size_t)vb * 64 + (tid >> 1)]; ent[tid] = (tid & 1) ? ((r >> 8) & 255u) : (r & 255u); }
    __syncthreads();
    if (tid < 32) { unsigned st = 0, sb = 0; for (int p = 0; p < 16; ++p) { st += part[(p * 32 + tid) * 2]; sb += part[(p * 32 + tid) * 2 + 1]; } tot[tid] = st; bef[tid] = sb; }
    __syncthreads();
    if (tid == 0) { unsigned acc = 0; for (int e = 0; e < 32; ++e) { base[e] = acc * 256u; const unsigned nt = (tot[e] + 255u) >> 8;
            if (vb == 0) for (unsigned i = 0; i < nt; ++i) TILEE[acc + i] = e;
            acc += nt; }
        if (vb == 0) TILEE[MOE_TILES] = (int)acc; }
    __syncthreads();
    if (tid < 128) { const unsigned e = ent[tid]; unsigned rank = 0; for (int i = 0; i < tid; ++i) rank += (ent[i] == e) ? 1u : 0u;
        const unsigned s = base[e] + bef[e] + rank; slots[tid] = s; SLOT[(size_t)vb * 128 + tid] = s; }
    __syncthreads();
    for (int t = 0; t < 8; ++t) { const int tl = w * 8 + t; const size_t tok = (size_t)vb * 64 + tl;
        const u32x4* src = (const u32x4*)(XN + tok * D) + lane; const u32x4 a = src[0], bq = src[64];
        const unsigned s0 = slots[2 * tl], s1 = slots[2 * tl + 1];
        u32x4* d0 = (u32x4*)(XS + (size_t)s0 * D) + lane; u32x4* d1 = (u32x4*)(XS + (size_t)s1 * D) + lane;
        d0[0] = a; d0[64] = bq; d1[0] = a; d1[64] = bq; }
}
__device__ __forceinline__ void moe_combine_token(float* hbuf, const bf16_t* YD, const unsigned* SLOT, const f32x2* RW, bf16_t* HB, const float* ESS, float* ERSTD, size_t tok, int lane) {
    const unsigned s0 = SLOT[tok * 2], s1 = SLOT[tok * 2 + 1]; const f32x2 wv = RW[tok];
    f32x4* hr = (f32x4*)(hbuf + tok * D) + lane; const u32x2* y0 = (const u32x2*)(YD + (size_t)s0 * D) + lane; const u32x2* y1 = (const u32x2*)(YD + (size_t)s1 * D) + lane;
    u32x2* hb = (u32x2*)(HB + tok * D) + lane;
#pragma unroll
    for (int j = 0; j < 4; ++j) { f32x4 v = hr[64 * j]; const u32x2 a = y0[64 * j], bq = y1[64 * j];
        v[0] += wv[0] * bf_lo(a.x) + wv[1] * bf_lo(bq.x); v[1] += wv[0] * bf_hi(a.x) + wv[1] * bf_hi(bq.x); v[2] += wv[0] * bf_lo(a.y) + wv[1] * bf_lo(bq.y); v[3] += wv[0] * bf_hi(a.y) + wv[1] * bf_hi(bq.y);
        hr[64 * j] = v; u32x2 o; o.x = cvt_pk_bf16(v[0], v[1]); o.y = cvt_pk_bf16(v[2], v[3]); hb[64 * j] = o; }
    float s = (lane < 16) ? ESS[tok * 16 + lane] : 0.f;
    s += __shfl_xor(s, 1); s += __shfl_xor(s, 2); s += __shfl_xor(s, 4); s += __shfl_xor(s, 8);
    if (lane == 0) ERSTD[tok] = 1.0f / sqrtf(s * (1.0f / D) + RMS_EPS);
}
__device__ __forceinline__ float ret_log2g(int h) { const float x = __builtin_ldexpf(1.0f, -5 - h); const float ln = -(x + x * x * 0.5f + x * x * x * (1.0f / 3.0f) + x * x * x * x * 0.25f + x * x * x * x * x * 0.2f + x * x * x * x * x * x * (1.0f / 6.0f)); return ln * LOG2E; }
__device__ __forceinline__ void ret_kv_unit(const bf16_t* Z1, float* SKV, ldsp lds, int b, int h, int sc, int tid) {
    const int lane = tid & 63, w = __builtin_amdgcn_readfirstlane(tid >> 6), i16 = lane & 15, g = lane >> 4;
    LAS bf16_t* Vs = (LAS bf16_t*)lds; LAS bf16_t* Ks = (LAS bf16_t*)(lds + 33792);
    const float l2g = ret_log2g(h);
    f32x4 acc[2][8];
#pragma unroll
    for (int mt = 0; mt < 2; ++mt)
#pragma unroll
        for (int nt = 0; nt < 8; ++nt) acc[mt][nt] = (f32x4){0.f, 0.f, 0.f, 0.f};
    const size_t tok0 = (size_t)b * SEQ + (size_t)sc * 256;
    for (int jb = 0; jb < 4; ++jb) {
        __syncthreads();
#pragma unroll
        for (int q = 0; q < 4; ++q) { const int idx = tid + 512 * q, row = idx >> 5, chn = idx & 31;
            *(LAS u32x4*)(Vs + row * 264 + chn * 8) = *(const u32x4*)(Z1 + (tok0 + jb * 64 + row) * OD_IN + 2048 + h * 256 + chn * 8); }
#pragma unroll
        for (int q = 0; q < 2; ++q) { const int idx = tid + 512 * q, row = idx >> 4, chn = idx & 15;
            const u32x4 kw = *(const u32x4*)(Z1 + (tok0 + jb * 64 + row) * OD_IN + 1024 + h * 128 + chn * 8);
            const float dk = exp2f(l2g * (float)(255 - (jb * 64 + row)));
            u32x4 o; o.x = cvt_pk_bf16(bf_lo(kw.x) * dk, bf_hi(kw.x) * dk); o.y = cvt_pk_bf16(bf_lo(kw.y) * dk, bf_hi(kw.y) * dk); o.z = cvt_pk_bf16(bf_lo(kw.z) * dk, bf_hi(kw.z) * dk); o.w = cvt_pk_bf16(bf_lo(kw.w) * dk, bf_hi(kw.w) * dk);
            *(LAS u32x4*)(Ks + row * 136 + chn * 8) = o; }
        __syncthreads();
#pragma unroll
        for (int kk = 0; kk < 2; ++kk) {
            bf16x8 af[2];
#pragma unroll
            for (int mt = 0; mt < 2; ++mt) af[mt] = frag_tr(Vs, 264, 32 * kk, 32 * w + 16 * mt, lane);
#pragma unroll
            for (int nt = 0; nt < 8; ++nt) { const bf16x8 bfr = frag_tr(Ks, 136, 32 * kk, 16 * nt, lane);
#pragma unroll
                for (int mt = 0; mt < 2; ++mt) acc[mt][nt] = MFMA16(af[mt], bfr, acc[mt][nt]); }
        }
    }
    float* out = SKV + ((size_t)((b * 8 + h) * 16 + sc)) * 32768;
#pragma unroll
    for (int mt = 0; mt < 2; ++mt)
#pragma unroll
        for (int nt = 0; nt < 8; ++nt)
#pragma unroll
            for (int i = 0; i < 4; ++i) out[(size_t)(32 * w + 16 * mt + 4 * g + i) * 128 + 16 * nt + i16] = acc[mt][nt][i];
}
__device__ __forceinline__ void ret_out_unit(const bf16_t* Z1, const bf16_t* SST, const float* gn_g, bf16_t* Y, ldsp lds, int b, int h, int sc, int half, int tid) {
    const int lane = tid & 63, w = __builtin_amdgcn_readfirstlane(tid >> 6), i16 = lane & 15, g = lane >> 4;
    LAS bf16_t* Vs = (LAS bf16_t*)lds; LAS bf16_t* Ks = (LAS bf16_t*)(lds + 33792);
    const float l2g = ret_log2g(h);
    const int ipos = half * 128 + w * 16 + i16;
    const size_t tok0 = (size_t)b * SEQ + (size_t)sc * 256, tokq = tok0 + ipos;
    bf16x8 qf[4];
#pragma unroll
    for (int ks = 0; ks < 4; ++ks) qf[ks] = *(const bf16x8*)(Z1 + tokq * OD_IN + h * 128 + 32 * ks + 8 * g);
    f32x4 o[16];
#pragma unroll
    for (int et = 0; et < 16; ++et) o[et] = (f32x4){0.f, 0.f, 0.f, 0.f};
    const bf16_t* S = SST + ((size_t)((b * 8 + h) * 16 + sc)) * 32768;
#pragma unroll
    for (int et = 0; et < 16; ++et)
#pragma unroll
        for (int ks = 0; ks < 4; ++ks) { const bf16x8 a = *(const bf16x8*)(S + (size_t)(16 * et + i16) * 128 + 32 * ks + 8 * g); o[et] = MFMA16(a, qf[ks], o[et]); }
    { const float dq = exp2f(l2g * (float)(ipos + 1));
#pragma unroll
      for (int et = 0; et < 16; ++et) o[et] = o[et] * dq; }
    const int nb = 2 * half + 2, myb = 2 * half + (w >> 2);
    for (int jb = 0; jb < nb; ++jb) {
        __syncthreads();
#pragma unroll
        for (int q = 0; q < 4; ++q) { const int idx = tid + 512 * q, row = idx >> 5, chn = idx & 31;
            *(LAS u32x4*)(Vs + row * 264 + chn * 8) = *(const u32x4*)(Z1 + (tok0 + jb * 64 + row) * OD_IN + 2048 + h * 256 + chn * 8); }
#pragma unroll
        for (int q = 0; q < 2; ++q) { const int idx = tid + 512 * q, row = idx >> 4, chn = idx & 15;
            *(LAS u32x4*)(Ks + row * 136 + chn * 8) = *(const u32x4*)(Z1 + (tok0 + jb * 64 + row) * OD_IN + 1024 + h * 128 + chn * 8); }
        __syncthreads();
        if (jb <= myb) {
            f32x4 s[4];
#pragma unroll
            for (int kt = 0; kt < 4; ++kt) { f32x4 a4 = (f32x4){0.f, 0.f, 0.f, 0.f};
#pragma unroll
                for (int ks = 0; ks < 4; ++ks) { const bf16x8 a = *(const LAS bf16x8*)(Ks + (kt * 16 + i16) * 136 + 32 * ks + 8 * g); a4 = MFMA16(a, qf[ks], a4); }
#pragma unroll
                for (int i = 0; i < 4; ++i) { const int j = jb * 64 + kt * 16 + 4 * g + i; const int df = ipos - j; a4[i] = (df >= 0) ? a4[i] * exp2f(l2g * (float)df) : 0.f; }
                s[kt] = a4; }
            const bf16x8 pb0 = pack_frag(s[0], s[1]), pb1 = pack_frag(s[2], s[3]);
#pragma unroll
            for (int et = 0; et < 16; ++et) { o[et] = MFMA16(frag_tr(Vs, 264, 0, 16 * et, lane), pb0, o[et]); o[et] = MFMA16(frag_tr(Vs, 264, 32, 16 * et, lane), pb1, o[et]); }
        }
    }
    float sm = 0.f;
#pragma unroll
    for (int et = 0; et < 16; ++et) sm += (o[et][0] + o[et][1]) + (o[et][2] + o[et][3]);
    sm += __shfl_xor(sm, 16); sm += __shfl_xor(sm, 32);
    const float mean = sm * (1.0f / 256.0f); float vq = 0.f;
#pragma unroll
    for (int et = 0; et < 16; ++et) { const f32x4 dd = o[et] - mean; vq += (dd[0] * dd[0] + dd[1] * dd[1]) + (dd[2] * dd[2] + dd[3] * dd[3]); }
    vq += __shfl_xor(vq, 16); vq += __shfl_xor(vq, 32);
    const float rstd = 1.0f / sqrtf(vq * (1.0f / 256.0f) + GN_EPS);
#pragma unroll
    for (int et = 0; et < 16; ++et) { const int e0 = h * 256 + 16 * et + 4 * g;
        const f32x4 gn = *(const f32x4*)(gn_g + e0); const u32x2 gw = *(const u32x2*)(Z1 + tokq * OD_IN + 4096 + e0);
        const float y0 = (o[et][0] - mean) * rstd * gn[0] * siluf_(bf_lo(gw.x)), y1 = (o[et][1] - mean) * rstd * gn[1] * siluf_(bf_hi(gw.x));
        const float y2 = (o[et][2] - mean) * rstd * gn[2] * siluf_(bf_lo(gw.y)), y3 = (o[et][3] - mean) * rstd * gn[3] * siluf_(bf_hi(gw.y));
        u32x2 ov; ov.x = cvt_pk_bf16(y0, y1); ov.y = cvt_pk_bf16(y2, y3); *(u32x2*)(Y + tokq * 2048 + e0) = ov; }
}
enum InIdx { I_X = 0, I_P, I_RELB, I_MIXG, I_FFNG, I_PLEG, I_EVWIN, I_CONVW, I_CONVB, I_WA, I_BA, I_WX, I_BX, I_LAM, I_QG, I_KG, I_EVWOUT, I_ODWIN, I_GNG, I_ODWOUT,
             I_WGROUP, I_WEXPERT, I_WGATE, I_WUP, I_WDOWN, I_PLEUP, I_PLEGATE, N_IN };
struct Args { const float* in[N_IN]; float* out; unsigned char* ws; int ph_lo, ph_hi; };
static_assert(sizeof(Args) == N_IN * 8 + 8 + 8 + 8, "Args has no padding");
constexpr int N_PHASES = 24;

__global__ void __launch_bounds__(512, 2) mk_fwd(Args args) {
    extern __shared__ __attribute__((aligned(16))) unsigned char lds_raw[];
    const ldsp lds = (ldsp)lds_raw;
    volatile LAS unsigned* MISC = (volatile LAS unsigned*)(lds + LDS_MISC_OFF);
    const int tid = threadIdx.x, lane = tid & 63, wave = __builtin_amdgcn_readfirstlane(tid >> 6);
    const int G = gridDim.x, bid = blockIdx.x;
    const int gw = bid * 8 + wave, ngw = G * 8;
    unsigned char* ws0 = args.ws;
#define FRESH_WS() unsigned char* ws = ws0; asm volatile("" : "+s"(ws))
    for (int u = tid; u < 64; u += 512) MISC[u] = 0u;
    __syncthreads();
#if MK_N_LAUNCHES == 1
    XcdBarrier bar = xcd_barrier_post((unsigned*)(ws0 + WS_CTL) + CW_BAR, MISC + 8);
#define GRID_BAR() xcd_barrier(bar)
#else
#define GRID_BAR() do { } while (0)
#endif
    const int lo = args.ph_lo, hi = args.ph_hi;
#ifndef ONLY_PHASE
#define ONLY_PHASE (-1)
#endif
#define IN(k) ((ONLY_PHASE < 0 || ONLY_PHASE == (k)) && lo <= (k) && (k) < hi)
#define SEAM(k) do { if (IN(k) && IN((k) + 1)) GRID_BAR(); } while (0)

    const float* x = args.in[I_X]; float* hbuf = args.out;
#define XN ((bf16_t*)(ws + WS_XN))
#define PB ((bf16_t*)(ws + WS_PB))
#define ERAW ((bf16_t*)(ws + WS_ERAW))
#define ESS ((float*)(ws + MS_ESS))
#define ERSTD ((float*)(ws + MS_ERSTD))
#define Z ((bf16_t*)(ws + WS_Z))
#define Y ((bf16_t*)(ws + WS_Y))
#define ROPE ((float*)(ws + WS_ROPE))
#define RT ((float*)(ws + WS_RT))
#define W_GU ((bf16_t*)(ws + WS_W_GU))
#define W_DN ((bf16_t*)(ws + WS_W_DN))
    LAS float* scr = (LAS float*)(lds + wave * 16640);

    if (IN(0)) { FRESH_WS();
        tr_matrix<0>(args.in[I_EVWIN], nullptr, D, EV_IN, (bf16_t*)(ws + WS_W_EVIN), EV_INP, scr, lane, gw, ngw);
        tr_matrix<0>(args.in[I_EVWOUT], nullptr, D, D, (bf16_t*)(ws + WS_W_EVOUT), D, scr, lane, gw, ngw);
        tr_matrix<1>(args.in[I_ODWIN], nullptr, D, OD_IN, (bf16_t*)(ws + WS_W_ODIN), OD_IN, scr, lane, gw, ngw);
        tr_matrix<0>(args.in[I_ODWOUT], nullptr, 2048, D, (bf16_t*)(ws + WS_W_ODOUT), D, scr, lane, gw, ngw);
        for (int l = 0; l < 2; ++l) {
            tr_matrix<0>(args.in[I_PLEUP] + (size_t)l * PLE * D, nullptr, PLE, D, (bf16_t*)(ws + WS_W_PLEUP) + (size_t)l * D * PLE, D, scr, lane, gw, ngw);
            tr_matrix<0>(args.in[I_PLEGATE] + (size_t)l * D * D, nullptr, D, D, (bf16_t*)(ws + WS_W_PLEGATE) + (size_t)l * D * D, D, scr, lane, gw, ngw); }
        convert_moe_layer(args.in[I_WGATE], args.in[I_WUP], args.in[I_WDOWN], W_GU, W_DN, scr, lane, gw, ngw);
        for (int m = gw; m < M; m += ngw) rms_row_to_bf16(x + (size_t)m * D, args.in[I_MIXG], XN + (size_t)m * D, lane);
        { const float* p = args.in[I_P]; const size_t n4 = (size_t)2 * M * PLE / 4;
          for (size_t i = (size_t)bid * 512 + tid; i < n4; i += (size_t)G * 512) { const f32x4 v = ((const f32x4*)p)[i]; u32x2 o; o.x = cvt_pk_bf16(v[0], v[1]); o.y = cvt_pk_bf16(v[2], v[3]); ((u32x2*)PB)[i] = o; } }
        for (int i = bid * 512 + tid; i < SEQ * 64; i += G * 512) { const int pos = i >> 6, f = i & 63;
            const float inv = powf(10000.0f, -(float)f / 64.0f); const float ang = (float)pos * inv; ROPE[i] = cosf(ang); ROPE[SEQ * 64 + i] = sinf(ang); }
        for (int i = bid * 512 + tid; i < 2 * 36 * D; i += G * 512) { const int l = i / (36 * D), r = i % (36 * D), o = r / D, k = r % D;
            RT[i] = (o < 4) ? args.in[I_WGROUP][(size_t)l * D * 4 + k * 4 + o] : args.in[I_WEXPERT][(size_t)l * D * 32 + k * 32 + (o - 4)]; }
    }
    SEAM(0);
    if (IN(1)) { FRESH_WS();
        { pg8::Gemm gm{XN, (const bf16_t*)(ws + WS_W_EVIN), M, EV_INP, D}; pg8::StaticOrder S; S.init(M, EV_INP, G, bid); EpiPlainBf16<EV_INP, 13> E{Z};
          pg8::gemm_phase<EpiPlainBf16<EV_INP, 13>, pg8::StaticOrder>(lds, gm, S, E, nullptr); }
        __syncthreads();
        { pg8::Gemm gm{PB, (const bf16_t*)(ws + WS_W_PLEUP), M, D, PLE}; pg8::StaticOrder S; S.init(M, D, G, bid); EpiPleUp E{ERAW, ESS};
          pg8::gemm_phase<EpiPleUp, pg8::StaticOrder>(lds, gm, S, E, nullptr); }
    }
    SEAM(1);
    if (IN(2)) { FRESH_WS();
        for (int u = bid; u < 256; u += G)
            lru_local_unit(Z, args.in[I_CONVW], args.in[I_CONVB], args.in[I_WA], args.in[I_BA], args.in[I_WX], args.in[I_BX], args.in[I_LAM],
                           (float*)(ws + WS_HLOC), (float*)(ws + WS_PCUM), (float*)(ws + MS_SUMA), (float*)(ws + MS_SUMH), lds, u >> 6, u & 63, tid);
        for (int m = gw; m < M; m += ngw) dsa_prep_token(Z, args.in[I_QG], args.in[I_KG], (size_t)m, lane);
    }
    SEAM(2);
    if (IN(3)) { FRESH_WS();
        for (int idx = bid; idx < 1024; idx += G) { const int r = idx >> 8, v = idx & 255; const int qt = (r & 1) ? 255 - v : v;
            dsa_select_unit(Z, (unsigned*)(ws + WS_MASK), lds, r, qt, tid); }
    }
    SEAM(3);
    if (IN(4)) { FRESH_WS();
        for (int idx = bid; idx < 1024; idx += G) { const int r = idx >> 8, v = idx & 255; const int bh = r * 8 + (v >> 5); const int qt = (r & 1) ? 31 - (v & 31) : (v & 31);
            dsa_attn_unit(Z, (const unsigned*)(ws + WS_MASK), args.in[I_RELB], Y, lds, bh >> 3, bh & 7, qt, tid); }
        for (int u = bid; u < 256; u += G)
            lru_fix_unit(Z, (const float*)(ws + WS_HLOC), (const float*)(ws + WS_PCUM), (const float*)(ws + MS_SUMA), (const float*)(ws + MS_SUMH), Y, u >> 6, u & 63, tid);
    }
    SEAM(4);
    if (IN(5)) { FRESH_WS();
        __syncthreads();
        pg8::Gemm gm{Y, (const bf16_t*)(ws + WS_W_EVOUT), M, D, D}; pg8::StaticOrder S; S.init(M, D, G, bid); EpiResid E{x, hbuf};
        pg8::gemm_phase<EpiResid, pg8::StaticOrder>(lds, gm, S, E, nullptr);
    }
    SEAM(5);
    if (IN(6 + 0)) { FRESH_WS();
        __syncthreads();
        if (false) convert_moe_layer(args.in[I_WGATE] + (size_t)NEXP * D * FF, args.in[I_WUP] + (size_t)NEXP * D * FF, args.in[I_WDOWN] + (size_t)NEXP * FF * D, W_GU, W_DN, scr, lane, gw, ngw);
        for (int vb = bid; vb < 256; vb += G)
            moe_route_block(hbuf, args.in[I_FFNG] + 0 * D, RT + (size_t)0 * 36 * D, XN, (unsigned*)(ws + MS_RE), (f32x2*)(ws + MS_RW), (unsigned*)(ws + MS_CNT), lds, vb, tid);
    }
    SEAM(6 + 0);
    if (IN(6 + 1)) { FRESH_WS(); for (int vb = bid; vb < 256; vb += G) moe_scatter_block((const unsigned*)(ws + MS_RE), (const unsigned*)(ws + MS_CNT), XN, (bf16_t*)(ws + WS_XS), (unsigned*)(ws + MS_SLOT), (int*)(ws + MS_TILEE), lds, vb, tid); }
    SEAM(6 + 1);
    if (IN(6 + 2)) { FRESH_WS();
        __syncthreads();
        pg8::Gemm gm{(const bf16_t*)(ws + WS_XS), W_GU, MOE_ROWS, NEXP * 1024, D}; MoeOrder S; S.init((const int*)(ws + MS_TILEE), G, bid); EpiSwiglu E{Y};
        pg8::gemm_phase<EpiSwiglu, MoeOrder>(lds, gm, S, E, nullptr);
    }
    SEAM(6 + 2);
    if (IN(6 + 3)) { FRESH_WS();
        __syncthreads();
        pg8::Gemm gm{Y, W_DN, MOE_ROWS, NEXP * 1024, FF}; MoeOrder S; S.init((const int*)(ws + MS_TILEE), G, bid); EpiPlainBf16<D, 4> E{(bf16_t*)(ws + WS_YD)};
        pg8::gemm_phase<EpiPlainBf16<D, 4>, MoeOrder>(lds, gm, S, E, nullptr);
    }
    SEAM(6 + 3);
    if (IN(6 + 4)) { FRESH_WS(); for (int m = gw; m < M; m += ngw) moe_combine_token(hbuf, (const bf16_t*)(ws + WS_YD), (const unsigned*)(ws + MS_SLOT), (const f32x2*)(ws + MS_RW), XN, ESS, ERSTD, (size_t)m, lane); }
    SEAM(6 + 4);
    if (IN(6 + 5)) { FRESH_WS();
        __syncthreads();
        pg8::Gemm gm{XN, (const bf16_t*)(ws + WS_W_PLEGATE) + (size_t)0 * D * D, M, D, D}; pg8::StaticOrder S; S.init(M, D, G, bid); EpiPleGate E{hbuf, ERAW, ERSTD, args.in[I_PLEG] + 0 * D};
        pg8::gemm_phase<EpiPleGate, pg8::StaticOrder>(lds, gm, S, E, nullptr);
    }
    SEAM(11);
        if (IN(12)) { FRESH_WS(); for (int m = gw; m < M; m += ngw) rms_row_to_bf16(hbuf + (size_t)m * D, args.in[I_MIXG] + D, XN + (size_t)m * D, lane); }
        SEAM(12);
        if (IN(13)) { FRESH_WS();
            __syncthreads();
            { pg8::Gemm gm{XN, (const bf16_t*)(ws + WS_W_ODIN), M, OD_IN, D}; pg8::StaticOrder S; S.init(M, OD_IN, G, bid); EpiRet E{Z, ROPE};
              pg8::gemm_phase<EpiRet, pg8::StaticOrder>(lds, gm, S, E, nullptr); }
            __syncthreads();
            { pg8::Gemm gm{PB + (size_t)M * PLE, (const bf16_t*)(ws + WS_W_PLEUP) + (size_t)D * PLE, M, D, PLE}; pg8::StaticOrder S; S.init(M, D, G, bid); EpiPleUp E{ERAW, ESS};
              pg8::gemm_phase<EpiPleUp, pg8::StaticOrder>(lds, gm, S, E, nullptr); }
        }
        SEAM(13);
        if (IN(14)) { FRESH_WS(); for (int u = bid; u < 512; u += G) ret_kv_unit(Z, (float*)(ws + WS_W_GU), lds, u >> 7, (u >> 4) & 7, u & 15, tid); }
        SEAM(14);
        if (IN(15)) { FRESH_WS();
            const float* SKV = (const float*)(ws + WS_W_GU); bf16_t* SST = (bf16_t*)(ws + WS_W_DN);
            for (int i = bid * 512 + tid; i < 32 * 32768; i += G * 512) { const int bh = i >> 15, el = i & 32767; const float g256 = exp2f(ret_log2g(bh & 7) * 256.0f); float run = 0.f;
#pragma unroll 4
                for (int sc = 0; sc < 16; ++sc) { const size_t o = ((size_t)(bh * 16 + sc)) * 32768 + el; const float v = SKV[o]; SST[o] = (bf16_t)(cvt_pk_bf16(run, 0.f) & 0xffffu); run = run * g256 + v; } }
        }
        SEAM(15);
        if (IN(16)) { FRESH_WS();
            for (int idx = bid; idx < 1024; idx += G) { const int r = idx >> 8, v = idx & 255; const int half = r & 1; const int u = (r >> 1) * 256 + v;
                ret_out_unit(Z, (const bf16_t*)(ws + WS_W_DN), args.in[I_GNG], Y, lds, u >> 7, (u >> 4) & 7, u & 15, 1 - half, tid); }
        }
        SEAM(16);
        if (IN(17)) { FRESH_WS();
            __syncthreads();
            pg8::Gemm gm{Y, (const bf16_t*)(ws + WS_W_ODOUT), M, D, 2048}; pg8::StaticOrder S; S.init(M, D, G, bid); EpiResid E{hbuf, hbuf};
            pg8::gemm_phase<EpiResid, pg8::StaticOrder>(lds, gm, S, E, nullptr);
        }
        SEAM(17);
    if (IN(18 + 0)) { FRESH_WS();
        __syncthreads();
        convert_moe_layer(args.in[I_WGATE] + (size_t)NEXP * D * FF, args.in[I_WUP] + (size_t)NEXP * D * FF, args.in[I_WDOWN] + (size_t)NEXP * FF * D, W_GU, W_DN, scr, lane, gw, ngw);
        for (int vb = bid; vb < 256; vb += G)
            moe_route_block(hbuf, args.in[I_FFNG] + 1 * D, RT + (size_t)1 * 36 * D, XN, (unsigned*)(ws + MS_RE), (f32x2*)(ws + MS_RW), (unsigned*)(ws + MS_CNT), lds, vb, tid);
    }
    SEAM(18 + 0);
    if (IN(18 + 1)) { FRESH_WS(); for (int vb = bid; vb < 256; vb += G) moe_scatter_block((const unsigned*)(ws + MS_RE), (const unsigned*)(ws + MS_CNT), XN, (bf16_t*)(ws + WS_XS), (unsigned*)(ws + MS_SLOT), (int*)(ws + MS_TILEE), lds, vb, tid); }
    SEAM(18 + 1);
    if (IN(18 + 2)) { FRESH_WS();
        __syncthreads();
        pg8::Gemm gm{(const bf16_t*)(ws + WS_XS), W_GU, MOE_ROWS, NEXP * 1024, D}; MoeOrder S; S.init((const int*)(ws + MS_TILEE), G, bid); EpiSwiglu E{Y};
        pg8::gemm_phase<EpiSwiglu, MoeOrder>(lds, gm, S, E, nullptr);
    }
    SEAM(18 + 2);
    if (IN(18 + 3)) { FRESH_WS();
        __syncthreads();
        pg8::Gemm gm{Y, W_DN, MOE_ROWS, NEXP * 1024, FF}; MoeOrder S; S.init((const int*)(ws + MS_TILEE), G, bid); EpiPlainBf16<D, 4> E{(bf16_t*)(ws + WS_YD)};
        pg8::gemm_phase<EpiPlainBf16<D, 4>, MoeOrder>(lds, gm, S, E, nullptr);
    }
    SEAM(18 + 3);
    if (IN(18 + 4)) { FRESH_WS(); for (int m = gw; m < M; m += ngw) moe_combine_token(hbuf, (const bf16_t*)(ws + WS_YD), (const unsigned*)(ws + MS_SLOT), (const f32x2*)(ws + MS_RW), XN, ESS, ERSTD, (size_t)m, lane); }
    SEAM(18 + 4);
    if (IN(18 + 5)) { FRESH_WS();
        __syncthreads();
        pg8::Gemm gm{XN, (const bf16_t*)(ws + WS_W_PLEGATE) + (size_t)1 * D * D, M, D, D}; pg8::StaticOrder S; S.init(M, D, G, bid); EpiPleGate E{hbuf, ERAW, ERSTD, args.in[I_PLEG] + 1 * D};
        pg8::gemm_phase<EpiPleGate, pg8::StaticOrder>(lds, gm, S, E, nullptr);
    }
}

extern "C" void kernel_launch(void* const* d_in, const int* in_sizes, int n_in, void* d_out, int out_size, void* d_ws, size_t ws_size, hipStream_t stream) {
    static int grid = 0;
    if (grid == 0) {
        if (n_in != N_IN || out_size != M * D || ws_size < WS_END) { fprintf(stderr, "kernel_launch: unexpected problem (n_in %d, out %d, ws %zu)\n", n_in, out_size, ws_size); grid = -1; return; }
        int dev = 0, cus = 0, per_cu = 0;
        if (hipGetDevice(&dev) != hipSuccess || hipDeviceGetAttribute(&cus, hipDeviceAttributeMultiprocessorCount, dev) != hipSuccess) { grid = -1; return; }
        if (hipFuncSetAttribute((const void*)mk_fwd, hipFuncAttributeMaxDynamicSharedMemorySize, LDS_BYTES) != hipSuccess) { fprintf(stderr, "kernel_launch: hipFuncSetAttribute failed\n"); grid = -1; return; }
        if (hipOccupancyMaxActiveBlocksPerMultiprocessor(&per_cu, (const void*)mk_fwd, 512, LDS_BYTES) != hipSuccess || per_cu < 1) fprintf(stderr, "kernel_launch: occupancy query reports %d\n", per_cu);
        (void)hipGetLastError();
        grid = cus;
    }
    if (grid < 0) return;
    (void)hipMemsetAsync((char*)d_ws + WS_CTL, 0, CTL_ZERO_BYTES, stream);
    Args a{};
    for (int i = 0; i < N_IN; ++i) a.in[i] = (const float*)d_in[i];
    a.out = (float*)d_out; a.ws = (unsigned char*)d_ws;
#if MK_N_LAUNCHES == 1
    a.ph_lo = 0; a.ph_hi = N_PHASES;
    hipLaunchKernelGGL(mk_fwd, dim3(grid), dim3(512), LDS_BYTES, stream, a);
#else
    for (int p = 0; p < N_PHASES; ++p) { a.ph_lo = p; a.ph_hi = p + 1; hipLaunchKernelGGL(mk_fwd, dim3(grid), dim3(512), LDS_BYTES, stream, a); }
#endif
}
```

```cpp
#include <hip/hip_runtime.h>
#include <cstdio>
#include <cstdint>

#define GAS __attribute__((address_space(1)))
#define LAS __attribute__((address_space(3)))
#ifndef MK_N_LAUNCHES
#define MK_N_LAUNCHES 1
#endif

constexpr int D = 1024, BATCH = 4, SEQ = 4096, M = BATCH * SEQ, PLE = 256;
constexpr int EV_IN = 3144, EV_INP = 3328;
constexpr int OD_IN = 6144;
constexpr int ZC_XA = 0, ZC_GA = 512, ZC_Q = 1024, ZC_K = 1536, ZC_V = 2048, ZC_IQ = 2560, ZC_IK = 3072, ZC_IW = 3136;
constexpr int NEXP = 32, FF = 512;
constexpr int MOE_ROWS = 40960, MOE_TILES = 160;
constexpr float RMS_EPS = 1e-6f, GN_EPS = 1e-5f;
constexpr float LOG2E = 1.4426950408889634f;

constexpr size_t MiB = 1u << 20;
constexpr size_t WS_CTL = 0, CTL_ZERO_BYTES = 1 * MiB;
constexpr size_t WS_RT = 1 * MiB;
constexpr size_t WS_ROPE = 2 * MiB;
constexpr size_t WS_W_EVIN = 4 * MiB;
constexpr size_t WS_W_EVOUT = 11 * MiB;
constexpr size_t WS_W_ODIN = 13 * MiB;
constexpr size_t WS_W_ODOUT = 25 * MiB;
constexpr size_t WS_W_PLEUP = 29 * MiB;
constexpr size_t WS_W_PLEGATE = 30 * MiB;
constexpr size_t WS_W_GU = 34 * MiB;
constexpr size_t WS_W_DN = 98 * MiB;
constexpr size_t WS_XN = 130 * MiB;
constexpr size_t WS_PB = 162 * MiB;
constexpr size_t WS_ERAW = 178 * MiB;
constexpr size_t WS_MISC = 210 * MiB;
constexpr size_t WS_MASK = 214 * MiB;
constexpr size_t WS_Y = 222 * MiB;
constexpr size_t WS_Z = 286 * MiB;
constexpr size_t WS_XS = WS_Z, WS_YD = WS_Z + 80 * MiB;
constexpr size_t WS_HLOC = WS_Z + 104 * MiB, WS_PCUM = WS_HLOC + 32 * MiB;
constexpr size_t WS_END = 478 * MiB;
constexpr size_t MS_ESS = WS_MISC, MS_ERSTD = WS_MISC + 1 * MiB, MS_RE = MS_ERSTD + 65536, MS_RW = MS_RE + 65536, MS_SLOT = MS_RW + 131072, MS_CNT = MS_SLOT + 131072,
                 MS_TILEE = MS_CNT + 32768, MS_SUMA = MS_TILEE + 4096, MS_SUMH = MS_SUMA + 524288;
static_assert(MS_SUMH + 524288 <= WS_MASK, "misc map");
constexpr int CW_BAR = 4096;

constexpr int LDS_BYTES = 147456;
constexpr int LDS_MISC_OFF = 144 * 1024 - 256;

typedef unsigned short bf16_t;
typedef short bf16x8 __attribute__((ext_vector_type(8)));
typedef short s16x4 __attribute__((ext_vector_type(4)));
typedef float f32x4 __attribute__((ext_vector_type(4)));
typedef float f32x2 __attribute__((ext_vector_type(2)));
typedef unsigned u32x4 __attribute__((ext_vector_type(4)));
typedef unsigned u32x2 __attribute__((ext_vector_type(2)));
typedef LAS unsigned char* ldsp;
namespace pg8 {
#define PG8_LAS __attribute__((address_space(3)))
typedef unsigned short bf16_t;
typedef short bf16x8 __attribute__((ext_vector_type(8)));
typedef float f32x4 __attribute__((ext_vector_type(4)));
typedef unsigned u32x4 __attribute__((ext_vector_type(4)));
constexpr int BM = 256, BK = 64, HALF = 128, HTB = HALF * BK * 2  , STAGE_BYTES = 8 * HTB, NXCD = 8, WGM = 8;

__host__ __device__ __forceinline__ int lds_byte(int r, int c) { const int st = (r >> 4) * 2 + (c >> 5), rr = r & 15, cc = c & 31, ob = rr * 64 + cc * 2; return st * 1024 + (ob ^ (((ob >> 9) & 1) << 5)); }
__host__ __device__ __forceinline__ void stage_rc(int b, int& R, int& C) { const int st = b / 1024, sb = b % 1024, swz = sb ^ (((sb >> 9) & 1) << 5); R = (st >> 1) * 16 + swz / 64; C = (st & 1) * 32 + (swz % 64) / 2; }
__host__ __device__ __forceinline__ int perm32(int rho) { const int n = rho >> 4, i = rho & 15; return 8 * (i >> 2) + 4 * n + (i & 3); }

struct Unit { int pm, pn; };
struct Gemm { const bf16_t* A; const bf16_t* Bt; int M, N, K; };

struct StaticOrder {
    int nM, nN, nwg, G, c;
    __host__ __device__ void init(int M, int N, int G_, int c_) { nM = M / BM; nN = N / BM; nwg = nM * nN; G = G_; c = c_; }
    __host__ __device__ bool next(int i, Unit& u) const {
        const long L = (long)i * G + c; if (L >= nwg) return false;
        int wgid = (int)L; { const int q = nwg / NXCD, r = nwg % NXCD, xcd = wgid % NXCD, off = wgid / NXCD; wgid = (xcd < r ? xcd * (q + 1) : r * (q + 1) + (xcd - r) * q) + off; }
        const int nig = WGM * nN, gid = wgid / nig, fm = gid * WGM, gsz = (nM - fm) < WGM ? (nM - fm) : WGM;
        u.pm = fm + ((wgid % nig) % gsz); u.pn = (wgid % nig) / gsz; return true;
    }
    __device__ __forceinline__ void a_ready(const Unit&) const {}
    __device__ __forceinline__ void done(const Unit&) const {}
};
__device__ __forceinline__ unsigned cvt_pk_bf16(float lo, float hi) { unsigned r; asm volatile("v_cvt_pk_bf16_f32 %0, %1, %2" : "=v"(r) : "v"(lo), "v"(hi)); return r; }
template <class Epi, class Sched, bool STAMP = false>
__device__ __forceinline__ void gemm_phase(PG8_LAS unsigned char* lds, const Gemm g, const Sched& S, const Epi& E, unsigned long long* stamps) {
    const int tid = threadIdx.x, wid = __builtin_amdgcn_readfirstlane(tid >> 6), lane = tid & 63, wr = wid >> 2, wc = wid & 3, fr = lane & 15, fq = lane >> 4;
    const int K = g.K, nt = K / BK;
    int ts_lo = 0, ts_hi = 0, nts = 0; const unsigned long long rt_entry = STAMP ? (unsigned long long)wall_clock64() : 0ull;
#define PG8_STAMP() do { if (STAMP && wid == 0 && nts < 64) { const unsigned long long _c = (unsigned long long)clock64(); \
        ts_lo = (lane == nts) ? (int)(unsigned)_c : ts_lo; ts_hi = (lane == nts) ? (int)(unsigned)(_c >> 32) : ts_hi; ++nts; } } while (0)
    PG8_STAMP();
    unsigned voffA[2], voffB[2];
#pragma unroll
    for (int i = 0; i < 2; ++i) { int R, C; stage_rc(tid * 16 + i * 8192, R, C); const int Rb = Epi::PERM ? ((R & ~31) + perm32(R & 31)) : R;
        voffA[i] = (unsigned)(R * K + C) * 2u; voffB[i] = (unsigned)(Rb * K + C) * 2u; }
    const size_t kstep = (size_t)(BK * 2);
    const size_t hstep = (size_t)HALF * K * 2;
    const size_t tstep = 2 * hstep;
    const unsigned ldsw = (unsigned)wid * 1024u;
    const int aoff = lds_byte(wr * 64 + fr, fq * 8), boff = lds_byte(wc * 32 + fr, fq * 8);
#define PG8_SA(b, h) (((b) * 2 + (h)) * HTB)
#define PG8_SB(b, h) ((4 + (b) * 2 + (h)) * HTB)
#define PG8_STAGE(bufoff, gbase, voff) do { _Pragma("unroll") for (int _i = 0; _i < 2; ++_i) \
        __builtin_amdgcn_global_load_lds((const unsigned*)((const char*)(gbase) + (voff)[_i]), (PG8_LAS unsigned*)(lds + (bufoff) + ldsw + _i * 8192), 16, 0, 0); } while (0)
#define PG8_LDA(dst, b, h) do { _Pragma("unroll") for (int m = 0; m < 4; ++m) _Pragma("unroll") for (int k = 0; k < 2; ++k) dst[m][k] = *(const PG8_LAS bf16x8*)(lds + PG8_SA(b, h) + aoff + m * 2048 + k * 1024); } while (0)
#define PG8_LDB(dst, b, h) do { _Pragma("unroll") for (int n = 0; n < 2; ++n) _Pragma("unroll") for (int k = 0; k < 2; ++k) dst[n][k] = *(const PG8_LAS bf16x8*)(lds + PG8_SB(b, h) + boff + n * 2048 + k * 1024); } while (0)
#define PG8_MMA(ai, bj, At, Bt) do { __builtin_amdgcn_s_setprio(1); _Pragma("unroll") for (int m = 0; m < 4; ++m) _Pragma("unroll") for (int n = 0; n < 2; ++n) _Pragma("unroll") for (int k = 0; k < 2; ++k) \
        acc[ai][bj][m][n] = __builtin_amdgcn_mfma_f32_16x16x32_bf16(Bt[n][k], At[m][k], acc[ai][bj][m][n], 0, 0, 0); __builtin_amdgcn_s_setprio(0); } while (0)
#define PG8_WAIT_V(n) asm volatile("s_waitcnt vmcnt(" #n ")" ::: "memory")
#define PG8_WAIT_L(n) asm volatile("s_waitcnt lgkmcnt(" #n ")" ::: "memory")
#define PG8_BAR __builtin_amdgcn_s_barrier()
#define PG8_SCHED __builtin_amdgcn_sched_barrier(0)
    Unit cur, nxt; int ui = 0;
    if (!S.next(0, cur)) return;
    f32x4 acc[2][2][4][2];
#pragma unroll
    for (int a = 0; a < 2; ++a)
#pragma unroll
        for (int b = 0; b < 2; ++b)
#pragma unroll
            for (int m = 0; m < 4; ++m)
#pragma unroll
                for (int n = 0; n < 2; ++n) acc[a][b][m][n] = (f32x4){0.f, 0.f, 0.f, 0.f};
    bf16x8 At[4][2], B0[2][2], B1[2][2];
    const char* cA = (const char*)g.A + (size_t)cur.pm * tstep; const char* cB = (const char*)g.Bt + (size_t)cur.pn * tstep;
    S.a_ready(cur);
    PG8_STAGE(PG8_SB(0, 0), cB, voffB); PG8_STAGE(PG8_SA(0, 0), cA, voffA); PG8_STAGE(PG8_SB(0, 1), cB + hstep, voffB); PG8_STAGE(PG8_SA(0, 1), cA + hstep, voffA);
    if (wr == 1) PG8_BAR;
    PG8_WAIT_V(4); PG8_BAR;
    PG8_STAGE(PG8_SB(1, 0), cB + kstep, voffB); PG8_STAGE(PG8_SA(1, 0), cA + kstep, voffA); PG8_STAGE(PG8_SB(1, 1), cB + hstep + kstep, voffB);
    PG8_WAIT_V(6); PG8_BAR;
    PG8_STAMP();
    for (;;) {
        const bool has_next = S.next(ui + 1, nxt);
        const char* nA = has_next ? (const char*)g.A + (size_t)nxt.pm * tstep : cA; const char* nB = has_next ? (const char*)g.Bt + (size_t)nxt.pn * tstep : cB;
        for (int t = 0; t < nt; t += 2) {
            const bool last = (t == nt - 2);
            const char* a1 = cA + (size_t)(t + 1) * kstep;
            const char* a2 = last ? nA : cA + (size_t)(t + 2) * kstep; const char* b2 = last ? nB : cB + (size_t)(t + 2) * kstep;
            const char* a3 = a2 + kstep; const char* b3 = b2 + kstep;
            if (last && has_next) S.a_ready(nxt);
            PG8_LDB(B0, 0, 0); PG8_SCHED; PG8_LDA(At, 0, 0); PG8_STAGE(PG8_SA(1, 1), a1 + hstep, voffA);
            PG8_WAIT_L(8); PG8_BAR; PG8_WAIT_L(0); PG8_MMA(0, 0, At, B0); PG8_BAR; PG8_SCHED;
            PG8_LDB(B1, 0, 1); PG8_STAGE(PG8_SB(0, 0), b2, voffB);
            PG8_BAR; PG8_WAIT_L(0); PG8_MMA(0, 1, At, B1); PG8_BAR;
            PG8_LDA(At, 0, 1); PG8_STAGE(PG8_SA(0, 0), a2, voffA);
            PG8_BAR; PG8_WAIT_L(0); PG8_MMA(1, 0, At, B0); PG8_BAR; PG8_SCHED;
            PG8_STAGE(PG8_SB(0, 1), b2 + hstep, voffB);
            PG8_WAIT_V(6); PG8_BAR; PG8_MMA(1, 1, At, B1); PG8_BAR;
            PG8_LDB(B0, 1, 0); PG8_SCHED; PG8_LDA(At, 1, 0); PG8_STAGE(PG8_SA(0, 1), a2 + hstep, voffA);
            PG8_WAIT_L(8); PG8_BAR; PG8_WAIT_L(0); PG8_MMA(0, 0, At, B0); PG8_BAR; PG8_SCHED;
            PG8_LDB(B1, 1, 1); PG8_STAGE(PG8_SB(1, 0), b3, voffB);
            PG8_BAR; PG8_WAIT_L(0); PG8_MMA(0, 1, At, B1); PG8_BAR;
            PG8_LDA(At, 1, 1); PG8_STAGE(PG8_SA(1, 0), a3, voffA);
            PG8_BAR; PG8_WAIT_L(0); PG8_MMA(1, 0, At, B0); PG8_BAR; PG8_SCHED;
            PG8_STAGE(PG8_SB(1, 1), b3 + hstep, voffB);
            PG8_WAIT_V(6); PG8_BAR; PG8_MMA(1, 1, At, B1); PG8_BAR;
        }
        PG8_STAMP();
        if constexpr (!Epi::AFTER_DRAIN) { E(acc, cur, wr, wc, fr, fq); S.done(cur); }
        PG8_STAMP();
        if (!has_next) break;
#pragma unroll
        for (int a = 0; a < 2; ++a)
#pragma unroll
            for (int b = 0; b < 2; ++b)
#pragma unroll
                for (int m = 0; m < 4; ++m)
#pragma unroll
                    for (int n = 0; n < 2; ++n) acc[a][b][m][n] = (f32x4){0.f, 0.f, 0.f, 0.f};
        cur = nxt; cA = nA; cB = nB; ++ui;
    }
    PG8_WAIT_V(0);
    if (wr == 0) PG8_BAR;
    PG8_BAR;
    if constexpr (Epi::AFTER_DRAIN) { E.fused(acc, cur, wr, wc, fr, fq, lds, wid, lane); S.done(cur); }
    PG8_STAMP();
    if (STAMP && wid == 0) { stamps[lane] = lane < nts ? (((unsigned long long)(unsigned)ts_hi << 32) | (unsigned)ts_lo) : 0ull;
        if (lane == 62) stamps[62] = rt_entry; if (lane == 63) stamps[63] = (unsigned long long)wall_clock64(); }
#undef PG8_STAMP
#undef PG8_SA
#undef PG8_SB
#undef PG8_STAGE
#undef PG8_LDA
#undef PG8_LDB
#undef PG8_MMA
#undef PG8_WAIT_V
#undef PG8_WAIT_L
#undef PG8_BAR
#undef PG8_SCHED
}
}
#define XB_TMO      128
#define XB_XCNT(j)  (256  + 64 * (j))
#define XB_XSUB(j)  (1280 + 64 * (j))
#define XB_XGEN(j)  (2304 + 64 * (j))
#define XB_TOP      3328
#define XB_TOPGEN   3392
#define XCD_BAR_WORDS 3456
#define XB_SPIN_CAP (1u << 18)
__device__ __forceinline__ unsigned xb_ld(unsigned* p)              { return __hip_atomic_load(p, __ATOMIC_RELAXED, __HIP_MEMORY_SCOPE_AGENT); }
__device__ __forceinline__ unsigned xb_add(unsigned* p, unsigned v) { return __hip_atomic_fetch_add(p, v, __ATOMIC_RELAXED, __HIP_MEMORY_SCOPE_AGENT); }
__device__ __forceinline__ unsigned xb_xcc_id() { return (unsigned)__builtin_amdgcn_s_getreg((3 << 11) | 20) & 0xFu; }
#define XB_SPIN(cond, bar) do { unsigned _sp = 0; while (cond) { __builtin_amdgcn_s_sleep(1); \
    if ((++_sp & 255u) == 0u) { if (xb_ld(&(bar)[XB_TMO])) break; if (_sp > XB_SPIN_CAP) { atomicAdd(&(bar)[XB_TMO], 1u); break; } } } } while (0)

struct XcdBarrier {
    unsigned* bar; unsigned x;
    volatile LAS unsigned* st;
};

__device__ __forceinline__ XcdBarrier xcd_barrier_post(unsigned* bar, volatile LAS unsigned* st) {
    XcdBarrier b; b.bar = bar; b.x = xb_xcc_id(); b.st = st;
    if (threadIdx.x == 0) (void)xb_add(&bar[XB_XCNT(b.x)], 1u);
    return b;
}
__device__ __forceinline__ void xcd_barrier_complete(unsigned* bar, unsigned x, unsigned& nloc, unsigned& nx) {
    const unsigned G = gridDim.x * gridDim.y * gridDim.z;
    unsigned sum, cnt, mine, sp = 0u;
    for (;;) {
        sum = 0u; cnt = 0u; mine = 0u;
#pragma unroll
        for (unsigned j = 0; j < 16; ++j) { const unsigned c = xb_ld(&bar[XB_XCNT(j)]); sum += c; cnt += (c > 0u) ? 1u : 0u; mine = (j == x) ? c : mine; }
        if (sum == G) break;
        __builtin_amdgcn_s_sleep(1);
        if ((++sp & 255u) == 0u) { if (xb_ld(&bar[XB_TMO])) break; if (sp > XB_SPIN_CAP) { atomicAdd(&bar[XB_TMO], 1u); break; } }
    }
    nloc = mine > 0u ? mine : 1u; nx = cnt > 0u ? cnt : 1u;
}

__device__ __forceinline__ void xcd_barrier(const XcdBarrier& b) {
    asm volatile("s_waitcnt vmcnt(0)" ::: "memory");
    __syncthreads();
    if (threadIdx.x == 0) {
        unsigned* bar = b.bar;
        __builtin_amdgcn_s_waitcnt(0);
        unsigned nloc = b.st[0], nx = b.st[1];
        if (nloc == 0u) { xcd_barrier_complete(bar, b.x, nloc, nx); b.st[0] = nloc; b.st[1] = nx; }
        const unsigned old = xb_add(&bar[XB_XSUB(b.x)], 1u);
        const unsigned gen = old / nloc;
        if (old + 1u == (gen + 1u) * nloc) {
            __builtin_amdgcn_fence(__ATOMIC_RELEASE, "agent");
            asm volatile("s_waitcnt vmcnt(0)" ::: "memory");
            const unsigned og = xb_add(&bar[XB_TOP], 1u);
            const unsigned tg = og / nx;
            if (og + 1u == (tg + 1u) * nx) xb_add(&bar[XB_TOPGEN], 1u);
            else XB_SPIN(xb_ld(&bar[XB_TOPGEN]) == tg, bar);
            __builtin_amdgcn_fence(__ATOMIC_ACQUIRE, "agent");
            xb_add(&bar[XB_XGEN(b.x)], 1u);
            asm volatile("s_waitcnt vmcnt(0)" ::: "memory");
        } else {
            XB_SPIN(xb_ld(&bar[XB_XGEN(b.x)]) == gen, bar);
            __builtin_amdgcn_fence(__ATOMIC_ACQUIRE, "agent");
            asm volatile("s_waitcnt vmcnt(0)" ::: "memory");
        }
    }
    __syncthreads();
}
typedef short v4i16_t __attribute__((ext_vector_type(4)));
__device__ __forceinline__ unsigned cvt_pk_bf16(float lo, float hi) { return pg8::cvt_pk_bf16(lo, hi); }
__device__ __forceinline__ float bf_lo(unsigned u) { return __uint_as_float(u << 16); }
__device__ __forceinline__ float bf_hi(unsigned u) { return __uint_as_float(u & 0xffff0000u); }
__device__ __forceinline__ float bf2f(bf16_t b) { return __uint_as_float(((unsigned)b) << 16); }
__device__ __forceinline__ float wave_sum(float v) {
#pragma unroll
    for (int o = 1; o < 64; o <<= 1) v += __shfl_xor(v, o);
    return v;
}
__device__ __forceinline__ float sigmoidf_(float x) { return __builtin_amdgcn_rcpf(1.0f + __expf(-x)); }
__device__ __forceinline__ float siluf_(float x) { return x * __builtin_amdgcn_rcpf(1.0f + __expf(-x)); }
__device__ __forceinline__ float gelu_tanh_(float x) { const float y = 0.7978845608028654f * (x + 0.044715f * x * x * x); const float t = 1.0f - 2.0f * __builtin_amdgcn_rcpf(1.0f + __expf(2.0f * y)); return 0.5f * x * (1.0f + t); }
__device__ __forceinline__ s16x4 vtr(const LAS bf16_t* p) { return __builtin_bit_cast(s16x4, __builtin_amdgcn_ds_read_tr16_b64_v4i16((LAS v4i16_t*)p)); }
__device__ __forceinline__ bf16x8 frag_tr(const LAS bf16_t* tile, int pitch, int k0, int n0, int lane) {
    const int i16 = lane & 15, g = lane >> 4;
    const LAS bf16_t* a = tile + (k0 + 4 * g + (i16 >> 2)) * pitch + n0 + 4 * (i16 & 3);
    const s16x4 lo = vtr(a), hi = vtr(a + 16 * pitch);
    bf16x8 r; r[0] = lo[0]; r[1] = lo[1]; r[2] = lo[2]; r[3] = lo[3]; r[4] = hi[0]; r[5] = hi[1]; r[6] = hi[2]; r[7] = hi[3]; return r;
}
__device__ __forceinline__ bf16x8 pack_frag(const f32x4 a, const f32x4 b) {
    u32x4 w; w.x = cvt_pk_bf16(a[0], a[1]); w.y = cvt_pk_bf16(a[2], a[3]); w.z = cvt_pk_bf16(b[0], b[1]); w.w = cvt_pk_bf16(b[2], b[3]);
    return __builtin_bit_cast(bf16x8, w);
}
#define MFMA16(a, b, c) __builtin_amdgcn_mfma_f32_16x16x32_bf16((a), (b), (c), 0, 0, 0)

typedef const f32x4 (&AccRef)[2][2][4][2];
#define EPI_ROWS() _Pragma("unroll") for (int ai = 0; ai < 2; ++ai) _Pragma("unroll") for (int m = 0; m < 4; ++m)
#define EPI_BJ() _Pragma("unroll") for (int bj = 0; bj < 2; ++bj)

template <int LDC, int NTN> struct EpiPlainBf16 {
    static constexpr bool PERM = true, AFTER_DRAIN = false; static constexpr int ldc = LDC, ntn = NTN;
    bf16_t* O;
    __device__ __forceinline__ void operator()(AccRef acc, const pg8::Unit& u, int wr, int wc, int fr_, int fq_) const {
        int fr = fr_, fq = fq_; asm volatile("" : "+v"(fr), "+v"(fq));
        const int row0 = u.pm * 256 + wr * 64 + fr, col0 = (u.pn % ntn) * 256 + wc * 32 + 8 * fq;
        EPI_ROWS() { bf16_t* rowp = O + (size_t)(row0 + ai * 128 + m * 16) * ldc + col0;
            EPI_BJ() { const f32x4 v0 = acc[ai][bj][m][0], v1 = acc[ai][bj][m][1];
                u32x4 w; w.x = cvt_pk_bf16(v0[0], v0[1]); w.y = cvt_pk_bf16(v0[2], v0[3]); w.z = cvt_pk_bf16(v1[0], v1[1]); w.w = cvt_pk_bf16(v1[2], v1[3]);
                *(u32x4*)(rowp + bj * 128) = w; } }
    }
};
struct EpiPleUp {
    static constexpr bool PERM = true, AFTER_DRAIN = false;
    bf16_t* O; float* ess;
    __device__ __forceinline__ void operator()(AccRef acc, const pg8::Unit& u, int wr, int wc, int fr_, int fq_) const {
        int fr = fr_, fq = fq_; asm volatile("" : "+v"(fr), "+v"(fq));
        const int row0 = u.pm * 256 + wr * 64 + fr, col0 = u.pn * 256 + wc * 32 + 8 * fq;
        EPI_ROWS() { const int row = row0 + ai * 128 + m * 16; bf16_t* rowp = O + (size_t)row * D + col0; float s = 0.f;
            EPI_BJ() { const f32x4 v0 = acc[ai][bj][m][0], v1 = acc[ai][bj][m][1];
                s += (v0[0] * v0[0] + v0[1] * v0[1]) + (v0[2] * v0[2] + v0[3] * v0[3]) + (v1[0] * v1[0] + v1[1] * v1[1]) + (v1[2] * v1[2] + v1[3] * v1[3]);
                u32x4 w; w.x = cvt_pk_bf16(v0[0], v0[1]); w.y = cvt_pk_bf16(v0[2], v0[3]); w.z = cvt_pk_bf16(v1[0], v1[1]); w.w = cvt_pk_bf16(v1[2], v1[3]);
                *(u32x4*)(rowp + bj * 128) = w; }
            s += __shfl_xor(s, 16); s += __shfl_xor(s, 32);
            if (fq == 0) ess[(size_t)row * 16 + u.pn * 4 + wc] = s;
            asm volatile("" ::: "memory"); }
    }
};
struct EpiResid {
    static constexpr bool PERM = false, AFTER_DRAIN = false;
    const float* base; float* out;
    __device__ __forceinline__ void operator()(AccRef acc, const pg8::Unit& u, int wr, int wc, int fr_, int fq_) const {
        int fr = fr_, fq = fq_; asm volatile("" : "+v"(fr), "+v"(fq));
        const int row0 = u.pm * 256 + wr * 64 + fr, col0 = u.pn * 256 + wc * 32 + 4 * fq;
        EPI_ROWS() { const size_t ro = (size_t)(row0 + ai * 128 + m * 16) * D + col0;
            EPI_BJ()
#pragma unroll
                for (int n = 0; n < 2; ++n) { const size_t o = ro + bj * 128 + n * 16; const f32x4 b = *(const f32x4*)(base + o); *(f32x4*)(out + o) = b + acc[ai][bj][m][n]; } }
    }
};
struct EpiSwiglu {
    static constexpr bool PERM = true, AFTER_DRAIN = false;
    bf16_t* H;
    __device__ __forceinline__ void operator()(AccRef acc, const pg8::Unit& u, int wr, int wc, int fr_, int fq_) const {
        int fr = fr_, fq = fq_; asm volatile("" : "+v"(fr), "+v"(fq));
        const int row0 = u.pm * 256 + wr * 64 + fr, ct = u.pn & 3;
        EPI_ROWS() { bf16_t* rowp = H + (size_t)(row0 + ai * 128 + m * 16) * FF;
            EPI_BJ() { const f32x4 g = acc[ai][bj][m][0], up = acc[ai][bj][m][1]; const int ff = 128 * ct + 64 * bj + 16 * wc + 4 * fq;
                u32x2 w; w.x = cvt_pk_bf16(siluf_(g[0]) * up[0], siluf_(g[1]) * up[1]); w.y = cvt_pk_bf16(siluf_(g[2]) * up[2], siluf_(g[3]) * up[3]);
                *(u32x2*)(rowp + ff) = w; } }
    }
};
struct EpiPleGate {
    static constexpr bool PERM = false, AFTER_DRAIN = false;
    float* h; const bf16_t* eraw; const float* erstd; const float* gple;
    __device__ __forceinline__ void operator()(AccRef acc, const pg8::Unit& u, int wr, int wc, int fr_, int fq_) const {
        int fr = fr_, fq = fq_; asm volatile("" : "+v"(fr), "+v"(fq));
        const int row0 = u.pm * 256 + wr * 64 + fr, col0 = u.pn * 256 + wc * 32 + 4 * fq;
        EPI_ROWS() { const int row = row0 + ai * 128 + m * 16; const float rs = erstd[row]; const size_t ro = (size_t)row * D + col0;
            EPI_BJ()
#pragma unroll
                for (int n = 0; n < 2; ++n) { const size_t o = ro + bj * 128 + n * 16; const int c = col0 + bj * 128 + n * 16;
                    const f32x4 hv = *(const f32x4*)(h + o); const f32x4 gv = *(const f32x4*)(gple + c); const u32x2 ew = *(const u32x2*)(eraw + o); const f32x4 a = acc[ai][bj][m][n];
                    f32x4 r; r[0] = hv[0] + bf_lo(ew.x) * rs * gv[0] * sigmoidf_(a[0]); r[1] = hv[1] + bf_hi(ew.x) * rs * gv[1] * sigmoidf_(a[1]);
                    r[2] = hv[2] + bf_lo(ew.y) * rs * gv[2] * sigmoidf_(a[2]); r[3] = hv[3] + bf_hi(ew.y) * rs * gv[3] * sigmoidf_(a[3]);
                    *(f32x4*)(h + o) = r; } }
    }
};
struct EpiRet {
    static constexpr bool PERM = true, AFTER_DRAIN = false;
    bf16_t* Z; const float* rope;
    __device__ __forceinline__ void operator()(AccRef acc, const pg8::Unit& u, int wr, int wc, int fr_, int fq_) const {
        int fr = fr_, fq = fq_; asm volatile("" : "+v"(fr), "+v"(fq));
        const int row0 = u.pm * 256 + wr * 64 + fr;
        const bool rot = u.pn < 8;
        const float sc = (rot && u.pn >= 4) ? 0.08838834764831845f : 1.0f;
        const int i0 = 4 * (4 * wc + fq);
        const int ca = rot ? (2 * u.pn) * 128 + i0 : u.pn * 256 + wc * 32 + 8 * fq, dcb = rot ? 64 : 4;
        EPI_ROWS() { const int row = row0 + ai * 128 + m * 16; const int pos = row & (SEQ - 1);
            f32x4 cs = (f32x4){1.f, 1.f, 1.f, 1.f}, sn = (f32x4){0.f, 0.f, 0.f, 0.f};
            if (rot) { cs = *(const f32x4*)(rope + (size_t)pos * 64 + i0); sn = *(const f32x4*)(rope + (size_t)SEQ * 64 + (size_t)pos * 64 + i0); }
            bf16_t* rowp = Z + (size_t)row * OD_IN + ca;
            EPI_BJ() { const f32x4 x1 = acc[ai][bj][m][0], x2 = acc[ai][bj][m][1];
                u32x2 a, b;
                a.x = cvt_pk_bf16((x1[0] * cs[0] - x2[0] * sn[0]) * sc, (x1[1] * cs[1] - x2[1] * sn[1]) * sc); a.y = cvt_pk_bf16((x1[2] * cs[2] - x2[2] * sn[2]) * sc, (x1[3] * cs[3] - x2[3] * sn[3]) * sc);
                b.x = cvt_pk_bf16((x2[0] * cs[0] + x1[0] * sn[0]) * sc, (x2[1] * cs[1] + x1[1] * sn[1]) * sc); b.y = cvt_pk_bf16((x2[2] * cs[2] + x1[2] * sn[2]) * sc, (x2[3] * cs[3] + x1[3] * sn[3]) * sc);
                *(u32x2*)(rowp + bj * 128) = a; *(u32x2*)(rowp + bj * 128 + dcb) = b; }
            asm volatile("" ::: "memory"); }
    }
};
struct MoeOrder {
    const int* tile_e; int ntiles, G, c;
    __device__ __forceinline__ void init(const int* te, int G_, int c_) { tile_e = te; ntiles = te[MOE_TILES]; G = G_; c = c_; }
    __device__ __forceinline__ bool next(int i, pg8::Unit& u) const {
        const int nwg = ntiles * 4; int L = i * G + c; if (L >= nwg) return false;
        { const int q = nwg / 8, r = nwg % 8, xcd = L % 8, off = L / 8; L = (xcd < r ? xcd * (q + 1) : r * (q + 1) + (xcd - r) * q) + off; }
        const int rt = L >> 2; u.pm = rt; u.pn = tile_e[rt] * 4 + (L & 3); return true;
    }
    __device__ __forceinline__ void a_ready(const pg8::Unit&) const {}
    __device__ __forceinline__ void done(const pg8::Unit&) const {}
};
template <int MODE>
__device__ __forceinline__ void tr_item(const float* W, const float* W2, int K, int Nsrc, bf16_t* WT, int r0, int k0, LAS float* scr, int lane) {
    const int kr = lane >> 4, c4 = lane & 15, r = r0 + 4 * c4;
    const float* src = W; int col = r; bool ok = true;
    if (MODE == 0) { ok = r < Nsrc; }
    if (MODE == 1) { if (r < 2048) { const int hh = r >> 7, w = r & 127, w8 = w >> 3, rr = w & 7; col = hh * 128 + ((rr < 4) ? 4 * w8 : 64 + 4 * w8); } }
    if (MODE == 2) { const int w8 = r >> 3; src = ((r >> 2) & 1) ? W2 : W; col = 4 * w8; }
#pragma unroll 4
    for (int i = 0; i < 16; ++i) { const int k = kr + 4 * i;
        f32x4 v = (f32x4){0.f, 0.f, 0.f, 0.f};
        if (ok) v = *(const f32x4*)(src + (size_t)(k0 + k) * Nsrc + col);
        LAS float* d = scr + k * 65 + 4 * c4; d[0] = v[0]; d[1] = v[1]; d[2] = v[2]; d[3] = v[3]; }
    asm volatile("s_waitcnt lgkmcnt(0)" ::: "memory");
    const int c = lane & 7;
#pragma unroll
    for (int j = 0; j < 8; ++j) { const int n = (lane >> 3) + 8 * j; const LAS float* s = scr + (8 * c) * 65 + n;
        u32x4 o; o.x = cvt_pk_bf16(s[0 * 65], s[1 * 65]); o.y = cvt_pk_bf16(s[2 * 65], s[3 * 65]); o.z = cvt_pk_bf16(s[4 * 65], s[5 * 65]); o.w = cvt_pk_bf16(s[6 * 65], s[7 * 65]);
        *(u32x4*)(WT + (size_t)(r0 + n) * K + k0 + 8 * c) = o; }
    asm volatile("s_waitcnt lgkmcnt(0)" ::: "memory");
}
template <int MODE>
__device__ __forceinline__ void tr_matrix(const float* W, const float* W2, int K, int Nsrc, bf16_t* WT, int rows, LAS float* scr, int lane, int gw, int ngw) {
    const int nkb = K / 64, nitems = (rows / 64) * nkb;
    for (int it = gw; it < nitems; it += ngw) { const int rb = it / nkb, kb = it % nkb; tr_item<MODE>(W, W2, K, Nsrc, WT, rb * 64, kb * 64, scr, lane); }
}
__device__ __forceinline__ void convert_moe_layer(const float* wg, const float* wu, const float* wd, bf16_t* GU, bf16_t* DN, LAS float* scr, int lane, int gw, int ngw) {
    const int n_gu = NEXP * 256, n_dn = NEXP * 128;
    for (int it = gw; it < n_gu + n_dn; it += ngw) {
        if (it < n_gu) { const int e = it >> 8, r = it & 255, rb = r >> 4, kb = r & 15;
            tr_item<2>(wg + (size_t)e * D * FF, wu + (size_t)e * D * FF, D, FF, GU + (size_t)e * 1024 * D, rb * 64, kb * 64, scr, lane); }
        else { const int q = it - n_gu, e = q >> 7, r = q & 127, rb = r >> 3, kb = r & 7;
            tr_item<0>(wd + (size_t)e * FF * D, nullptr, FF, D, DN + (size_t)e * 1024 * FF, rb * 64, kb * 64, scr, lane); }
    }
}
__device__ __forceinline__ void rms_row_to_bf16(const float* xrow, const float* gain, bf16_t* orow, int lane) {
    const f32x4* xr = (const f32x4*)xrow + lane; const f32x4* gr = (const f32x4*)gain + lane;
    f32x4 v[4]; float s = 0.f;
#pragma unroll
    for (int j = 0; j < 4; ++j) { v[j] = xr[64 * j]; s += (v[j][0] * v[j][0] + v[j][1] * v[j][1]) + (v[j][2] * v[j][2] + v[j][3] * v[j][3]); }
    const float rstd = 1.0f / sqrtf(wave_sum(s) * (1.0f / D) + RMS_EPS);
    u32x2* o8 = (u32x2*)orow + lane;
#pragma unroll
    for (int j = 0; j < 4; ++j) { const f32x4 g = gr[64 * j]; u32x2 w; w.x = cvt_pk_bf16(v[j][0] * rstd * g[0], v[j][1] * rstd * g[1]); w.y = cvt_pk_bf16(v[j][2] * rstd * g[2], v[j][3] * rstd * g[3]); o8[64 * j] = w; }
}
__device__ __forceinline__ void lru_local_unit(const bf16_t* Z0, const float* conv_w, const float* conv_b, const float* wa, const float* ba, const float* wx, const float* bx, const float* lam,
                                               float* HLOC, float* PCUM, float* SUMA, float* SUMH, ldsp lds, int b, int c, int tid) {
    const int ch = tid, lane = tid & 63, blk = __builtin_amdgcn_readfirstlane(tid >> 6), i16 = lane & 15, g = lane >> 4;
    LAS bf16_t* Xc = (LAS bf16_t*)(lds + blk * 17408); LAS float* GB = (LAS float*)(lds + blk * 17408 + 9216);
    const float w0 = conv_w[ch], w1 = conv_w[512 + ch], w2 = conv_w[1024 + ch], w3 = conv_w[1536 + ch], cb = conv_b[ch];
    const float bav = ba[ch], bxv = bx[ch];
    const float l = lam[ch]; const float z = __expf(-l);
    const float sp = (z < 0.02f) ? z * (1.0f - z * (0.5f - z * (0.33333334f - 0.25f * z))) : __logf(1.0f + z);
    const float c8 = -8.0f * sp;
    const size_t tok0 = (size_t)b * SEQ + (size_t)c * 64;
    float xm3 = 0.f, xm2 = 0.f, xm1 = 0.f;
    if (c > 0) { xm3 = bf2f(Z0[(tok0 - 3) * EV_INP + ZC_XA + ch]); xm2 = bf2f(Z0[(tok0 - 2) * EV_INP + ZC_XA + ch]); xm1 = bf2f(Z0[(tok0 - 1) * EV_INP + ZC_XA + ch]); }
    bf16x8 bfa[2][4], bfx[2][4];
#pragma unroll
    for (int ks = 0; ks < 2; ++ks)
#pragma unroll
        for (int nt = 0; nt < 4; ++nt) { const float* pa = wa + (size_t)blk * 4096 + (32 * ks + 8 * g) * 64 + 16 * nt + i16; const float* px = wx + (size_t)blk * 4096 + (32 * ks + 8 * g) * 64 + 16 * nt + i16;
            u32x4 ua, ux; ua.x = cvt_pk_bf16(pa[0], pa[64]); ua.y = cvt_pk_bf16(pa[128], pa[192]); ua.z = cvt_pk_bf16(pa[256], pa[320]); ua.w = cvt_pk_bf16(pa[384], pa[448]);
            ux.x = cvt_pk_bf16(px[0], px[64]); ux.y = cvt_pk_bf16(px[128], px[192]); ux.z = cvt_pk_bf16(px[256], px[320]); ux.w = cvt_pk_bf16(px[384], px[448]);
            bfa[ks][nt] = __builtin_bit_cast(bf16x8, ua); bfx[ks][nt] = __builtin_bit_cast(bf16x8, ux); }
    float xc[64];
#pragma unroll
    for (int t = 0; t < 64; ++t) { const float xt = bf2f(Z0[(tok0 + t) * EV_INP + ZC_XA + ch]);
        xc[t] = w0 * xm3 + w1 * xm2 + w2 * xm1 + w3 * xt + cb; xm3 = xm2; xm2 = xm1; xm1 = xt;
        Xc[t * 72 + lane] = (bf16_t)(cvt_pk_bf16(xc[t], 0.f) & 0xffffu); }
    asm volatile("s_waitcnt lgkmcnt(0)" ::: "memory");
    float h = 0.f, P = 1.f;
#pragma unroll
    for (int mt = 0; mt < 4; ++mt) {
        const bf16x8 a0 = *(const LAS bf16x8*)(Xc + (16 * mt + i16) * 72 + 8 * g), a1 = *(const LAS bf16x8*)(Xc + (16 * mt + i16) * 72 + 32 + 8 * g);
#pragma unroll
        for (int nt = 0; nt < 4; ++nt) { f32x4 ca = (f32x4){0.f, 0.f, 0.f, 0.f}, cx = (f32x4){0.f, 0.f, 0.f, 0.f};
            ca = MFMA16(a0, bfa[0][nt], ca); ca = MFMA16(a1, bfa[1][nt], ca); cx = MFMA16(a0, bfx[0][nt], cx); cx = MFMA16(a1, bfx[1][nt], cx);
#pragma unroll
            for (int i = 0; i < 4; ++i) { GB[(4 * g + i) * 128 + 16 * nt + i16] = ca[i]; GB[(4 * g + i) * 128 + 64 + 16 * nt + i16] = cx[i]; } }
        asm volatile("s_waitcnt lgkmcnt(0)" ::: "memory");
#pragma unroll
        for (int t = 0; t < 16; ++t) {
            const float r = sigmoidf_(GB[t * 128 + lane] + bav), gi = sigmoidf_(GB[t * 128 + 64 + lane] + bxv);
            const float log_a = c8 * r; const float a = __expf(log_a);
            const float y2 = 2.0f * log_a;
            const float om = (y2 > -0.3f) ? -y2 * (1.0f + y2 * (0.5f + y2 * (0.16666667f + y2 * (0.041666668f + y2 * (0.008333334f + y2 * 0.0013888889f))))) : 1.0f - a * a;
            const float u = sqrtf(fmaxf(om, 0.f)) * (gi * xc[16 * mt + t]);
            h = a * h + u; P *= a;
            const size_t o = (tok0 + 16 * mt + t) * 512 + ch;
            HLOC[o] = h; PCUM[o] = P;
        }
        asm volatile("" ::: "memory");
    }
    SUMA[((size_t)b * 64 + c) * 512 + ch] = P; SUMH[((size_t)b * 64 + c) * 512 + ch] = h;
}
__device__ __forceinline__ void lru_fix_unit(const bf16_t* Z0, const float* HLOC, const float* PCUM, const float* SUMA, const float* SUMH, bf16_t* Y0, int b, int c, int tid) {
    const int ch = tid; float hin = 0.f;
    for (int c0 = 0; c0 < c; c0 += 16) {
        float av[16], hv[16];
#pragma unroll
        for (int j = 0; j < 16; ++j) { const int cc = (c0 + j < c) ? c0 + j : c - 1; const size_t o = ((size_t)b * 64 + cc) * 512 + ch; av[j] = SUMA[o]; hv[j] = SUMH[o]; }
#pragma unroll
        for (int j = 0; j < 16; ++j) if (c0 + j < c) hin = av[j] * hin + hv[j];
    }
    const size_t tok0 = (size_t)b * SEQ + (size_t)c * 64;
#pragma unroll 1
    for (int t0 = 0; t0 < 64; t0 += 16) {
        float hl[16], pc[16], gav[16];
#pragma unroll
        for (int j = 0; j < 16; ++j) { const size_t tok = tok0 + t0 + j; hl[j] = HLOC[tok * 512 + ch]; pc[j] = PCUM[tok * 512 + ch]; gav[j] = bf2f(Z0[tok * EV_INP + ZC_GA + ch]); }
#pragma unroll
        for (int j = 0; j < 16; ++j) { const size_t tok = tok0 + t0 + j; Y0[tok * D + ch] = (bf16_t)(cvt_pk_bf16((hl[j] + pc[j] * hin) * gelu_tanh_(gav[j]), 0.f) & 0xffffu); }
    }
}
__device__ __forceinline__ void dsa_prep_token(bf16_t* Z0, const float* qg, const float* kg, size_t tok, int lane) {
    const int d0 = (lane & 7) * 8;
#pragma unroll
    for (int which = 0; which < 2; ++which) {
        bf16_t* p = Z0 + tok * EV_INP + (which ? ZC_K : ZC_Q) + lane * 8; const float* g = (which ? kg : qg) + d0;
        const u32x4 w = *(const u32x4*)p; float v[8] = {bf_lo(w.x), bf_hi(w.x), bf_lo(w.y), bf_hi(w.y), bf_lo(w.z), bf_hi(w.z), bf_lo(w.w), bf_hi(w.w)};
        float s = 0.f;
#pragma unroll
        for (int i = 0; i < 8; ++i) s += v[i] * v[i];
        s += __shfl_xor(s, 1); s += __shfl_xor(s, 2); s += __shfl_xor(s, 4);
        const float rstd = 1.0f / sqrtf(s * (1.0f / 64.0f) + RMS_EPS);
        u32x4 o; o.x = cvt_pk_bf16(v[0] * rstd * g[0], v[1] * rstd * g[1]); o.y = cvt_pk_bf16(v[2] * rstd * g[2], v[3] * rstd * g[3]);
        o.z = cvt_pk_bf16(v[4] * rstd * g[4], v[5] * rstd * g[5]); o.w = cvt_pk_bf16(v[6] * rstd * g[6], v[7] * rstd * g[7]);
        *(u32x4*)p = o;
    }
}
__device__ __forceinline__ unsigned f2key(float f) { const unsigned u = __float_as_uint(f); return (u & 0x80000000u) ? ~u : (u | 0x80000000u); }
__device__ __forceinline__ float relu_i(float x) { const int i = __builtin_bit_cast(int, x); return __builtin_bit_cast(float, i > 0 ? i : 0); }
template <int WPL  >
__device__ __forceinline__ void radix_scan_row(LAS unsigned* hrow, LAS unsigned* pref, LAS unsigned* kneed, LAS unsigned* eqcnt, int row, int lane, int bits) {
    unsigned s = 0;
#pragma unroll
    for (int q = 0; q < WPL / 4; ++q) { const u32x4 c4 = *(const LAS u32x4*)(hrow + lane * WPL + 4 * q);
        s += (c4.x & 0xffffu) + (c4.x >> 16) + (c4.y & 0xffffu) + (c4.y >> 16) + (c4.z & 0xffffu) + (c4.z >> 16) + (c4.w & 0xffffu) + (c4.w >> 16); }
    unsigned v = s;
#pragma unroll
    for (int off = 1; off < 64; off <<= 1) { const unsigned t2 = __shfl_down(v, off); if (lane + off < 64) v += t2; }
    const unsigned ex = v - s;
    const unsigned kn = kneed[row];
    if (ex < kn && kn <= ex + s) {
        unsigned cum = ex; int bin = -1; unsigned cb = 0, ab = 0;
        for (int wi = WPL - 1; wi >= 0 && bin < 0; --wi) { const unsigned cw = hrow[lane * WPL + wi]; const unsigned chi = cw >> 16, clo = cw & 0xffffu;
            if (kn <= cum + chi) { bin = 2 * (lane * WPL + wi) + 1; cb = chi; ab = cum; }
            else { cum += chi; if (kn <= cum + clo) { bin = 2 * (lane * WPL + wi); cb = clo; ab = cum; } else cum += clo; } }
        pref[row] = (pref[row] << bits) | (unsigned)bin; kneed[row] = kn - ab; eqcnt[row] = cb;
    }
}
#define HADD(hp, d) __hip_atomic_fetch_add((hp) + ((d) >> 1), ((d) & 1u) ? 0x10000u : 1u, __ATOMIC_RELAXED, __HIP_MEMORY_SCOPE_WORKGROUP)
template <int HALF>
__device__ __forceinline__ void dsa_select_round(const bf16_t* Z0, unsigned* MASK, ldsp lds, const bf16x8 (&qf)[8][2], const bf16_t* kbase, unsigned loff, size_t tok0, int nt, int tid, int dbg) {
    const int lane = tid & 63, w = __builtin_amdgcn_readfirstlane(tid >> 6), g = lane >> 4;
    LAS unsigned* H0 = (LAS unsigned*)lds; LAS unsigned* H1 = (LAS unsigned*)(lds + 65536); LAS unsigned short* MB = (LAS unsigned short*)(lds + 81920); LAS unsigned* GE = (LAS unsigned*)(lds + 86016);
    LAS unsigned* pref = (LAS unsigned*)(lds + 98304); LAS unsigned* kneed = pref + 8; LAS unsigned* eqcnt = pref + 16; LAS unsigned* lcount = pref + 24; LAS unsigned* flg = pref + 32;
    float wq0[8], wq1[8];
    { const u32x4 wa4 = *(const u32x4*)(Z0 + (tok0 + 4 * g + 2 * HALF) * EV_INP + ZC_IW), wb4 = *(const u32x4*)(Z0 + (tok0 + 4 * g + 2 * HALF + 1) * EV_INP + ZC_IW);
      const float k0 = 0.04419417382415922f;
      wq0[0] = bf_lo(wa4.x) * k0; wq0[1] = bf_hi(wa4.x) * k0; wq0[2] = bf_lo(wa4.y) * k0; wq0[3] = bf_hi(wa4.y) * k0; wq0[4] = bf_lo(wa4.z) * k0; wq0[5] = bf_hi(wa4.z) * k0; wq0[6] = bf_lo(wa4.w) * k0; wq0[7] = bf_hi(wa4.w) * k0;
      wq1[0] = bf_lo(wb4.x) * k0; wq1[1] = bf_hi(wb4.x) * k0; wq1[2] = bf_lo(wb4.y) * k0; wq1[3] = bf_hi(wb4.y) * k0; wq1[4] = bf_lo(wb4.z) * k0; wq1[5] = bf_hi(wb4.z) * k0; wq1[6] = bf_lo(wb4.w) * k0; wq1[7] = bf_hi(wb4.w) * k0; }
    u32x2 ky[32];
    const int ntw = (nt - w + 7) >> 3;
    LAS unsigned char* ring = lds + w * 16384; const unsigned ring_rd = (unsigned)(size_t)(ring + lane * 16);
#define IK_ISSUE(tt_) do { const int tc_ = ((tt_) < ntw) ? (tt_) : (ntw - 1); unsigned long long kb64_ = (unsigned long long)kbase; asm volatile("" : "+s"(kb64_)); \
        const char* gp_ = (const char*)(kb64_ + (unsigned long long)tc_ * (128ull * EV_INP * 2ull)); unsigned lo2_ = loff; asm volatile("" : "+v"(lo2_)); \
        __builtin_amdgcn_global_load_lds((const unsigned*)(gp_ + lo2_), (LAS unsigned*)(ring + (2 * ((tt_) & 7)) * 1024), 16, 0, 0); \
        __builtin_amdgcn_global_load_lds((const unsigned*)(gp_ + lo2_ + 64), (LAS unsigned*)(ring + (2 * ((tt_) & 7) + 1) * 1024), 16, 0, 0); } while (0)
#pragma unroll
    for (int h = 0; h < 8; ++h) asm volatile("" :: "v"(qf[h][0]), "v"(qf[h][1]), "v"(wq0[h]), "v"(wq1[h]));
    asm volatile("s_waitcnt vmcnt(0)" ::: "memory");
    if (ntw > 0 && !(dbg & 4)) {
#pragma unroll
        for (int tt = 0; tt < 8; ++tt) IK_ISSUE(tt);
    }
#pragma unroll
    for (int tt = 0; tt < 32; ++tt) {
        ky[tt] = (u32x2){0u, 0u};
        if (tt < ntw && !(dbg & 4)) {
            asm volatile("s_waitcnt vmcnt(14)" ::: "memory");
            bf16x8 k0f, k1f;
            asm volatile("ds_read_b128 %0, %2 offset:%3\n\tds_read_b128 %1, %2 offset:%4\n\ts_waitcnt lgkmcnt(0)" : "=&v"(k0f), "=&v"(k1f) : "v"(ring_rd), "i"((2 * (tt & 7)) * 1024), "i"((2 * (tt & 7) + 1) * 1024) : "memory");
            IK_ISSUE(tt + 8);
            f32x4 acc[8];
#pragma unroll
            for (int h = 0; h < 8; ++h) acc[h] = MFMA16(qf[h][0], k0f, ((f32x4){0.f, 0.f, 0.f, 0.f}));
#pragma unroll
            for (int h = 0; h < 8; ++h) acc[h] = MFMA16(qf[h][1], k1f, acc[h]);
            float s0 = 0.f, s1 = 0.f;
#pragma unroll
            for (int h = 0; h < 8; ++h) { s0 += relu_i(acc[h][2 * HALF]) * wq0[h]; s1 += relu_i(acc[h][2 * HALF + 1]) * wq1[h]; }
            ky[tt] = (u32x2){f2key(s0), f2key(s1)};
        }
    }
#undef IK_ISSUE
    asm volatile("s_waitcnt vmcnt(0)" ::: "memory");
    __syncthreads();
    if (tid < 8) { pref[tid] = 0u; kneed[tid] = 256u; eqcnt[tid] = 0u; lcount[tid] = 0u; }
    if (tid < 2) flg[tid] = 0u;
    { const u32x4 z4 = (u32x4){0u, 0u, 0u, 0u}; for (int i = tid; i < 256; i += 512) *(LAS u32x4*)((LAS unsigned*)MB + 4 * i) = z4;
      if (nt > 16) for (int i = tid; i < 4096; i += 512) *(LAS u32x4*)(H0 + 4 * i) = z4; }
    __syncthreads();
    if (nt > 16 && !(dbg & 2)) {
        { LAS unsigned* h0 = H0 + (2 * g) * 2048; LAS unsigned* h1 = H0 + (2 * g + 1) * 2048;
#pragma unroll
          for (int tt = 0; tt < 32; ++tt) if (tt < ntw) { const unsigned da = ky[tt].x >> 20, db = ky[tt].y >> 20; HADD(h0, da); HADD(h1, db); } }
        __syncthreads();
        radix_scan_row<32>(H0 + w * 2048, pref, kneed, eqcnt, w, lane, 12);
        if (eqcnt[w] > 2048u && lane == 0) flg[0] = 1u;
        __syncthreads();
        if (flg[0] == 0u) {
            { const unsigned pf0 = pref[2 * g], pf1 = pref[2 * g + 1];
#pragma unroll
              for (int tt = 0; tt < 32; ++tt) if (tt < ntw) { const unsigned ka = ky[tt].x, kb = ky[tt].y;
                  if ((ka >> 20) == pf0) { const unsigned p = __hip_atomic_fetch_add(lcount + 2 * g, 1u, __ATOMIC_RELAXED, __HIP_MEMORY_SCOPE_WORKGROUP); H0[(2 * g) * 2048 + p] = ka; }
                  if ((kb >> 20) == pf1) { const unsigned p = __hip_atomic_fetch_add(lcount + 2 * g + 1, 1u, __ATOMIC_RELAXED, __HIP_MEMORY_SCOPE_WORKGROUP); H0[(2 * g + 1) * 2048 + p] = kb; } } }
            __syncthreads();
            { const int n = (int)lcount[w]; LAS unsigned* hr = H1 + w * 512; const LAS unsigned* lst = H0 + w * 2048;
#pragma unroll 1
              for (int pass = 1; pass < 3; ++pass) { const int shift = pass == 1 ? 10 : 0;
                  *(LAS u32x4*)(hr + 8 * lane) = (u32x4){0u, 0u, 0u, 0u}; *(LAS u32x4*)(hr + 8 * lane + 4) = (u32x4){0u, 0u, 0u, 0u};
                  const unsigned pw = pref[w];
                  asm volatile("" ::: "memory");
                  for (int i = lane; i < n; i += 64) { const unsigned key = lst[i]; const unsigned d = (key >> shift) & 1023u; if (pass == 1 || (key >> 10) == pw) HADD(hr, d); }
                  asm volatile("s_waitcnt lgkmcnt(0)" ::: "memory");
                  radix_scan_row<8>(hr, pref, kneed, eqcnt, w, lane, 10);
                  asm volatile("s_waitcnt lgkmcnt(0)" ::: "memory"); } }
        } else {
#pragma unroll 1
            for (int pass = 1; pass < 3; ++pass) { const int shift = pass == 1 ? 10 : 0;
                for (int i = tid; i < 1024; i += 512) *(LAS u32x4*)(H1 + 4 * i) = (u32x4){0u, 0u, 0u, 0u};
                __syncthreads();
                const unsigned pf0 = pref[2 * g], pf1 = pref[2 * g + 1];
#pragma unroll
                for (int tt = 0; tt < 32; ++tt) if (tt < ntw) { const unsigned ka = ky[tt].x, kb = ky[tt].y;
                    if ((ka >> (shift + 10)) == pf0) { const unsigned d = (ka >> shift) & 1023u; HADD(H1 + (2 * g) * 512, d); }
                    if ((kb >> (shift + 10)) == pf1) { const unsigned d = (kb >> shift) & 1023u; HADD(H1 + (2 * g + 1) * 512, d); } }
                __syncthreads();
                radix_scan_row<8>(H1 + w * 512, pref, kneed, eqcnt, w, lane, 10);
                __syncthreads(); }
        }
        __syncthreads();
        if (tid < 8 && kneed[tid] < eqcnt[tid]) flg[1] = 1u;
    }
    __syncthreads();
    {
        const unsigned T0 = pref[2 * g], T1 = pref[2 * g + 1];
        if (dbg & 8) { } else if (flg[1] == 0u) {
#pragma unroll
            for (int tt = 0; tt < 32; ++tt) if (tt < ntw) { const int t = w + 8 * tt;
                const unsigned long long b0 = __ballot(ky[tt].x >= T0), b1 = __ballot(ky[tt].y >= T1);
                if (lane == 0) { *(LAS unsigned long long*)(MB + (t * 2 + 0) * 4) = b0; *(LAS unsigned long long*)(MB + (t * 2 + 1) * 4) = b1; } }
            __syncthreads();
        } else {
            for (int i = tid; i < 2048; i += 512) GE[i] = 0u;
            __syncthreads();
#pragma unroll
            for (int tt = 0; tt < 32; ++tt) if (tt < ntw) { const int t = w + 8 * tt;
                const unsigned long long gt0 = __ballot(ky[tt].x > T0), eq0 = __ballot(ky[tt].x == T0), gt1 = __ballot(ky[tt].y > T1), eq1 = __ballot(ky[tt].y == T1);
                if (lane < 4) { GE[(2 * lane) * 256 + t] = (unsigned)((gt0 >> (16 * lane)) & 0xffffull) | ((unsigned)((eq0 >> (16 * lane)) & 0xffffull) << 16);
                                GE[(2 * lane + 1) * 256 + t] = (unsigned)((gt1 >> (16 * lane)) & 0xffffull) | ((unsigned)((eq1 >> (16 * lane)) & 0xffffull) << 16); } }
            __syncthreads();
            if (tid < 8) { const int q = tid; unsigned rem = kneed[q];
                for (int t = 0; t < nt; ++t) { unsigned x = GE[q * 256 + t]; unsigned e = x >> 16; const unsigned pc = __popc(e);
                    if (pc <= rem) rem -= pc;
                    else { unsigned keep = 0; while (rem) { const unsigned low = e & (0u - e); keep |= low; e ^= low; --rem; } x = (x & 0xffffu) | (keep << 16); GE[q * 256 + t] = x; } } }
            __syncthreads();
            for (int i = tid; i < 2048; i += 512) { const int r8 = i >> 8, t = i & 255; const unsigned x = GE[i]; MB[(t * 2 + (r8 & 1)) * 4 + (r8 >> 1)] = (unsigned short)((x | (x >> 16)) & 0xffffu); }
            __syncthreads();
        }
    }
    for (int i = tid; i < 1024; i += 512) { const int r8 = i >> 7, t2 = i & 127, gg = r8 >> 1, j = r8 & 1; const int q = 4 * gg + 2 * HALF + j;
        const unsigned m0 = MB[((2 * t2) * 2 + j) * 4 + gg], m1 = MB[((2 * t2 + 1) * 2 + j) * 4 + gg];
        MASK[(tok0 + q) * 128 + t2] = m0 | (m1 << 16); }
    __syncthreads();
}
__device__ __forceinline__ void dsa_select_unit(const bf16_t* Z0, unsigned* MASK, ldsp lds, int b, int qt, int tid, int dbg) {
    const int lane = tid & 63, w = __builtin_amdgcn_readfirstlane(tid >> 6), i16 = lane & 15, g = lane >> 4;
    const int c = qt >> 2, nt = 4 * (c + 1);
    const size_t tok0 = (size_t)b * SEQ + (size_t)qt * 16;
    bf16x8 qf[8][2];
#pragma unroll
    for (int h = 0; h < 8; ++h)
#pragma unroll
        for (int ks = 0; ks < 2; ++ks) qf[h][ks] = *(const bf16x8*)(Z0 + (tok0 + i16) * EV_INP + ZC_IQ + h * 64 + 32 * ks + 8 * g);
    const unsigned loff = (unsigned)(i16 * EV_INP + ZC_IK + 8 * g) * 2u;
    const bf16_t* kbase = Z0 + ((size_t)b * SEQ + (size_t)w * 16) * EV_INP;
    dsa_select_round<0>(Z0, MASK, lds, qf, kbase, loff, tok0, nt, tid, dbg);
    dsa_select_round<1>(Z0, MASK, lds, qf, kbase, loff, tok0, nt, tid, dbg);
}
__device__ __forceinline__ int t5_bucket(int rel) {
    const int n = rel < 0 ? -rel : rel; const int ret = rel > 0 ? 16 : 0;
    int v;
    if (n < 8) v = n; else { const int val = n < 12 ? 0 : n < 16 ? 1 : n < 23 ? 2 : n < 32 ? 3 : n < 46 ? 4 : n < 64 ? 5 : n < 91 ? 6 : 7; v = 8 + val; if (v > 15) v = 15; }
    return ret + v;
}
__device__ __forceinline__ void dsa_attn_unit(const bf16_t* Z0, const unsigned* MASK, const float* rel_bias, bf16_t* Y0, ldsp lds, int b, int h, int qt, int tid) {
    const int lane = tid & 63, w = __builtin_amdgcn_readfirstlane(tid >> 6), i16 = lane & 15, g = lane >> 4;
    LAS float* lut = (LAS float*)(lds + 36864);
    __syncthreads();
    if (tid < 192) lut[tid] = rel_bias[t5_bucket(tid - 128) * 8 + h] * LOG2E;
    int qpos[2]; size_t tokq[2]; bf16x8 qf[2][2]; const unsigned long long* mrow[2];
    const float scale = 0.125f * LOG2E;
#pragma unroll
    for (int nt = 0; nt < 2; ++nt) { qpos[nt] = qt * 256 + w * 32 + nt * 16 + i16; tokq[nt] = (size_t)b * SEQ + qpos[nt]; mrow[nt] = (const unsigned long long*)(MASK + tokq[nt] * 128);
#pragma unroll
        for (int ks = 0; ks < 2; ++ks) { const u32x4 q4 = *(const u32x4*)(Z0 + tokq[nt] * EV_INP + ZC_Q + h * 64 + 32 * ks + 8 * g);
            u32x4 r; r.x = cvt_pk_bf16(bf_lo(q4.x) * scale, bf_hi(q4.x) * scale); r.y = cvt_pk_bf16(bf_lo(q4.y) * scale, bf_hi(q4.y) * scale); r.z = cvt_pk_bf16(bf_lo(q4.z) * scale, bf_hi(q4.z) * scale); r.w = cvt_pk_bf16(bf_lo(q4.w) * scale, bf_hi(q4.w) * scale);
            qf[nt][ks] = __builtin_bit_cast(bf16x8, r); } }
    const int nkb = 4 * qt + 4;
    float mrun[2] = {-1e30f, -1e30f}, lsum[2] = {0.f, 0.f}; f32x4 o[2][4];
#pragma unroll
    for (int nt = 0; nt < 2; ++nt)
#pragma unroll
        for (int dt = 0; dt < 4; ++dt) o[nt][dt] = (f32x4){0.f, 0.f, 0.f, 0.f};
    const int srow = tid >> 3, sch = tid & 7;
    const bf16_t* sbase = Z0 + ((size_t)b * SEQ + srow) * EV_INP + h * 64 + sch * 8;
    const int soff = srow * 72 + sch * 8;
    u32x4 kreg = *(const u32x4*)(sbase + ZC_K), vreg = *(const u32x4*)(sbase + ZC_V);
    *(LAS u32x4*)((LAS bf16_t*)lds + soff) = kreg; *(LAS u32x4*)((LAS bf16_t*)(lds + 9216) + soff) = vreg;
    { const bf16_t* src = sbase + (size_t)64 * EV_INP; kreg = *(const u32x4*)(src + ZC_K); vreg = *(const u32x4*)(src + ZC_V); }
    unsigned long long mcur[2] = {mrow[0][0], mrow[1][0]}, mnx[2] = {mrow[0][1], mrow[1][1]};
    __syncthreads();
    for (int kb = 0; kb < nkb; ++kb) {
        const LAS bf16_t* Ks = (const LAS bf16_t*)(lds + (kb & 1) * 18432); const LAS bf16_t* Vs = (const LAS bf16_t*)(lds + (kb & 1) * 18432 + 9216);
        const bool far = (kb * 64 + 63 + 128 <= qt * 256);
        const float bfar = lut[0];
        f32x4 s[2][4];
#pragma unroll
        for (int nt = 0; nt < 2; ++nt) { const unsigned mlo = (unsigned)mcur[nt] >> (4 * g), mhi = (unsigned)(mcur[nt] >> 32) >> (4 * g);
#pragma unroll
            for (int kt = 0; kt < 4; ++kt)
#pragma unroll
                for (int i = 0; i < 4; ++i) { float bias = bfar;
                    if (!far) { int idx = kb * 64 + kt * 16 + 4 * g + i - qpos[nt]; idx = idx < -128 ? -128 : idx; bias = lut[idx + 128]; }
                    const int mbit = __builtin_amdgcn_sbfe((int)((kt & 2) ? mhi : mlo), 16 * (kt & 1) + i, 1);
                    s[nt][kt][i] = __uint_as_float((__float_as_uint(bias) & (unsigned)mbit) | (0xff800000u & ~(unsigned)mbit)); } }
#pragma unroll
        for (int kt = 0; kt < 4; ++kt) { const bf16x8 a0 = *(const LAS bf16x8*)(Ks + (kt * 16 + i16) * 72 + 8 * g), a1 = *(const LAS bf16x8*)(Ks + (kt * 16 + i16) * 72 + 32 + 8 * g);
#pragma unroll
            for (int nt = 0; nt < 2; ++nt) { s[nt][kt] = MFMA16(a0, qf[nt][0], s[nt][kt]); s[nt][kt] = MFMA16(a1, qf[nt][1], s[nt][kt]); } }
        bf16x8 pb[2][2];
#pragma unroll
        for (int nt = 0; nt < 2; ++nt) {
            float mx = fmaxf(fmaxf(s[nt][0][0], s[nt][0][1]), fmaxf(s[nt][0][2], s[nt][0][3]));
#pragma unroll
            for (int kt = 1; kt < 4; ++kt) mx = fmaxf(fmaxf(mx, s[nt][kt][0]), fmaxf(fmaxf(s[nt][kt][1], s[nt][kt][2]), s[nt][kt][3]));
            mx = fmaxf(mx, __shfl_xor(mx, 16)); mx = fmaxf(mx, __shfl_xor(mx, 32));
            const float mnew = fmaxf(mrun[nt], mx); const float alpha = __builtin_amdgcn_exp2f(mrun[nt] - mnew); mrun[nt] = mnew;
            float ps = 0.f;
#pragma unroll
            for (int kt = 0; kt < 4; ++kt)
#pragma unroll
                for (int i = 0; i < 4; ++i) { const float p = __builtin_amdgcn_exp2f(s[nt][kt][i] - mnew); s[nt][kt][i] = p; ps += p; }
            lsum[nt] = lsum[nt] * alpha + ps;
#pragma unroll
            for (int dt = 0; dt < 4; ++dt) o[nt][dt] = o[nt][dt] * alpha;
            pb[nt][0] = pack_frag(s[nt][0], s[nt][1]); pb[nt][1] = pack_frag(s[nt][2], s[nt][3]); }
#pragma unroll
        for (int dt = 0; dt < 4; ++dt)
#pragma unroll
            for (int kk = 0; kk < 2; ++kk) { const bf16x8 vf = frag_tr(Vs, 72, 32 * kk, 16 * dt, lane);
#pragma unroll
                for (int nt = 0; nt < 2; ++nt) o[nt][dt] = MFMA16(vf, pb[nt][kk], o[nt][dt]); }
        if (kb + 1 < nkb) { LAS bf16_t* Kn = (LAS bf16_t*)(lds + ((kb + 1) & 1) * 18432); *(LAS u32x4*)(Kn + soff) = kreg; *(LAS u32x4*)((LAS bf16_t*)((ldsp)Kn + 9216) + soff) = vreg; mcur[0] = mnx[0]; mcur[1] = mnx[1]; }
        if (kb + 2 < nkb) { const bf16_t* src = sbase + (size_t)(kb + 2) * 64 * EV_INP; kreg = *(const u32x4*)(src + ZC_K); vreg = *(const u32x4*)(src + ZC_V); mnx[0] = mrow[0][kb + 2]; mnx[1] = mrow[1][kb + 2]; }
        __syncthreads();
    }
#pragma unroll
    for (int nt = 0; nt < 2; ++nt) { float ls = lsum[nt]; ls += __shfl_xor(ls, 16); ls += __shfl_xor(ls, 32); const float inv = 1.0f / ls;
#pragma unroll
        for (int dt = 0; dt < 4; ++dt) { u32x2 wv; wv.x = cvt_pk_bf16(o[nt][dt][0] * inv, o[nt][dt][1] * inv); wv.y = cvt_pk_bf16(o[nt][dt][2] * inv, o[nt][dt][3] * inv);
            *(u32x2*)(Y0 + tokq[nt] * D + 512 + h * 64 + 16 * dt + 4 * g) = wv; } }
}
__device__ __forceinline__ void moe_route_block(const float* hbuf, const float* gain, const float* RT  , bf16_t* XN, unsigned* RE, f32x2* RW, unsigned* CNT, ldsp lds, int vb, int tid) {
    const int lane = tid & 63, w = __builtin_amdgcn_readfirstlane(tid >> 6), i16 = lane & 15, g = lane >> 4;
    LAS float* Yc = (LAS float*)lds; LAS float* Wc = (LAS float*)(lds + 33792); LAS float* PART = (LAS float*)(lds + 59136); LAS float* LG = (LAS float*)(lds + 71424); LAS unsigned* lcnt = (LAS unsigned*)(lds + 83712);
    __syncthreads();
    if (tid < 32) lcnt[tid] = 0u;
    for (int i = tid; i < 12 * 132; i += 512) Wc[36 * 132 + i] = 0.f;
    f32x4 y[8][4];
    { f32x4 gv[4];
#pragma unroll
      for (int j = 0; j < 4; ++j) gv[j] = *((const f32x4*)gain + lane + 64 * j);
#pragma unroll
      for (int t = 0; t < 8; ++t) { const size_t tok = (size_t)vb * 64 + w * 8 + t; const f32x4* xr = (const f32x4*)(hbuf + tok * D) + lane; float s = 0.f;
#pragma unroll
          for (int j = 0; j < 4; ++j) { y[t][j] = xr[64 * j]; s += (y[t][j][0] * y[t][j][0] + y[t][j][1] * y[t][j][1]) + (y[t][j][2] * y[t][j][2] + y[t][j][3] * y[t][j][3]); }
          const float rstd = 1.0f / sqrtf(wave_sum(s) * (1.0f / D) + RMS_EPS);
          u32x2* o8 = (u32x2*)(XN + tok * D) + lane;
#pragma unroll
          for (int j = 0; j < 4; ++j) { y[t][j] = y[t][j] * rstd * gv[j]; u32x2 wv; wv.x = cvt_pk_bf16(y[t][j][0], y[t][j][1]); wv.y = cvt_pk_bf16(y[t][j][2], y[t][j][3]); o8[64 * j] = wv; } } }
    f32x4 acc[3];
#pragma unroll
    for (int nt = 0; nt < 3; ++nt) acc[nt] = (f32x4){0.f, 0.f, 0.f, 0.f};
    const int tt4 = w & 3, kh = w >> 2;
#pragma unroll
    for (int c = 0; c < 8; ++c) {
        __syncthreads();
        if ((lane >> 5) == (c & 1)) {
#pragma unroll
            for (int t = 0; t < 8; ++t) *(LAS f32x4*)(Yc + (8 * w + t) * 132 + 4 * (lane & 31)) = y[t][c >> 1]; }
        for (int idx = tid; idx < 36 * 32; idx += 512) { const int row = idx >> 5, q = idx & 31; *(LAS f32x4*)(Wc + row * 132 + 4 * q) = *(const f32x4*)(RT + (size_t)row * D + 128 * c + 4 * q); }
        __syncthreads();
#pragma unroll
        for (int S = 0; S < 4; ++S) { const int k0 = 64 * kh + 16 * S + 4 * g;
            const f32x4 a = *(const LAS f32x4*)(Yc + (16 * tt4 + i16) * 132 + k0);
#pragma unroll
            for (int nt = 0; nt < 3; ++nt) { const f32x4 bq = *(const LAS f32x4*)(Wc + (16 * nt + i16) * 132 + k0);
#pragma unroll
                for (int e = 0; e < 4; ++e) acc[nt] = __builtin_amdgcn_mfma_f32_16x16x4f32(a[e], bq[e], acc[nt], 0, 0, 0); } }
    }
    if (kh == 1) {
#pragma unroll
        for (int nt = 0; nt < 3; ++nt) *(LAS f32x4*)(PART + ((tt4 * 3 + nt) * 64 + lane) * 4) = acc[nt]; }
    __syncthreads();
    if (kh == 0) {
#pragma unroll
        for (int nt = 0; nt < 3; ++nt) { const f32x4 p = *(const LAS f32x4*)(PART + ((tt4 * 3 + nt) * 64 + lane) * 4);
#pragma unroll
            for (int i = 0; i < 4; ++i) LG[(16 * tt4 + 4 * g + i) * 48 + 16 * nt + i16] = acc[nt][i] + p[i]; } }
    __syncthreads();
    if (tid < 64) {
        const LAS float* lg = LG + tid * 48; const size_t tok = (size_t)vb * 64 + tid;
        int gs = 0; float gm = lg[0];
#pragma unroll
        for (int i = 1; i < 4; ++i) if (lg[i] > gm) { gm = lg[i]; gs = i; }
        float den = 0.f;
#pragma unroll
        for (int i = 0; i < 4; ++i) den += __expf(lg[i] - gm);
        const float gw = 1.0f / den;
        int i1 = 0; float v1 = lg[4 + gs * 8];
#pragma unroll
        for (int i = 1; i < 8; ++i) { const float v = lg[4 + gs * 8 + i]; if (v > v1) { v1 = v; i1 = i; } }
        int i2 = -1; float v2 = -INFINITY;
#pragma unroll
        for (int i = 0; i < 8; ++i) { const float v = lg[4 + gs * 8 + i]; if (i != i1 && v > v2) { v2 = v; i2 = i; } }
        const float e2 = __expf(v2 - v1); const float w1 = gw / (1.0f + e2), w2 = gw * e2 / (1.0f + e2);
        const unsigned ex1 = gs * 8 + i1, ex2 = gs * 8 + i2;
        RE[tok] = ex1 | (ex2 << 8); RW[tok] = (f32x2){w1, w2};
        __hip_atomic_fetch_add(lcnt + ex1, 1u, __ATOMIC_RELAXED, __HIP_MEMORY_SCOPE_WORKGROUP); __hip_atomic_fetch_add(lcnt + ex2, 1u, __ATOMIC_RELAXED, __HIP_MEMORY_SCOPE_WORKGROUP);
    }
    __syncthreads();
    if (tid < 32) CNT[vb * 32 + tid] = lcnt[tid];
}
__device__ __forceinline__ void moe_scatter_block(const unsigned* RE, const unsigned* CNT, const bf16_t* XN, bf16_t* XS, unsigned* SLOT, int* TILEE, ldsp lds, int vb, int tid) {
    const int lane = tid & 63, w = __builtin_amdgcn_readfirstlane(tid >> 6);
    LAS unsigned* part = (LAS unsigned*)lds; LAS unsigned* tot = (LAS unsigned*)(lds + 4096); LAS unsigned* bef = tot + 32; LAS unsigned* base = tot + 64;
    LAS unsigned* ent = (LAS unsigned*)(lds + 4608); LAS unsigned* slots = (LAS unsigned*)(lds + 5120);
    __syncthreads();
    { const int e = tid & 31, pt = tid >> 5; unsigned st = 0, sb = 0;
        for (int i = 0; i < 16; ++i) { const int v = pt * 16 + i; const unsigned cval = CNT[v * 32 + e]; st += cval; if (v < vb) sb += cval; }
        part[(pt * 32 + e) * 2] = st; part[(pt * 32 + e) * 2 + 1] = sb; }
    if (tid < 128) { const unsigned r = RE[(size_t)vb * 64 + (tid >> 1)]; ent[tid] = (tid & 1) ? ((r >> 8) & 255u) : (r & 255u); }
    __syncthreads();
    if (tid < 32) { unsigned st = 0, sb = 0; for (int p = 0; p < 16; ++p) { st += part[(p * 32 + tid) * 2]; sb += part[(p * 32 + tid) * 2 + 1]; } tot[tid] = st; bef[tid] = sb; }
    __syncthreads();
    if (tid == 0) { unsigned acc = 0; for (int e = 0; e < 32; ++e) { base[e] = acc * 256u; const unsigned nt = (tot[e] + 255u) >> 8;
            if (vb == 0) for (unsigned i = 0; i < nt; ++i) TILEE[acc + i] = e;
            acc += nt; }
        if (vb == 0) TILEE[MOE_TILES] = (int)acc; }
    __syncthreads();
    if (tid < 128) { const unsigned e = ent[tid]; unsigned rank = 0; for (int i = 0; i < tid; ++i) rank += (ent[i] == e) ? 1u : 0u;
        const unsigned s = base[e] + bef[e] + rank; slots[tid] = s; SLOT[(size_t)vb * 128 + tid] = s; }
    __syncthreads();
    for (int t = 0; t < 8; ++t) { const int tl = w * 8 + t; const size_t tok = (size_t)vb * 64 + tl;
        const u32x4* src = (const u32x4*)(XN + tok * D) + lane; const u32x4 a = src[0], bq = src[64];
        const unsigned s0 = slots[2 * tl], s1 = slots[2 * tl + 1];
        u32x4* d0 = (u32x4*)(XS + (size_t)s0 * D) + lane; u32x4* d1 = (u32x4*)(XS + (size_t)s1 * D) + lane;
        d0[0] = a; d0[64] = bq; d1[0] = a; d1[64] = bq; }
}
__device__ __forceinline__ void moe_combine_token(float* hbuf, const bf16_t* YD, const unsigned* SLOT, const f32x2* RW, bf16_t* HB, const bf16_t* ERAW_, float* ERSTD_, size_t tok, int lane) {
    const unsigned s0 = SLOT[tok * 2], s1 = SLOT[tok * 2 + 1]; const f32x2 wv = RW[tok];
    f32x4* hr = (f32x4*)(hbuf + tok * D) + lane; const u32x2* y0 = (const u32x2*)(YD + (size_t)s0 * D) + lane; const u32x2* y1 = (const u32x2*)(YD + (size_t)s1 * D) + lane;
    u32x2* hb = (u32x2*)(HB + tok * D) + lane; const u32x2* er = (const u32x2*)(ERAW_ + tok * D) + lane;
    float es = 0.f;
#pragma unroll
    for (int j = 0; j < 4; ++j) { f32x4 v = hr[64 * j]; const u32x2 a = y0[64 * j], bq = y1[64 * j], e2 = er[64 * j];
        v[0] += wv[0] * bf_lo(a.x) + wv[1] * bf_lo(bq.x); v[1] += wv[0] * bf_hi(a.x) + wv[1] * bf_hi(bq.x); v[2] += wv[0] * bf_lo(a.y) + wv[1] * bf_lo(bq.y); v[3] += wv[0] * bf_hi(a.y) + wv[1] * bf_hi(bq.y);
        hr[64 * j] = v; u32x2 o; o.x = cvt_pk_bf16(v[0], v[1]); o.y = cvt_pk_bf16(v[2], v[3]); hb[64 * j] = o;
        es += (bf_lo(e2.x) * bf_lo(e2.x) + bf_hi(e2.x) * bf_hi(e2.x)) + (bf_lo(e2.y) * bf_lo(e2.y) + bf_hi(e2.y) * bf_hi(e2.y)); }
    es = wave_sum(es);
    if (lane == 0) ERSTD_[tok] = 1.0f / sqrtf(es * (1.0f / D) + RMS_EPS);
}
__device__ __forceinline__ float ret_log2g(int h) { const float x = __builtin_ldexpf(1.0f, -5 - h); const float ln = -(x + x * x * 0.5f + x * x * x * (1.0f / 3.0f) + x * x * x * x * 0.25f + x * x * x * x * x * 0.2f + x * x * x * x * x * x * (1.0f / 6.0f)); return ln * LOG2E; }
__device__ __forceinline__ void ret_kv_unit(const bf16_t* Z1, float* SKV, ldsp lds, int b, int h, int sc, int tid) {
    const int lane = tid & 63, w = __builtin_amdgcn_readfirstlane(tid >> 6), i16 = lane & 15, g = lane >> 4;
    LAS bf16_t* Vs = (LAS bf16_t*)lds; LAS bf16_t* Ks = (LAS bf16_t*)(lds + 33792);
    const float l2g = ret_log2g(h);
    f32x4 acc[2][8];
#pragma unroll
    for (int mt = 0; mt < 2; ++mt)
#pragma unroll
        for (int nt = 0; nt < 8; ++nt) acc[mt][nt] = (f32x4){0.f, 0.f, 0.f, 0.f};
    const size_t tok0 = (size_t)b * SEQ + (size_t)sc * 256;
    for (int jb = 0; jb < 4; ++jb) {
        __syncthreads();
#pragma unroll
        for (int q = 0; q < 4; ++q) { const int idx = tid + 512 * q, row = idx >> 5, chn = idx & 31;
            *(LAS u32x4*)(Vs + row * 264 + chn * 8) = *(const u32x4*)(Z1 + (tok0 + jb * 64 + row) * OD_IN + 2048 + h * 256 + chn * 8); }
#pragma unroll
        for (int q = 0; q < 2; ++q) { const int idx = tid + 512 * q, row = idx >> 4, chn = idx & 15;
            const u32x4 kw = *(const u32x4*)(Z1 + (tok0 + jb * 64 + row) * OD_IN + 1024 + h * 128 + chn * 8);
            const float dk = exp2f(l2g * (float)(255 - (jb * 64 + row)));
            u32x4 o; o.x = cvt_pk_bf16(bf_lo(kw.x) * dk, bf_hi(kw.x) * dk); o.y = cvt_pk_bf16(bf_lo(kw.y) * dk, bf_hi(kw.y) * dk); o.z = cvt_pk_bf16(bf_lo(kw.z) * dk, bf_hi(kw.z) * dk); o.w = cvt_pk_bf16(bf_lo(kw.w) * dk, bf_hi(kw.w) * dk);
            *(LAS u32x4*)(Ks + row * 136 + chn * 8) = o; }
        __syncthreads();
#pragma unroll
        for (int kk = 0; kk < 2; ++kk) {
            bf16x8 af[2];
#pragma unroll
            for (int mt = 0; mt < 2; ++mt) af[mt] = frag_tr(Vs, 264, 32 * kk, 32 * w + 16 * mt, lane);
#pragma unroll
            for (int nt = 0; nt < 8; ++nt) { const bf16x8 bfr = frag_tr(Ks, 136, 32 * kk, 16 * nt, lane);
#pragma unroll
                for (int mt = 0; mt < 2; ++mt) acc[mt][nt] = MFMA16(af[mt], bfr, acc[mt][nt]); }
        }
    }
    float* out = SKV + ((size_t)((b * 8 + h) * 16 + sc)) * 32768;
#pragma unroll
    for (int mt = 0; mt < 2; ++mt)
#pragma unroll
        for (int nt = 0; nt < 8; ++nt)
#pragma unroll
            for (int i = 0; i < 4; ++i) out[(size_t)(32 * w + 16 * mt + 4 * g + i) * 128 + 16 * nt + i16] = acc[mt][nt][i];
}
__device__ __forceinline__ void ret_out_unit(const bf16_t* Z1, const bf16_t* SST, const float* gn_g, bf16_t* Y, ldsp lds, int b, int h, int sc, int tid) {
    const int lane = tid & 63, w = __builtin_amdgcn_readfirstlane(tid >> 6), i16 = lane & 15, g = lane >> 4;
    const float l2g = ret_log2g(h);
    const size_t tok0 = (size_t)b * SEQ + (size_t)sc * 256;
    int ipos[2], blk[2];
#pragma unroll
    for (int nt = 0; nt < 2; ++nt) { const int tq = nt ? 15 - w : w; ipos[nt] = 16 * tq + i16; blk[nt] = tq >> 2; }
#define RET_QF(dst, nt_) do { _Pragma("unroll") for (int ks = 0; ks < 4; ++ks) dst[ks] = *(const bf16x8*)(Z1 + (tok0 + ipos[nt_]) * OD_IN + h * 128 + 32 * ks + 8 * g); } while (0)
    f32x4 o[2][16];
#pragma unroll
    for (int nt = 0; nt < 2; ++nt)
#pragma unroll
        for (int et = 0; et < 16; ++et) o[nt][et] = (f32x4){0.f, 0.f, 0.f, 0.f};
    u32x4 vr[4], kr[2];
#define RET_LOAD(jb_) do { unsigned t_ = (unsigned)tid; asm volatile("" : "+v"(t_));     \
        const char* vb_ = (const char*)(Z1 + (tok0 + (jb_) * 64) * OD_IN + 2048 + h * 256); const char* kb_ = (const char*)(Z1 + (tok0 + (jb_) * 64) * OD_IN + 1024 + h * 128); \
        _Pragma("unroll") for (int q = 0; q < 4; ++q) { const unsigned idx = t_ + 512u * q, row = idx >> 5, chn = idx & 31u; vr[q] = *(const u32x4*)(vb_ + (size_t)((row * OD_IN + chn * 8u) * 2u)); } \
        _Pragma("unroll") for (int q = 0; q < 2; ++q) { const unsigned idx = t_ + 512u * q, row = idx >> 4, chn = idx & 15u; kr[q] = *(const u32x4*)(kb_ + (size_t)((row * OD_IN + chn * 8u) * 2u)); } } while (0)
#define RET_STORE(buf_) do { LAS bf16_t* Vw = (LAS bf16_t*)(lds + (buf_) * 51200); LAS bf16_t* Kw = (LAS bf16_t*)(lds + (buf_) * 51200 + 33792); \
        _Pragma("unroll") for (int q = 0; q < 4; ++q) { const int idx = tid + 512 * q, row = idx >> 5, chn = idx & 31; *(LAS u32x4*)(Vw + row * 264 + chn * 8) = vr[q]; } \
        _Pragma("unroll") for (int q = 0; q < 2; ++q) { const int idx = tid + 512 * q, row = idx >> 4, chn = idx & 15; *(LAS u32x4*)(Kw + row * 136 + chn * 8) = kr[q]; } } while (0)
    __syncthreads();
    RET_LOAD(0); RET_STORE(0); RET_LOAD(1);
    const bf16_t* S = SST + ((size_t)((b * 8 + h) * 16 + sc)) * 32768;
    { bf16x8 qf[2][4]; RET_QF(qf[0], 0); RET_QF(qf[1], 1);
      unsigned soff = (unsigned)((i16 * 128 + 8 * g) * 2); asm volatile("" : "+v"(soff));
#pragma unroll
    for (int et = 0; et < 16; ++et) {
        if ((et & 1) == 0) asm volatile("" ::: "memory");
#pragma unroll
        for (int ks = 0; ks < 4; ++ks) { const bf16x8 a = *(const bf16x8*)((const char*)S + (size_t)(soff + (unsigned)((16 * et * 128 + 32 * ks) * 2)));
#pragma unroll
            for (int nt = 0; nt < 2; ++nt) o[nt][et] = MFMA16(a, qf[nt][ks], o[nt][et]); } } }
    asm volatile("" ::: "memory");
#pragma unroll
    for (int nt = 0; nt < 2; ++nt) { const float dq = __builtin_amdgcn_exp2f(l2g * (float)(ipos[nt] + 1));
#pragma unroll
        for (int et = 0; et < 16; ++et) o[nt][et] = o[nt][et] * dq; }
    __syncthreads();
#pragma unroll 1
    for (int jb = 0; jb < 4; ++jb) {
        const LAS bf16_t* Vs = (const LAS bf16_t*)(lds + (jb & 1) * 51200); const LAS bf16_t* Ks = (const LAS bf16_t*)(lds + (jb & 1) * 51200 + 33792);
        const bool act0 = jb <= blk[0], act1 = jb <= blk[1];
        bf16x8 pb[2][2];
#pragma unroll
        for (int nt = 0; nt < 2; ++nt) if (nt ? act1 : act0) {
            bf16x8 qf1[4]; RET_QF(qf1, nt);
            f32x4 s[4];
#pragma unroll
            for (int kt = 0; kt < 4; ++kt) { f32x4 a4 = (f32x4){0.f, 0.f, 0.f, 0.f};
#pragma unroll
                for (int ks = 0; ks < 4; ++ks) { const bf16x8 a = *(const LAS bf16x8*)(Ks + (kt * 16 + i16) * 136 + 32 * ks + 8 * g); a4 = MFMA16(a, qf1[ks], a4); }
#pragma unroll
                for (int i = 0; i < 4; ++i) { const int j = jb * 64 + kt * 16 + 4 * g + i; const int df = ipos[nt] - j; a4[i] = (df >= 0) ? a4[i] * __builtin_amdgcn_exp2f(l2g * (float)df) : 0.f; }
                s[kt] = a4; }
            pb[nt][0] = pack_frag(s[0], s[1]); pb[nt][1] = pack_frag(s[2], s[3]); }
        asm volatile("" ::: "memory");
        if (act0 || act1) {
#pragma unroll
            for (int et = 0; et < 16; ++et)
#pragma unroll
                for (int kk = 0; kk < 2; ++kk) { const bf16x8 vf = frag_tr(Vs, 264, 32 * kk, 16 * et, lane);
                    if (act0) o[0][et] = MFMA16(vf, pb[0][kk], o[0][et]);
                    if (act1) o[1][et] = MFMA16(vf, pb[1][kk], o[1][et]); } }
        if (jb + 1 < 4) RET_STORE((jb + 1) & 1);
        if (jb + 2 < 4) RET_LOAD(jb + 2);
        __syncthreads();
    }
#undef RET_LOAD
#undef RET_STORE
#undef RET_QF
#pragma unroll
    for (int nt = 0; nt < 2; ++nt) {
        int l2 = lane; asm volatile("" : "+v"(l2)); const int g = l2 >> 4;
        const size_t tokq = tok0 + 16 * (nt ? 15 - w : w) + (l2 & 15);
        float sm = 0.f;
#pragma unroll
        for (int et = 0; et < 16; ++et) sm += (o[nt][et][0] + o[nt][et][1]) + (o[nt][et][2] + o[nt][et][3]);
        sm += __shfl_xor(sm, 16); sm += __shfl_xor(sm, 32);
        const float mean = sm * (1.0f / 256.0f); float vq = 0.f;
#pragma unroll
        for (int et = 0; et < 16; ++et) { const f32x4 dd = o[nt][et] - mean; vq += (dd[0] * dd[0] + dd[1] * dd[1]) + (dd[2] * dd[2] + dd[3] * dd[3]); }
        vq += __shfl_xor(vq, 16); vq += __shfl_xor(vq, 32);
        const float rstd = 1.0f / sqrtf(vq * (1.0f / 256.0f) + GN_EPS);
#pragma unroll
        for (int et = 0; et < 16; ++et) { const int e0 = h * 256 + 16 * et + 4 * g;
            const f32x4 gn = *(const f32x4*)(gn_g + e0); const u32x2 gw = *(const u32x2*)(Z1 + tokq * OD_IN + 4096 + e0);
            const float y0 = (o[nt][et][0] - mean) * rstd * gn[0] * siluf_(bf_lo(gw.x)), y1 = (o[nt][et][1] - mean) * rstd * gn[1] * siluf_(bf_hi(gw.x));
            const float y2 = (o[nt][et][2] - mean) * rstd * gn[2] * siluf_(bf_lo(gw.y)), y3 = (o[nt][et][3] - mean) * rstd * gn[3] * siluf_(bf_hi(gw.y));
            u32x2 ov; ov.x = cvt_pk_bf16(y0, y1); ov.y = cvt_pk_bf16(y2, y3); *(u32x2*)(Y + tokq * 2048 + e0) = ov; } }
}
enum InIdx { I_X = 0, I_P, I_RELB, I_MIXG, I_FFNG, I_PLEG, I_EVWIN, I_CONVW, I_CONVB, I_WA, I_BA, I_WX, I_BX, I_LAM, I_QG, I_KG, I_EVWOUT, I_ODWIN, I_GNG, I_ODWOUT,
             I_WGROUP, I_WEXPERT, I_WGATE, I_WUP, I_WDOWN, I_PLEUP, I_PLEGATE, N_IN };
struct Args { const float* in[N_IN]; float* out; unsigned char* ws; int ph_lo, ph_hi, flags, pad; };
static_assert(sizeof(Args) == N_IN * 8 + 8 + 8 + 16, "Args has no padding");
constexpr int N_PHASES = 24;

__global__ void __launch_bounds__(512, 2) mk_fwd(Args args) {
    extern __shared__ __attribute__((aligned(16))) unsigned char lds_raw[];
    const ldsp lds = (ldsp)lds_raw;
    volatile LAS unsigned* MISC = (volatile LAS unsigned*)(lds + LDS_MISC_OFF);
    const int tid = threadIdx.x, lane = tid & 63, wave = __builtin_amdgcn_readfirstlane(tid >> 6);
    const int G = gridDim.x, bid = blockIdx.x;
    const int gw = bid * 8 + wave, ngw = G * 8;
    unsigned char* ws0 = args.ws;
#define FRESH_WS() size_t wsz_ = 0; asm volatile("" : "+s"(wsz_)); unsigned char* ws = ws0 + wsz_
    for (int u = tid; u < 64; u += 512) MISC[u] = 0u;
    __syncthreads();
#if MK_N_LAUNCHES == 1
    XcdBarrier bar = xcd_barrier_post((unsigned*)(ws0 + WS_CTL) + CW_BAR, MISC + 8);
#define GRID_BAR() xcd_barrier(bar)
#else
#define GRID_BAR() do { } while (0)
#endif
    const int lo = args.ph_lo, hi = args.ph_hi;
#ifndef ONLY_PHASE
#define ONLY_PHASE (-1)
#endif
#define IN(k) ((ONLY_PHASE < 0 || ONLY_PHASE == (k)) && lo <= (k) && (k) < hi)
#define SEAM(k) do { if (IN(k) && IN((k) + 1)) GRID_BAR(); } while (0)

    const float* x = args.in[I_X]; float* hbuf = args.out;
#define XN ((bf16_t*)(ws + WS_XN))
#define PB ((bf16_t*)(ws + WS_PB))
#define ERAW ((bf16_t*)(ws + WS_ERAW))
#define ESS ((float*)(ws + MS_ESS))
#define ERSTD ((float*)(ws + MS_ERSTD))
#define Z ((bf16_t*)(ws + WS_Z))
#define Y ((bf16_t*)(ws + WS_Y))
#define ROPE ((float*)(ws + WS_ROPE))
#define RT ((float*)(ws + WS_RT))
#define W_GU ((bf16_t*)(ws + WS_W_GU))
#define W_DN ((bf16_t*)(ws + WS_W_DN))
    LAS float* scr = (LAS float*)(lds + wave * 16640);

    if (IN(0)) { FRESH_WS();
        tr_matrix<0>(args.in[I_EVWIN], nullptr, D, EV_IN, (bf16_t*)(ws + WS_W_EVIN), EV_INP, scr, lane, gw, ngw);
        tr_matrix<0>(args.in[I_EVWOUT], nullptr, D, D, (bf16_t*)(ws + WS_W_EVOUT), D, scr, lane, gw, ngw);
        tr_matrix<1>(args.in[I_ODWIN], nullptr, D, OD_IN, (bf16_t*)(ws + WS_W_ODIN), OD_IN, scr, lane, gw, ngw);
        tr_matrix<0>(args.in[I_ODWOUT], nullptr, 2048, D, (bf16_t*)(ws + WS_W_ODOUT), D, scr, lane, gw, ngw);
        for (int l = 0; l < 2; ++l) {
            tr_matrix<0>(args.in[I_PLEUP] + (size_t)l * PLE * D, nullptr, PLE, D, (bf16_t*)(ws + WS_W_PLEUP) + (size_t)l * D * PLE, D, scr, lane, gw, ngw);
            tr_matrix<0>(args.in[I_PLEGATE] + (size_t)l * D * D, nullptr, D, D, (bf16_t*)(ws + WS_W_PLEGATE) + (size_t)l * D * D, D, scr, lane, gw, ngw); }
        convert_moe_layer(args.in[I_WGATE], args.in[I_WUP], args.in[I_WDOWN], W_GU, W_DN, scr, lane, gw, ngw);
        for (int m = gw; m < M; m += ngw) rms_row_to_bf16(x + (size_t)m * D, args.in[I_MIXG], XN + (size_t)m * D, lane);
        { const float* p = args.in[I_P]; const size_t n4 = (size_t)2 * M * PLE / 4;
          for (size_t i = (size_t)bid * 512 + tid; i < n4; i += (size_t)G * 512) { const f32x4 v = ((const f32x4*)p)[i]; u32x2 o; o.x = cvt_pk_bf16(v[0], v[1]); o.y = cvt_pk_bf16(v[2], v[3]); ((u32x2*)PB)[i] = o; } }
        for (int i = bid * 512 + tid; i < SEQ * 64; i += G * 512) { const int pos = i >> 6, f = i & 63;
            const float inv = powf(10000.0f, -(float)f / 64.0f); const float ang = (float)pos * inv; ROPE[i] = cosf(ang); ROPE[SEQ * 64 + i] = sinf(ang); }
        for (int i = bid * 512 + tid; i < 2 * 36 * D; i += G * 512) { const int l = i / (36 * D), r = i % (36 * D), o = r / D, k = r % D;
            RT[i] = (o < 4) ? args.in[I_WGROUP][(size_t)l * D * 4 + k * 4 + o] : args.in[I_WEXPERT][(size_t)l * D * 32 + k * 32 + (o - 4)]; }
    }
    SEAM(0);
    if (IN(1)) { FRESH_WS();
        { pg8::Gemm gm{XN, (const bf16_t*)(ws + WS_W_EVIN), M, EV_INP, D}; pg8::StaticOrder S; S.init(M, EV_INP, G, bid); EpiPlainBf16<EV_INP, 13> E{Z};
          pg8::gemm_phase<EpiPlainBf16<EV_INP, 13>, pg8::StaticOrder>(lds, gm, S, E, nullptr); }
        __syncthreads();
        { pg8::Gemm gm{PB, (const bf16_t*)(ws + WS_W_PLEUP), M, D, PLE}; pg8::StaticOrder S; S.init(M, D, G, bid); EpiPlainBf16<D, 4> E{ERAW};
          pg8::gemm_phase<EpiPlainBf16<D, 4>, pg8::StaticOrder>(lds, gm, S, E, nullptr); }
    }
    SEAM(1);
    if (IN(2)) { FRESH_WS();
        for (int u = bid; u < 256; u += G)
            lru_local_unit(Z, args.in[I_CONVW], args.in[I_CONVB], args.in[I_WA], args.in[I_BA], args.in[I_WX], args.in[I_BX], args.in[I_LAM],
                           (float*)(ws + WS_HLOC), (float*)(ws + WS_PCUM), (float*)(ws + MS_SUMA), (float*)(ws + MS_SUMH), lds, u >> 6, u & 63, tid);
        if (!(args.flags & 1)) for (int m = gw; m < M; m += ngw) dsa_prep_token(Z, args.in[I_QG], args.in[I_KG], (size_t)m, lane);
    }
    SEAM(2);
    if (IN(3)) { FRESH_WS();
        for (int idx = bid; idx < 1024; idx += G) { const int r = idx >> 8, v = idx & 255; const int qt = (r & 1) ? 255 - v : v;
            dsa_select_unit(Z, (unsigned*)(ws + ((args.flags & 1) ? WS_Y + 32 * MiB : WS_MASK)), lds, r, qt, tid, args.flags); }
    }
    SEAM(3);
    if (IN(4)) { FRESH_WS();
        for (int idx = bid; idx < 512; idx += G) { const int r = idx >> 8, v = idx & 255; const int bh = v >> 3; const int qt = r ? 15 - (v & 7) : (v & 7);
            dsa_attn_unit(Z, (const unsigned*)(ws + WS_MASK), args.in[I_RELB], Y, lds, bh >> 3, bh & 7, qt, tid); }
        __syncthreads();
        for (int u = bid; u < 256; u += G)
            lru_fix_unit(Z, (const float*)(ws + WS_HLOC), (const float*)(ws + WS_PCUM), (const float*)(ws + MS_SUMA), (const float*)(ws + MS_SUMH), Y, u >> 6, u & 63, tid);
    }
    SEAM(4);
    if (IN(5)) { FRESH_WS();
        __syncthreads();
        pg8::Gemm gm{Y, (const bf16_t*)(ws + WS_W_EVOUT), M, D, D}; pg8::StaticOrder S; S.init(M, D, G, bid); EpiResid E{x, hbuf};
        pg8::gemm_phase<EpiResid, pg8::StaticOrder>(lds, gm, S, E, nullptr);
    }
    SEAM(5);
    if (IN(6 + 0)) { FRESH_WS();
        __syncthreads();
        if (false) convert_moe_layer(args.in[I_WGATE] + (size_t)NEXP * D * FF, args.in[I_WUP] + (size_t)NEXP * D * FF, args.in[I_WDOWN] + (size_t)NEXP * FF * D, W_GU, W_DN, scr, lane, gw, ngw);
        for (int vb = bid; vb < 256; vb += G)
            moe_route_block(hbuf, args.in[I_FFNG] + 0 * D, RT + (size_t)0 * 36 * D, XN, (unsigned*)(ws + MS_RE), (f32x2*)(ws + MS_RW), (unsigned*)(ws + MS_CNT), lds, vb, tid);
    }
    SEAM(6 + 0);
    if (IN(6 + 1)) { FRESH_WS(); for (int vb = bid; vb < 256; vb += G) moe_scatter_block((const unsigned*)(ws + MS_RE), (const unsigned*)(ws + MS_CNT), XN, (bf16_t*)(ws + WS_XS), (unsigned*)(ws + MS_SLOT), (int*)(ws + MS_TILEE), lds, vb, tid); }
    SEAM(6 + 1);
    if (IN(6 + 2)) { FRESH_WS();
        __syncthreads();
        pg8::Gemm gm{(const bf16_t*)(ws + WS_XS), W_GU, MOE_ROWS, NEXP * 1024, D}; MoeOrder S; S.init((const int*)(ws + MS_TILEE), G, bid); EpiSwiglu E{Y};
        pg8::gemm_phase<EpiSwiglu, MoeOrder>(lds, gm, S, E, nullptr);
    }
    SEAM(6 + 2);
    if (IN(6 + 3)) { FRESH_WS();
        __syncthreads();
        pg8::Gemm gm{Y, W_DN, MOE_ROWS, NEXP * 1024, FF}; MoeOrder S; S.init((const int*)(ws + MS_TILEE), G, bid); EpiPlainBf16<D, 4> E{(bf16_t*)(ws + WS_YD)};
        pg8::gemm_phase<EpiPlainBf16<D, 4>, MoeOrder>(lds, gm, S, E, nullptr);
    }
    SEAM(6 + 3);
    if (IN(6 + 4)) { FRESH_WS(); for (int m = gw; m < M; m += ngw) moe_combine_token(hbuf, (const bf16_t*)(ws + WS_YD), (const unsigned*)(ws + MS_SLOT), (const f32x2*)(ws + MS_RW), XN, ERAW, ERSTD, (size_t)m, lane); }
    SEAM(6 + 4);
    if (IN(6 + 5)) { FRESH_WS();
        __syncthreads();
        pg8::Gemm gm{XN, (const bf16_t*)(ws + WS_W_PLEGATE) + (size_t)0 * D * D, M, D, D}; pg8::StaticOrder S; S.init(M, D, G, bid); EpiPleGate E{hbuf, ERAW, ERSTD, args.in[I_PLEG] + 0 * D};
        pg8::gemm_phase<EpiPleGate, pg8::StaticOrder>(lds, gm, S, E, nullptr);
    }
    SEAM(11);
        if (IN(12)) { FRESH_WS(); for (int m = gw; m < M; m += ngw) rms_row_to_bf16(hbuf + (size_t)m * D, args.in[I_MIXG] + D, XN + (size_t)m * D, lane); }
        SEAM(12);
        if (IN(13)) { FRESH_WS();
            __syncthreads();
            { pg8::Gemm gm{XN, (const bf16_t*)(ws + WS_W_ODIN), M, OD_IN, D}; pg8::StaticOrder S; S.init(M, OD_IN, G, bid); EpiRet E{Z, ROPE};
              pg8::gemm_phase<EpiRet, pg8::StaticOrder>(lds, gm, S, E, nullptr); }
            __syncthreads();
            { pg8::Gemm gm{PB + (size_t)M * PLE, (const bf16_t*)(ws + WS_W_PLEUP) + (size_t)D * PLE, M, D, PLE}; pg8::StaticOrder S; S.init(M, D, G, bid); EpiPlainBf16<D, 4> E{ERAW};
              pg8::gemm_phase<EpiPlainBf16<D, 4>, pg8::StaticOrder>(lds, gm, S, E, nullptr); }
        }
        SEAM(13);
        if (IN(14)) { FRESH_WS(); for (int u = bid; u < 512; u += G) ret_kv_unit(Z, (float*)(ws + WS_W_GU), lds, u >> 7, (u >> 4) & 7, u & 15, tid); }
        SEAM(14);
        if (IN(15)) { FRESH_WS();
            const float* SKV = (const float*)(ws + WS_W_GU); bf16_t* SST = (bf16_t*)(ws + WS_W_DN);
            for (int i = bid * 512 + tid; i < 32 * 32768; i += G * 512) { const int bh = i >> 15, el = i & 32767; const float g256 = exp2f(ret_log2g(bh & 7) * 256.0f); float run = 0.f;
#pragma unroll 4
                for (int sc = 0; sc < 16; ++sc) { const size_t o = ((size_t)(bh * 16 + sc)) * 32768 + el; const float v = SKV[o]; SST[o] = (bf16_t)(cvt_pk_bf16(run, 0.f) & 0xffffu); run = run * g256 + v; } }
        }
        SEAM(15);
        if (IN(16)) { FRESH_WS();
            for (int u = bid; u < 512; u += G) ret_out_unit(Z, (const bf16_t*)(ws + WS_W_DN), args.in[I_GNG], Y, lds, u >> 7, (u >> 4) & 7, u & 15, tid);
            __syncthreads();
        }
        SEAM(16);
        if (IN(17)) { FRESH_WS();
            __syncthreads();
            pg8::Gemm gm{Y, (const bf16_t*)(ws + WS_W_ODOUT), M, D, 2048}; pg8::StaticOrder S; S.init(M, D, G, bid); EpiResid E{hbuf, hbuf};
            pg8::gemm_phase<EpiResid, pg8::StaticOrder>(lds, gm, S, E, nullptr);
        }
        SEAM(17);
    if (IN(18 + 0)) { FRESH_WS();
        __syncthreads();
        convert_moe_layer(args.in[I_WGATE] + (size_t)NEXP * D * FF, args.in[I_WUP] + (size_t)NEXP * D * FF, args.in[I_WDOWN] + (size_t)NEXP * FF * D, W_GU, W_DN, scr, lane, gw, ngw);
        for (int vb = bid; vb < 256; vb += G)
            moe_route_block(hbuf, args.in[I_FFNG] + 1 * D, RT + (size_t)1 * 36 * D, XN, (unsigned*)(ws + MS_RE), (f32x2*)(ws + MS_RW), (unsigned*)(ws + MS_CNT), lds, vb, tid);
    }
    SEAM(18 + 0);
    if (IN(18 + 1)) { FRESH_WS(); for (int vb = bid; vb < 256; vb += G) moe_scatter_block((const unsigned*)(ws + MS_RE), (const unsigned*)(ws + MS_CNT), XN, (bf16_t*)(ws + WS_XS), (unsigned*)(ws + MS_SLOT), (int*)(ws + MS_TILEE), lds, vb, tid); }
    SEAM(18 + 1);
    if (IN(18 + 2)) { FRESH_WS();
        __syncthreads();
        pg8::Gemm gm{(const bf16_t*)(ws + WS_XS), W_GU, MOE_ROWS, NEXP * 1024, D}; MoeOrder S; S.init((const int*)(ws + MS_TILEE), G, bid); EpiSwiglu E{Y};
        pg8::gemm_phase<EpiSwiglu, MoeOrder>(lds, gm, S, E, nullptr);
    }
    SEAM(18 + 2);
    if (IN(18 + 3)) { FRESH_WS();
        __syncthreads();
        pg8::Gemm gm{Y, W_DN, MOE_ROWS, NEXP * 1024, FF}; MoeOrder S; S.init((const int*)(ws + MS_TILEE), G, bid); EpiPlainBf16<D, 4> E{(bf16_t*)(ws + WS_YD)};
        pg8::gemm_phase<EpiPlainBf16<D, 4>, MoeOrder>(lds, gm, S, E, nullptr);
    }
    SEAM(18 + 3);
    if (IN(18 + 4)) { FRESH_WS(); for (int m = gw; m < M; m += ngw) moe_combine_token(hbuf, (const bf16_t*)(ws + WS_YD), (const unsigned*)(ws + MS_SLOT), (const f32x2*)(ws + MS_RW), XN, ERAW, ERSTD, (size_t)m, lane); }
    SEAM(18 + 4);
    if (IN(18 + 5)) { FRESH_WS();
        __syncthreads();
        pg8::Gemm gm{XN, (const bf16_t*)(ws + WS_W_PLEGATE) + (size_t)1 * D * D, M, D, D}; pg8::StaticOrder S; S.init(M, D, G, bid); EpiPleGate E{hbuf, ERAW, ERSTD, args.in[I_PLEG] + 1 * D};
        pg8::gemm_phase<EpiPleGate, pg8::StaticOrder>(lds, gm, S, E, nullptr);
    }
}

extern "C" void kernel_launch(void* const* d_in, const int* in_sizes, int n_in, void* d_out, int out_size, void* d_ws, size_t ws_size, hipStream_t stream) {
    static int grid = 0;
    if (grid == 0) {
        if (n_in != N_IN || out_size != M * D || ws_size < WS_END) { fprintf(stderr, "kernel_launch: unexpected problem (n_in %d, out %d, ws %zu)\n", n_in, out_size, ws_size); grid = -1; return; }
        int dev = 0, cus = 0, per_cu = 0;
        if (hipGetDevice(&dev) != hipSuccess || hipDeviceGetAttribute(&cus, hipDeviceAttributeMultiprocessorCount, dev) != hipSuccess) { grid = -1; return; }
        if (hipFuncSetAttribute((const void*)mk_fwd, hipFuncAttributeMaxDynamicSharedMemorySize, LDS_BYTES) != hipSuccess) { fprintf(stderr, "kernel_launch: hipFuncSetAttribute failed\n"); grid = -1; return; }
        if (hipOccupancyMaxActiveBlocksPerMultiprocessor(&per_cu, (const void*)mk_fwd, 512, LDS_BYTES) != hipSuccess || per_cu < 1) fprintf(stderr, "kernel_launch: occupancy query reports %d\n", per_cu);
        (void)hipGetLastError();
        grid = cus;
    }
    if (grid < 0) return;
    (void)hipMemsetAsync((char*)d_ws + WS_CTL, 0, CTL_ZERO_BYTES, stream);
    Args a{};
    for (int i = 0; i < N_IN; ++i) a.in[i] = (const float*)d_in[i];
    a.out = (float*)d_out; a.ws = (unsigned char*)d_ws;
#if MK_N_LAUNCHES == 1
    a.ph_lo = 0; a.ph_hi = N_PHASES;
    hipLaunchKernelGGL(mk_fwd, dim3(grid), dim3(512), LDS_BYTES, stream, a);
#else
    for (int p = 0; p < N_PHASES; ++p) { a.ph_lo = p; a.ph_hi = p + 1; a.flags = 0; hipLaunchKernelGGL(mk_fwd, dim3(grid), dim3(512), LDS_BYTES, stream, a);
#if defined(PROBE_PHASE)
#ifndef PROBE_FLAGS
#define PROBE_FLAGS 0
#endif
        if (p == PROBE_PHASE) { a.flags = 1 | PROBE_FLAGS; for (int r = 0; r < PROBE_REPS; ++r) hipLaunchKernelGGL(mk_fwd, dim3(grid), dim3(512), LDS_BYTES, stream, a); }
#endif
    }
#endif
}
```

```cpp
#include <hip/hip_runtime.h>
#include <cstdio>
#include <cstdint>

#define GAS __attribute__((address_space(1)))
#define LAS __attribute__((address_space(3)))
#ifndef MK_N_LAUNCHES
#define MK_N_LAUNCHES 1
#endif

constexpr int D = 1024, BATCH = 4, SEQ = 4096, M = BATCH * SEQ, PLE = 256;
constexpr int EV_IN = 3144, EV_INP = 3328;
constexpr int OD_IN = 6144;
constexpr int ZC_XA = 0, ZC_GA = 512, ZC_Q = 1024, ZC_K = 1536, ZC_V = 2048, ZC_IQ = 2560, ZC_IK = 3072, ZC_IW = 3136;
constexpr int NEXP = 32, FF = 512;
constexpr int MOE_ROWS = 40960, MOE_TILES = 160;
constexpr float RMS_EPS = 1e-6f, GN_EPS = 1e-5f;
constexpr float LOG2E = 1.4426950408889634f;

constexpr size_t MiB = 1u << 20;
constexpr size_t WS_CTL = 0, CTL_ZERO_BYTES = 1 * MiB;
constexpr size_t WS_RT = 1 * MiB;
constexpr size_t WS_ROPE = 2 * MiB;
constexpr size_t WS_W_EVIN = 4 * MiB;
constexpr size_t WS_W_EVOUT = 11 * MiB;
constexpr size_t WS_W_ODIN = 13 * MiB;
constexpr size_t WS_W_ODOUT = 25 * MiB;
constexpr size_t WS_W_PLEUP = 29 * MiB;
constexpr size_t WS_W_PLEGATE = 30 * MiB;
constexpr size_t WS_W_GU = 34 * MiB;
constexpr size_t WS_W_DN = 98 * MiB;
constexpr size_t WS_XN = 130 * MiB;
constexpr size_t WS_PB = 162 * MiB;
constexpr size_t WS_ERAW = 178 * MiB;
constexpr size_t WS_MISC = 210 * MiB;
constexpr size_t WS_MASK = 214 * MiB;
constexpr size_t WS_Y = 222 * MiB;
constexpr size_t WS_Z = 286 * MiB;
constexpr size_t WS_XS = WS_Z, WS_YD = WS_Z + 80 * MiB;
constexpr size_t WS_HLOC = WS_Z + 104 * MiB, WS_PCUM = WS_HLOC + 32 * MiB;
constexpr size_t WS_HB = 446 * MiB;
constexpr size_t WS_HA = 478 * MiB;
constexpr size_t WS_END = 510 * MiB;
constexpr size_t MS_ESS = WS_MISC, MS_ERSTD = WS_MISC + 1 * MiB, MS_RE = MS_ERSTD + 65536, MS_RW = MS_RE + 65536, MS_SLOT = MS_RW + 131072, MS_CNT = MS_SLOT + 131072,
                 MS_TILEE = MS_CNT + 32768, MS_SUMA = MS_TILEE + 4096, MS_SUMH = MS_SUMA + 524288;
static_assert(MS_SUMH + 524288 <= WS_MASK, "misc map");
constexpr int CW_BAR = 4096;

constexpr int LDS_BYTES = 147456;
constexpr int LDS_MISC_OFF = 144 * 1024 - 256;

typedef unsigned short bf16_t;
typedef short bf16x8 __attribute__((ext_vector_type(8)));
typedef short s16x4 __attribute__((ext_vector_type(4)));
typedef float f32x4 __attribute__((ext_vector_type(4)));
typedef float f32x2 __attribute__((ext_vector_type(2)));
typedef unsigned u32x4 __attribute__((ext_vector_type(4)));
typedef unsigned u32x2 __attribute__((ext_vector_type(2)));
typedef LAS unsigned char* ldsp;
namespace pg8 {
#define PG8_LAS __attribute__((address_space(3)))
typedef unsigned short bf16_t;
typedef short bf16x8 __attribute__((ext_vector_type(8)));
typedef float f32x4 __attribute__((ext_vector_type(4)));
typedef unsigned u32x4 __attribute__((ext_vector_type(4)));
constexpr int BM = 256, BK = 64, HALF = 128, HTB = HALF * BK * 2  , STAGE_BYTES = 8 * HTB, NXCD = 8, WGM = 8;

__host__ __device__ __forceinline__ int lds_byte(int r, int c) { const int st = (r >> 4) * 2 + (c >> 5), rr = r & 15, cc = c & 31, ob = rr * 64 + cc * 2; return st * 1024 + (ob ^ (((ob >> 9) & 1) << 5)); }
__host__ __device__ __forceinline__ void stage_rc(int b, int& R, int& C) { const int st = b / 1024, sb = b % 1024, swz = sb ^ (((sb >> 9) & 1) << 5); R = (st >> 1) * 16 + swz / 64; C = (st & 1) * 32 + (swz % 64) / 2; }
__host__ __device__ __forceinline__ int perm32(int rho) { const int n = rho >> 4, i = rho & 15; return 8 * (i >> 2) + 4 * n + (i & 3); }

struct Unit { int pm, pn; };
struct Gemm { const bf16_t* A; const bf16_t* Bt; int M, N, K; };

struct StaticOrder {
    int nM, nN, nwg, G, c;
    __host__ __device__ void init(int M, int N, int G_, int c_) { nM = M / BM; nN = N / BM; nwg = nM * nN; G = G_; c = c_; }
    __host__ __device__ bool next(int i, Unit& u) const {
        const long L = (long)i * G + c; if (L >= nwg) return false;
        int wgid = (int)L; { const int q = nwg / NXCD, r = nwg % NXCD, xcd = wgid % NXCD, off = wgid / NXCD; wgid = (xcd < r ? xcd * (q + 1) : r * (q + 1) + (xcd - r) * q) + off; }
        const int nig = WGM * nN, gid = wgid / nig, fm = gid * WGM, gsz = (nM - fm) < WGM ? (nM - fm) : WGM;
        u.pm = fm + ((wgid % nig) % gsz); u.pn = (wgid % nig) / gsz; return true;
    }
    __device__ __forceinline__ void a_ready(const Unit&) const {}
    __device__ __forceinline__ void done(const Unit&) const {}
};
__device__ __forceinline__ unsigned cvt_pk_bf16(float lo, float hi) { unsigned r; asm volatile("v_cvt_pk_bf16_f32 %0, %1, %2" : "=v"(r) : "v"(lo), "v"(hi)); return r; }
template <class Epi, class Sched, bool STAMP = false>
__device__ __forceinline__ void gemm_phase(PG8_LAS unsigned char* lds, const Gemm g, const Sched& S, const Epi& E, unsigned long long* stamps) {
    const int tid = threadIdx.x, wid = __builtin_amdgcn_readfirstlane(tid >> 6), lane = tid & 63, wr = wid >> 2, wc = wid & 3, fr = lane & 15, fq = lane >> 4;
    const int K = g.K, nt = K / BK;
    int ts_lo = 0, ts_hi = 0, nts = 0; const unsigned long long rt_entry = STAMP ? (unsigned long long)wall_clock64() : 0ull;
#define PG8_STAMP() do { if (STAMP && wid == 0 && nts < 64) { const unsigned long long _c = (unsigned long long)clock64(); \
        ts_lo = (lane == nts) ? (int)(unsigned)_c : ts_lo; ts_hi = (lane == nts) ? (int)(unsigned)(_c >> 32) : ts_hi; ++nts; } } while (0)
    PG8_STAMP();
    unsigned voffA[2], voffB[2];
#pragma unroll
    for (int i = 0; i < 2; ++i) { int R, C; stage_rc(tid * 16 + i * 8192, R, C); const int Rb = Epi::PERM ? ((R & ~31) + perm32(R & 31)) : R;
        voffA[i] = (unsigned)(R * K + C) * 2u; voffB[i] = (unsigned)(Rb * K + C) * 2u; }
    const size_t kstep = (size_t)(BK * 2);
    const size_t hstep = (size_t)HALF * K * 2;
    const size_t tstep = 2 * hstep;
    const unsigned ldsw = (unsigned)wid * 1024u;
    const int aoff = lds_byte(wr * 64 + fr, fq * 8), boff = lds_byte(wc * 32 + fr, fq * 8);
#define PG8_SA(b, h) (((b) * 2 + (h)) * HTB)
#define PG8_SB(b, h) ((4 + (b) * 2 + (h)) * HTB)
#define PG8_STAGE(bufoff, gbase, voff) do { _Pragma("unroll") for (int _i = 0; _i < 2; ++_i) \
        __builtin_amdgcn_global_load_lds((const unsigned*)((const char*)(gbase) + (voff)[_i]), (PG8_LAS unsigned*)(lds + (bufoff) + ldsw + _i * 8192), 16, 0, 0); } while (0)
#define PG8_LDA(dst, b, h) do { _Pragma("unroll") for (int m = 0; m < 4; ++m) _Pragma("unroll") for (int k = 0; k < 2; ++k) dst[m][k] = *(const PG8_LAS bf16x8*)(lds + PG8_SA(b, h) + aoff + m * 2048 + k * 1024); } while (0)
#define PG8_LDB(dst, b, h) do { _Pragma("unroll") for (int n = 0; n < 2; ++n) _Pragma("unroll") for (int k = 0; k < 2; ++k) dst[n][k] = *(const PG8_LAS bf16x8*)(lds + PG8_SB(b, h) + boff + n * 2048 + k * 1024); } while (0)
#define PG8_MMA(ai, bj, At, Bt) do { __builtin_amdgcn_s_setprio(1); _Pragma("unroll") for (int m = 0; m < 4; ++m) _Pragma("unroll") for (int n = 0; n < 2; ++n) _Pragma("unroll") for (int k = 0; k < 2; ++k) \
        acc[ai][bj][m][n] = __builtin_amdgcn_mfma_f32_16x16x32_bf16(Bt[n][k], At[m][k], acc[ai][bj][m][n], 0, 0, 0); __builtin_amdgcn_s_setprio(0); } while (0)
#define PG8_WAIT_V(n) asm volatile("s_waitcnt vmcnt(" #n ")" ::: "memory")
#define PG8_WAIT_L(n) asm volatile("s_waitcnt lgkmcnt(" #n ")" ::: "memory")
#define PG8_BAR __builtin_amdgcn_s_barrier()
#define PG8_SCHED __builtin_amdgcn_sched_barrier(0)
    Unit cur, nxt; int ui = 0;
    if (!S.next(0, cur)) return;
    f32x4 acc[2][2][4][2];
#pragma unroll
    for (int a = 0; a < 2; ++a)
#pragma unroll
        for (int b = 0; b < 2; ++b)
#pragma unroll
            for (int m = 0; m < 4; ++m)
#pragma unroll
                for (int n = 0; n < 2; ++n) acc[a][b][m][n] = (f32x4){0.f, 0.f, 0.f, 0.f};
    bf16x8 At[4][2], B0[2][2], B1[2][2];
    const char* cA = (const char*)g.A + (size_t)cur.pm * tstep; const char* cB = (const char*)g.Bt + (size_t)cur.pn * tstep;
    S.a_ready(cur);
    PG8_STAGE(PG8_SB(0, 0), cB, voffB); PG8_STAGE(PG8_SA(0, 0), cA, voffA); PG8_STAGE(PG8_SB(0, 1), cB + hstep, voffB); PG8_STAGE(PG8_SA(0, 1), cA + hstep, voffA);
    if (wr == 1) PG8_BAR;
    PG8_WAIT_V(4); PG8_BAR;
    PG8_STAGE(PG8_SB(1, 0), cB + kstep, voffB); PG8_STAGE(PG8_SA(1, 0), cA + kstep, voffA); PG8_STAGE(PG8_SB(1, 1), cB + hstep + kstep, voffB);
    PG8_WAIT_V(6); PG8_BAR;
    PG8_STAMP();
    for (;;) {
        const bool has_next = S.next(ui + 1, nxt);
        const char* nA = has_next ? (const char*)g.A + (size_t)nxt.pm * tstep : cA; const char* nB = has_next ? (const char*)g.Bt + (size_t)nxt.pn * tstep : cB;
        for (int t = 0; t < nt; t += 2) {
            const bool last = (t == nt - 2);
            const char* a1 = cA + (size_t)(t + 1) * kstep;
            const char* a2 = last ? nA : cA + (size_t)(t + 2) * kstep; const char* b2 = last ? nB : cB + (size_t)(t + 2) * kstep;
            const char* a3 = a2 + kstep; const char* b3 = b2 + kstep;
            if (last && has_next) S.a_ready(nxt);
            PG8_LDB(B0, 0, 0); PG8_SCHED; PG8_LDA(At, 0, 0); PG8_STAGE(PG8_SA(1, 1), a1 + hstep, voffA);
            PG8_WAIT_L(8); PG8_BAR; PG8_WAIT_L(0); PG8_MMA(0, 0, At, B0); PG8_BAR; PG8_SCHED;
            PG8_LDB(B1, 0, 1); PG8_STAGE(PG8_SB(0, 0), b2, voffB);
            PG8_BAR; PG8_WAIT_L(0); PG8_MMA(0, 1, At, B1); PG8_BAR;
            PG8_LDA(At, 0, 1); PG8_STAGE(PG8_SA(0, 0), a2, voffA);
            PG8_BAR; PG8_WAIT_L(0); PG8_MMA(1, 0, At, B0); PG8_BAR; PG8_SCHED;
            PG8_STAGE(PG8_SB(0, 1), b2 + hstep, voffB);
            PG8_WAIT_V(6); PG8_BAR; PG8_MMA(1, 1, At, B1); PG8_BAR;
            PG8_LDB(B0, 1, 0); PG8_SCHED; PG8_LDA(At, 1, 0); PG8_STAGE(PG8_SA(0, 1), a2 + hstep, voffA);
            PG8_WAIT_L(8); PG8_BAR; PG8_WAIT_L(0); PG8_MMA(0, 0, At, B0); PG8_BAR; PG8_SCHED;
            PG8_LDB(B1, 1, 1); PG8_STAGE(PG8_SB(1, 0), b3, voffB);
            PG8_BAR; PG8_WAIT_L(0); PG8_MMA(0, 1, At, B1); PG8_BAR;
            PG8_LDA(At, 1, 1); PG8_STAGE(PG8_SA(1, 0), a3, voffA);
            PG8_BAR; PG8_WAIT_L(0); PG8_MMA(1, 0, At, B0); PG8_BAR; PG8_SCHED;
            PG8_STAGE(PG8_SB(1, 1), b3 + hstep, voffB);
            PG8_WAIT_V(6); PG8_BAR; PG8_MMA(1, 1, At, B1); PG8_BAR;
        }
        PG8_STAMP();
        if constexpr (!Epi::AFTER_DRAIN) { E(acc, cur, wr, wc, fr, fq); S.done(cur); }
        PG8_STAMP();
        if (!has_next) break;
#pragma unroll
        for (int a = 0; a < 2; ++a)
#pragma unroll
            for (int b = 0; b < 2; ++b)
#pragma unroll
                for (int m = 0; m < 4; ++m)
#pragma unroll
                    for (int n = 0; n < 2; ++n) acc[a][b][m][n] = (f32x4){0.f, 0.f, 0.f, 0.f};
        cur = nxt; cA = nA; cB = nB; ++ui;
    }
    PG8_WAIT_V(0);
    if (wr == 0) PG8_BAR;
    PG8_BAR;
    if constexpr (Epi::AFTER_DRAIN) { E.fused(acc, cur, wr, wc, fr, fq, lds, wid, lane); S.done(cur); }
    PG8_STAMP();
    if (STAMP && wid == 0) { stamps[lane] = lane < nts ? (((unsigned long long)(unsigned)ts_hi << 32) | (unsigned)ts_lo) : 0ull;
        if (lane == 62) stamps[62] = rt_entry; if (lane == 63) stamps[63] = (unsigned long long)wall_clock64(); }
#undef PG8_STAMP
#undef PG8_SA
#undef PG8_SB
#undef PG8_STAGE
#undef PG8_LDA
#undef PG8_LDB
#undef PG8_MMA
#undef PG8_WAIT_V
#undef PG8_WAIT_L
#undef PG8_BAR
#undef PG8_SCHED
}
}
#define XB_TMO      128
#define XB_XCNT(j)  (256  + 64 * (j))
#define XB_XSUB(j)  (1280 + 64 * (j))
#define XB_XGEN(j)  (2304 + 64 * (j))
#define XB_TOP      3328
#define XB_TOPGEN   3392
#define XCD_BAR_WORDS 3456
#define XB_SPIN_CAP (1u << 18)
__device__ __forceinline__ unsigned xb_ld(unsigned* p)              { return __hip_atomic_load(p, __ATOMIC_RELAXED, __HIP_MEMORY_SCOPE_AGENT); }
__device__ __forceinline__ unsigned xb_add(unsigned* p, unsigned v) { return __hip_atomic_fetch_add(p, v, __ATOMIC_RELAXED, __HIP_MEMORY_SCOPE_AGENT); }
__device__ __forceinline__ unsigned xb_xcc_id() { return (unsigned)__builtin_amdgcn_s_getreg((3 << 11) | 20) & 0xFu; }
#define XB_SPIN(cond, bar) do { unsigned _sp = 0; while (cond) { __builtin_amdgcn_s_sleep(1); \
    if ((++_sp & 255u) == 0u) { if (xb_ld(&(bar)[XB_TMO])) break; if (_sp > XB_SPIN_CAP) { atomicAdd(&(bar)[XB_TMO], 1u); break; } } } } while (0)

struct XcdBarrier {
    unsigned* bar; unsigned x;
    volatile LAS unsigned* st;
};

__device__ __forceinline__ XcdBarrier xcd_barrier_post(unsigned* bar, volatile LAS unsigned* st) {
    XcdBarrier b; b.bar = bar; b.x = xb_xcc_id(); b.st = st;
    if (threadIdx.x == 0) (void)xb_add(&bar[XB_XCNT(b.x)], 1u);
    return b;
}
__device__ __forceinline__ void xcd_barrier_complete(unsigned* bar, unsigned x, unsigned& nloc, unsigned& nx) {
    const unsigned G = gridDim.x * gridDim.y * gridDim.z;
    unsigned sum, cnt, mine, sp = 0u;
    for (;;) {
        sum = 0u; cnt = 0u; mine = 0u;
#pragma unroll
        for (unsigned j = 0; j < 16; ++j) { const unsigned c = xb_ld(&bar[XB_XCNT(j)]); sum += c; cnt += (c > 0u) ? 1u : 0u; mine = (j == x) ? c : mine; }
        if (sum == G) break;
        __builtin_amdgcn_s_sleep(1);
        if ((++sp & 255u) == 0u) { if (xb_ld(&bar[XB_TMO])) break; if (sp > XB_SPIN_CAP) { atomicAdd(&bar[XB_TMO], 1u); break; } }
    }
    nloc = mine > 0u ? mine : 1u; nx = cnt > 0u ? cnt : 1u;
}

__device__ __forceinline__ void xcd_barrier(const XcdBarrier& b) {
    asm volatile("s_waitcnt vmcnt(0)" ::: "memory");
    __syncthreads();
    if (threadIdx.x == 0) {
        unsigned* bar = b.bar;
        __builtin_amdgcn_s_waitcnt(0);
        unsigned nloc = b.st[0], nx = b.st[1];
        if (nloc == 0u) { xcd_barrier_complete(bar, b.x, nloc, nx); b.st[0] = nloc; b.st[1] = nx; }
        const unsigned old = xb_add(&bar[XB_XSUB(b.x)], 1u);
        const unsigned gen = old / nloc;
        if (old + 1u == (gen + 1u) * nloc) {
            __builtin_amdgcn_fence(__ATOMIC_RELEASE, "agent");
            asm volatile("s_waitcnt vmcnt(0)" ::: "memory");
            const unsigned og = xb_add(&bar[XB_TOP], 1u);
            const unsigned tg = og / nx;
            if (og + 1u == (tg + 1u) * nx) xb_add(&bar[XB_TOPGEN], 1u);
            else XB_SPIN(xb_ld(&bar[XB_TOPGEN]) == tg, bar);
            __builtin_amdgcn_fence(__ATOMIC_ACQUIRE, "agent");
            xb_add(&bar[XB_XGEN(b.x)], 1u);
            asm volatile("s_waitcnt vmcnt(0)" ::: "memory");
        } else {
            XB_SPIN(xb_ld(&bar[XB_XGEN(b.x)]) == gen, bar);
            __builtin_amdgcn_fence(__ATOMIC_ACQUIRE, "agent");
            asm volatile("s_waitcnt vmcnt(0)" ::: "memory");
        }
    }
    __syncthreads();
}
typedef short v4i16_t __attribute__((ext_vector_type(4)));
__device__ __forceinline__ unsigned cvt_pk_bf16(float lo, float hi) { return pg8::cvt_pk_bf16(lo, hi); }
__device__ __forceinline__ float bf_lo(unsigned u) { return __uint_as_float(u << 16); }
__device__ __forceinline__ float bf_hi(unsigned u) { return __uint_as_float(u & 0xffff0000u); }
__device__ __forceinline__ float bf2f(bf16_t b) { return __uint_as_float(((unsigned)b) << 16); }
__device__ __forceinline__ float wave_sum(float v) {
#pragma unroll
    for (int o = 1; o < 64; o <<= 1) v += __shfl_xor(v, o);
    return v;
}
__device__ __forceinline__ float sigmoidf_(float x) { return __builtin_amdgcn_rcpf(1.0f + __expf(-x)); }
__device__ __forceinline__ float siluf_(float x) { return x * __builtin_amdgcn_rcpf(1.0f + __expf(-x)); }
__device__ __forceinline__ float gelu_tanh_(float x) { const float y = 0.7978845608028654f * (x + 0.044715f * x * x * x); const float t = 1.0f - 2.0f * __builtin_amdgcn_rcpf(1.0f + __expf(2.0f * y)); return 0.5f * x * (1.0f + t); }
__device__ __forceinline__ s16x4 vtr(const LAS bf16_t* p) { return __builtin_bit_cast(s16x4, __builtin_amdgcn_ds_read_tr16_b64_v4i16((LAS v4i16_t*)p)); }
__device__ __forceinline__ bf16x8 frag_tr(const LAS bf16_t* tile, int pitch, int k0, int n0, int lane) {
    const int i16 = lane & 15, g = lane >> 4;
    const LAS bf16_t* a = tile + (k0 + 4 * g + (i16 >> 2)) * pitch + n0 + 4 * (i16 & 3);
    const s16x4 lo = vtr(a), hi = vtr(a + 16 * pitch);
    bf16x8 r; r[0] = lo[0]; r[1] = lo[1]; r[2] = lo[2]; r[3] = lo[3]; r[4] = hi[0]; r[5] = hi[1]; r[6] = hi[2]; r[7] = hi[3]; return r;
}
__device__ __forceinline__ bf16x8 pack_frag(const f32x4 a, const f32x4 b) {
    u32x4 w; w.x = cvt_pk_bf16(a[0], a[1]); w.y = cvt_pk_bf16(a[2], a[3]); w.z = cvt_pk_bf16(b[0], b[1]); w.w = cvt_pk_bf16(b[2], b[3]);
    return __builtin_bit_cast(bf16x8, w);
}
#define MFMA16(a, b, c) __builtin_amdgcn_mfma_f32_16x16x32_bf16((a), (b), (c), 0, 0, 0)

typedef const f32x4 (&AccRef)[2][2][4][2];
#define EPI_ROWS() _Pragma("unroll") for (int ai = 0; ai < 2; ++ai) _Pragma("unroll") for (int m = 0; m < 4; ++m)
#define EPI_BJ() _Pragma("unroll") for (int bj = 0; bj < 2; ++bj)

template <int LDC, int NTN> struct EpiPlainBf16 {
    static constexpr bool PERM = true, AFTER_DRAIN = false; static constexpr int ldc = LDC, ntn = NTN;
    bf16_t* O;
    __device__ __forceinline__ void operator()(AccRef acc, const pg8::Unit& u, int wr, int wc, int fr_, int fq_) const {
        int fr = fr_, fq = fq_; asm volatile("" : "+v"(fr), "+v"(fq));
        const int row0 = u.pm * 256 + wr * 64 + fr, col0 = (u.pn % ntn) * 256 + wc * 32 + 8 * fq;
        EPI_ROWS() { bf16_t* rowp = O + (size_t)(row0 + ai * 128 + m * 16) * ldc + col0;
            EPI_BJ() { const f32x4 v0 = acc[ai][bj][m][0], v1 = acc[ai][bj][m][1];
                u32x4 w; w.x = cvt_pk_bf16(v0[0], v0[1]); w.y = cvt_pk_bf16(v0[2], v0[3]); w.z = cvt_pk_bf16(v1[0], v1[1]); w.w = cvt_pk_bf16(v1[2], v1[3]);
                *(u32x4*)(rowp + bj * 128) = w; } }
    }
};
struct EpiPleUp {
    static constexpr bool PERM = true, AFTER_DRAIN = false;
    bf16_t* O; float* ess;
    __device__ __forceinline__ void operator()(AccRef acc, const pg8::Unit& u, int wr, int wc, int fr_, int fq_) const {
        int fr = fr_, fq = fq_; asm volatile("" : "+v"(fr), "+v"(fq));
        const int row0 = u.pm * 256 + wr * 64 + fr, col0 = u.pn * 256 + wc * 32 + 8 * fq;
        EPI_ROWS() { const int row = row0 + ai * 128 + m * 16; bf16_t* rowp = O + (size_t)row * D + col0; float s = 0.f;
            EPI_BJ() { const f32x4 v0 = acc[ai][bj][m][0], v1 = acc[ai][bj][m][1];
                s += (v0[0] * v0[0] + v0[1] * v0[1]) + (v0[2] * v0[2] + v0[3] * v0[3]) + (v1[0] * v1[0] + v1[1] * v1[1]) + (v1[2] * v1[2] + v1[3] * v1[3]);
                u32x4 w; w.x = cvt_pk_bf16(v0[0], v0[1]); w.y = cvt_pk_bf16(v0[2], v0[3]); w.z = cvt_pk_bf16(v1[0], v1[1]); w.w = cvt_pk_bf16(v1[2], v1[3]);
                *(u32x4*)(rowp + bj * 128) = w; }
            s += __shfl_xor(s, 16); s += __shfl_xor(s, 32);
            if (fq == 0) ess[(size_t)row * 16 + u.pn * 4 + wc] = s;
            asm volatile("" ::: "memory"); }
    }
};
template <bool BASE_F32> struct EpiResid {
    static constexpr bool PERM = true, AFTER_DRAIN = false;
    const void* base; bf16_t* out;
    __device__ __forceinline__ void operator()(AccRef acc, const pg8::Unit& u, int wr, int wc, int fr_, int fq_) const {
        int fr = fr_, fq = fq_; asm volatile("" : "+v"(fr), "+v"(fq));
        const int row0 = u.pm * 256 + wr * 64 + fr, col0 = u.pn * 256 + wc * 32 + 8 * fq;
        EPI_ROWS() { const size_t ro = (size_t)(row0 + ai * 128 + m * 16) * D + col0;
            EPI_BJ() { const size_t o = ro + bj * 128; f32x4 b0, b1;
                if (BASE_F32) { b0 = *(const f32x4*)((const float*)base + o); b1 = *(const f32x4*)((const float*)base + o + 4); }
                else { const u32x4 hb = *(const u32x4*)((const bf16_t*)base + o); b0 = (f32x4){bf_lo(hb.x), bf_hi(hb.x), bf_lo(hb.y), bf_hi(hb.y)}; b1 = (f32x4){bf_lo(hb.z), bf_hi(hb.z), bf_lo(hb.w), bf_hi(hb.w)}; }
                const f32x4 v0 = b0 + acc[ai][bj][m][0], v1 = b1 + acc[ai][bj][m][1];
                u32x4 w; w.x = cvt_pk_bf16(v0[0], v0[1]); w.y = cvt_pk_bf16(v0[2], v0[3]); w.z = cvt_pk_bf16(v1[0], v1[1]); w.w = cvt_pk_bf16(v1[2], v1[3]);
                *(u32x4*)(out + o) = w; } }
    }
};
struct EpiSwiglu {
    static constexpr bool PERM = true, AFTER_DRAIN = false;
    bf16_t* H;
    __device__ __forceinline__ void operator()(AccRef acc, const pg8::Unit& u, int wr, int wc, int fr_, int fq_) const {
        int fr = fr_, fq = fq_; asm volatile("" : "+v"(fr), "+v"(fq));
        const int row0 = u.pm * 256 + wr * 64 + fr, ct = u.pn & 3;
        EPI_ROWS() { bf16_t* rowp = H + (size_t)(row0 + ai * 128 + m * 16) * FF;
            EPI_BJ() { const f32x4 g = acc[ai][bj][m][0], up = acc[ai][bj][m][1]; const int ff = 128 * ct + 64 * bj + 16 * wc + 4 * fq;
                u32x2 w; w.x = cvt_pk_bf16(siluf_(g[0]) * up[0], siluf_(g[1]) * up[1]); w.y = cvt_pk_bf16(siluf_(g[2]) * up[2], siluf_(g[3]) * up[3]);
                *(u32x2*)(rowp + ff) = w; } }
    }
};
template <bool FINAL> struct EpiPleGate {
    static constexpr bool PERM = true, AFTER_DRAIN = false;
    const bf16_t* hin; void* hout; const bf16_t* eraw; const float* erstd; const float* gple;
    __device__ __forceinline__ void operator()(AccRef acc, const pg8::Unit& u, int wr, int wc, int fr_, int fq_) const {
        int fr = fr_, fq = fq_; asm volatile("" : "+v"(fr), "+v"(fq));
        const int row0 = u.pm * 256 + wr * 64 + fr, col0 = u.pn * 256 + wc * 32 + 8 * fq;
        EPI_ROWS() { const int row = row0 + ai * 128 + m * 16; const float rs = erstd[row]; const size_t ro = (size_t)row * D + col0;
            EPI_BJ() { const size_t o = ro + bj * 128; const int c = col0 + bj * 128;
                const u32x4 hb = *(const u32x4*)(hin + o), ew = *(const u32x4*)(eraw + o); const f32x4 g0 = *(const f32x4*)(gple + c), g1 = *(const f32x4*)(gple + c + 4);
                const f32x4 a0 = acc[ai][bj][m][0], a1 = acc[ai][bj][m][1];
                f32x4 r0, r1;
                r0[0] = bf_lo(hb.x) + bf_lo(ew.x) * rs * g0[0] * sigmoidf_(a0[0]); r0[1] = bf_hi(hb.x) + bf_hi(ew.x) * rs * g0[1] * sigmoidf_(a0[1]);
                r0[2] = bf_lo(hb.y) + bf_lo(ew.y) * rs * g0[2] * sigmoidf_(a0[2]); r0[3] = bf_hi(hb.y) + bf_hi(ew.y) * rs * g0[3] * sigmoidf_(a0[3]);
                r1[0] = bf_lo(hb.z) + bf_lo(ew.z) * rs * g1[0] * sigmoidf_(a1[0]); r1[1] = bf_hi(hb.z) + bf_hi(ew.z) * rs * g1[1] * sigmoidf_(a1[1]);
                r1[2] = bf_lo(hb.w) + bf_lo(ew.w) * rs * g1[2] * sigmoidf_(a1[2]); r1[3] = bf_hi(hb.w) + bf_hi(ew.w) * rs * g1[3] * sigmoidf_(a1[3]);
                if (FINAL) { *(f32x4*)((float*)hout + o) = r0; *(f32x4*)((float*)hout + o + 4) = r1; }
                else { u32x4 w; w.x = cvt_pk_bf16(r0[0], r0[1]); w.y = cvt_pk_bf16(r0[2], r0[3]); w.z = cvt_pk_bf16(r1[0], r1[1]); w.w = cvt_pk_bf16(r1[2], r1[3]); *(u32x4*)((bf16_t*)hout + o) = w; } }
            asm volatile("" ::: "memory"); }
    }
};
struct EpiRet {
    static constexpr bool PERM = true, AFTER_DRAIN = false;
    bf16_t* Z; const float* rope;
    __device__ __forceinline__ void operator()(AccRef acc, const pg8::Unit& u, int wr, int wc, int fr_, int fq_) const {
        int fr = fr_, fq = fq_; asm volatile("" : "+v"(fr), "+v"(fq));
        const int row0 = u.pm * 256 + wr * 64 + fr;
        const bool rot = u.pn < 8;
        const float sc = (rot && u.pn >= 4) ? 0.08838834764831845f : 1.0f;
        const int i0 = 4 * (4 * wc + fq);
        const int ca = rot ? (2 * u.pn) * 128 + i0 : u.pn * 256 + wc * 32 + 8 * fq, dcb = rot ? 64 : 4;
        EPI_ROWS() { const int row = row0 + ai * 128 + m * 16; const int pos = row & (SEQ - 1);
            f32x4 cs = (f32x4){1.f, 1.f, 1.f, 1.f}, sn = (f32x4){0.f, 0.f, 0.f, 0.f};
            if (rot) { cs = *(const f32x4*)(rope + (size_t)pos * 64 + i0); sn = *(const f32x4*)(rope + (size_t)SEQ * 64 + (size_t)pos * 64 + i0); }
            bf16_t* rowp = Z + (size_t)row * OD_IN + ca;
            EPI_BJ() { const f32x4 x1 = acc[ai][bj][m][0], x2 = acc[ai][bj][m][1];
                u32x2 a, b;
                a.x = cvt_pk_bf16((x1[0] * cs[0] - x2[0] * sn[0]) * sc, (x1[1] * cs[1] - x2[1] * sn[1]) * sc); a.y = cvt_pk_bf16((x1[2] * cs[2] - x2[2] * sn[2]) * sc, (x1[3] * cs[3] - x2[3] * sn[3]) * sc);
                b.x = cvt_pk_bf16((x2[0] * cs[0] + x1[0] * sn[0]) * sc, (x2[1] * cs[1] + x1[1] * sn[1]) * sc); b.y = cvt_pk_bf16((x2[2] * cs[2] + x1[2] * sn[2]) * sc, (x2[3] * cs[3] + x1[3] * sn[3]) * sc);
                if (rot) { *(u32x2*)(rowp + bj * 128) = a; *(u32x2*)(rowp + bj * 128 + 64) = b; }
                else { u32x4 w4; w4.x = a.x; w4.y = a.y; w4.z = b.x; w4.w = b.y; *(u32x4*)(rowp + bj * 128) = w4; } }
            asm volatile("" ::: "memory"); }
    }
};
struct MoeOrder {
    const int* tile_e; int ntiles, G, c;
    __device__ __forceinline__ void init(const int* te, int G_, int c_) { tile_e = te; ntiles = te[MOE_TILES]; G = G_; c = c_; }
    __device__ __forceinline__ bool next(int i, pg8::Unit& u) const {
        const int nwg = ntiles * 4; int L = i * G + c; if (L >= nwg) return false;
        { const int q = nwg / 8, r = nwg % 8, xcd = L % 8, off = L / 8; L = (xcd < r ? xcd * (q + 1) : r * (q + 1) + (xcd - r) * q) + off; }
        const int rt = L >> 2; u.pm = rt; u.pn = tile_e[rt] * 4 + (L & 3); return true;
    }
    __device__ __forceinline__ void a_ready(const pg8::Unit&) const {}
    __device__ __forceinline__ void done(const pg8::Unit&) const {}
};
template <int MODE>
__device__ __forceinline__ void tr_load(const float* W, const float* W2, int Nsrc, int r0, int k0, int lane, f32x4 (&v)[16]) {
    const int kr = lane >> 4, c4 = lane & 15, r = r0 + 4 * c4;
    const float* src = W; int col = r; bool ok = true;
    if (MODE == 0) { ok = r < Nsrc; }
    if (MODE == 1) { if (r < 2048) { const int hh = r >> 7, w = r & 127, w8 = w >> 3, rr = w & 7; col = hh * 128 + ((rr < 4) ? 4 * w8 : 64 + 4 * w8); } }
    if (MODE == 2) { const int w8 = r >> 3; src = ((r >> 2) & 1) ? W2 : W; col = 4 * w8; }
    const char* p = (const char*)(src + (size_t)(k0 + kr) * Nsrc + col); const size_t stride = (size_t)Nsrc * 16;
#pragma unroll
    for (int i = 0; i < 16; ++i) { v[i] = (f32x4){0.f, 0.f, 0.f, 0.f}; if (ok) v[i] = __builtin_nontemporal_load((const f32x4*)p); p += stride; asm volatile("" : "+v"(p)); }
}
__device__ __forceinline__ void tr_store(bf16_t* WT, int K, int r0, int k0, LAS float* scr, int lane, const f32x4 (&v)[16]) {
    const int kr = lane >> 4, c4 = lane & 15;
#pragma unroll
    for (int i = 0; i < 16; ++i) { LAS float* d = scr + (kr + 4 * i) * 65 + 4 * c4; d[0] = v[i][0]; d[1] = v[i][1]; d[2] = v[i][2]; d[3] = v[i][3]; }
    asm volatile("s_waitcnt lgkmcnt(0)" ::: "memory");
    const int c = lane & 7;
#pragma unroll
    for (int j = 0; j < 8; ++j) { const int n = (lane >> 3) + 8 * j; const LAS float* s = scr + (8 * c) * 65 + n;
        u32x4 o; o.x = cvt_pk_bf16(s[0 * 65], s[1 * 65]); o.y = cvt_pk_bf16(s[2 * 65], s[3 * 65]); o.z = cvt_pk_bf16(s[4 * 65], s[5 * 65]); o.w = cvt_pk_bf16(s[6 * 65], s[7 * 65]);
        *(u32x4*)(WT + (size_t)(r0 + n) * K + k0 + 8 * c) = o; }
    asm volatile("s_waitcnt lgkmcnt(0)" ::: "memory");
}
template <int MODE>
__device__ __forceinline__ void tr_matrix(const float* W, const float* W2, int K, int Nsrc, bf16_t* WT, int rows, LAS float* scr, int lane, int gw, int ngw) {
    const int nkb = K / 64, nitems = (rows / 64) * nkb;
    f32x4 va[16], vb[16];
    int it = gw;
    if (it < nitems) tr_load<MODE>(W, W2, Nsrc, (it / nkb) * 64, (it % nkb) * 64, lane, va);
    while (it < nitems) {
        const int n1 = it + ngw;
        if (n1 < nitems) tr_load<MODE>(W, W2, Nsrc, (n1 / nkb) * 64, (n1 % nkb) * 64, lane, vb);
        tr_store(WT, K, (it / nkb) * 64, (it % nkb) * 64, scr, lane, va);
        if (n1 >= nitems) break;
        const int n2 = n1 + ngw;
        if (n2 < nitems) tr_load<MODE>(W, W2, Nsrc, (n2 / nkb) * 64, (n2 % nkb) * 64, lane, va);
        tr_store(WT, K, (n1 / nkb) * 64, (n1 % nkb) * 64, scr, lane, vb);
        it = n2;
    }
}
__device__ __forceinline__ void moe_item_load(const float* wg, const float* wu, const float* wd, int it, int lane, f32x4 (&v)[16]) {
    const int n_gu = NEXP * 256;
    if (it < n_gu) { const int e = it >> 8, r = it & 255, rb = r >> 4, kb = r & 15; tr_load<2>(wg + (size_t)e * D * FF, wu + (size_t)e * D * FF, FF, rb * 64, kb * 64, lane, v); }
    else { const int q = it - n_gu, e = q >> 7, r = q & 127, rb = r >> 3, kb = r & 7; tr_load<0>(wd + (size_t)e * FF * D, nullptr, D, rb * 64, kb * 64, lane, v); }
}
__device__ __forceinline__ void moe_item_store(bf16_t* GU, bf16_t* DN, int it, LAS float* scr, int lane, const f32x4 (&v)[16]) {
    const int n_gu = NEXP * 256;
    if (it < n_gu) { const int e = it >> 8, r = it & 255, rb = r >> 4, kb = r & 15; tr_store(GU + (size_t)e * 1024 * D, D, rb * 64, kb * 64, scr, lane, v); }
    else { const int q = it - n_gu, e = q >> 7, r = q & 127, rb = r >> 3, kb = r & 7; tr_store(DN + (size_t)e * 1024 * FF, FF, rb * 64, kb * 64, scr, lane, v); }
}
__device__ __forceinline__ void convert_moe_layer(const float* wg, const float* wu, const float* wd, bf16_t* GU, bf16_t* DN, LAS float* scr, int lane, int gw, int ngw) {
    const int nitems = NEXP * 256 + NEXP * 128;
    f32x4 va[16], vb[16];
    int it = gw;
    if (it < nitems) moe_item_load(wg, wu, wd, it, lane, va);
    while (it < nitems) {
        const int n1 = it + ngw;
        if (n1 < nitems) moe_item_load(wg, wu, wd, n1, lane, vb);
        moe_item_store(GU, DN, it, scr, lane, va);
        if (n1 >= nitems) break;
        const int n2 = n1 + ngw;
        if (n2 < nitems) moe_item_load(wg, wu, wd, n2, lane, va);
        moe_item_store(GU, DN, n1, scr, lane, vb);
        it = n2;
    }
}
template <int NR, bool IN_F32>
__device__ __forceinline__ void rms_rows_to_bf16(const void* xbase, const float* gain, bf16_t* obase, int m, int step, int lane) {
    f32x4 v[NR][4];
#pragma unroll
    for (int r = 0; r < NR; ++r) { const int row = (m + r * step < M) ? m + r * step : m;
        if (IN_F32) { const f32x4* xr = (const f32x4*)((const float*)xbase + (size_t)row * D) + lane;
#pragma unroll
            for (int j = 0; j < 4; ++j) v[r][j] = xr[64 * j]; }
        else { const u32x2* xr = (const u32x2*)((const bf16_t*)xbase + (size_t)row * D) + lane;
#pragma unroll
            for (int j = 0; j < 4; ++j) { const u32x2 q = xr[64 * j]; v[r][j] = (f32x4){bf_lo(q.x), bf_hi(q.x), bf_lo(q.y), bf_hi(q.y)}; } } }
    f32x4 g[4];
#pragma unroll
    for (int j = 0; j < 4; ++j) g[j] = *((const f32x4*)gain + lane + 64 * j);
#pragma unroll
    for (int r = 0; r < NR; ++r) { float s = 0.f;
#pragma unroll
        for (int j = 0; j < 4; ++j) s += (v[r][j][0] * v[r][j][0] + v[r][j][1] * v[r][j][1]) + (v[r][j][2] * v[r][j][2] + v[r][j][3] * v[r][j][3]);
        const float rstd = 1.0f / sqrtf(wave_sum(s) * (1.0f / D) + RMS_EPS);
        u32x2* o8 = (u32x2*)(obase + (size_t)(m + r * step) * D) + lane;
        if (m + r * step < M)
#pragma unroll
        for (int j = 0; j < 4; ++j) { u32x2 w; w.x = cvt_pk_bf16(v[r][j][0] * rstd * g[j][0], v[r][j][1] * rstd * g[j][1]); w.y = cvt_pk_bf16(v[r][j][2] * rstd * g[j][2], v[r][j][3] * rstd * g[j][3]); o8[64 * j] = w; } }
}
__device__ __forceinline__ void lru_local_unit(const bf16_t* Z0, const float* conv_w, const float* conv_b, const float* wa, const float* ba, const float* wx, const float* bx, const float* lam,
                                               float* HLOC, float* PCUM, float* SUMA, float* SUMH, ldsp lds, int b, int c, int tid) {
    const int ch = tid, lane = tid & 63, blk = __builtin_amdgcn_readfirstlane(tid >> 6), i16 = lane & 15, g = lane >> 4;
    LAS bf16_t* Xc = (LAS bf16_t*)(lds + blk * 17408); LAS float* GB = (LAS float*)(lds + blk * 17408 + 9216);
    const float w0 = conv_w[ch], w1 = conv_w[512 + ch], w2 = conv_w[1024 + ch], w3 = conv_w[1536 + ch], cb = conv_b[ch];
    const float bav = ba[ch], bxv = bx[ch];
    const float l = lam[ch]; const float z = __expf(-l);
    const float sp = (z < 0.02f) ? z * (1.0f - z * (0.5f - z * (0.33333334f - 0.25f * z))) : __logf(1.0f + z);
    const float c8 = -8.0f * sp;
    const size_t tok0 = (size_t)b * SEQ + (size_t)c * 64;
    float xm3 = 0.f, xm2 = 0.f, xm1 = 0.f;
    if (c > 0) { xm3 = bf2f(Z0[(tok0 - 3) * EV_INP + ZC_XA + ch]); xm2 = bf2f(Z0[(tok0 - 2) * EV_INP + ZC_XA + ch]); xm1 = bf2f(Z0[(tok0 - 1) * EV_INP + ZC_XA + ch]); }
    bf16x8 bfa[2][4], bfx[2][4];
#pragma unroll
    for (int ks = 0; ks < 2; ++ks)
#pragma unroll
        for (int nt = 0; nt < 4; ++nt) { const float* pa = wa + (size_t)blk * 4096 + (32 * ks + 8 * g) * 64 + 16 * nt + i16; const float* px = wx + (size_t)blk * 4096 + (32 * ks + 8 * g) * 64 + 16 * nt + i16;
            u32x4 ua, ux; ua.x = cvt_pk_bf16(pa[0], pa[64]); ua.y = cvt_pk_bf16(pa[128], pa[192]); ua.z = cvt_pk_bf16(pa[256], pa[320]); ua.w = cvt_pk_bf16(pa[384], pa[448]);
            ux.x = cvt_pk_bf16(px[0], px[64]); ux.y = cvt_pk_bf16(px[128], px[192]); ux.z = cvt_pk_bf16(px[256], px[320]); ux.w = cvt_pk_bf16(px[384], px[448]);
            bfa[ks][nt] = __builtin_bit_cast(bf16x8, ua); bfx[ks][nt] = __builtin_bit_cast(bf16x8, ux); }
    float xc[64];
#pragma unroll
    for (int t = 0; t < 64; ++t) { const float xt = bf2f(Z0[(tok0 + t) * EV_INP + ZC_XA + ch]);
        xc[t] = w0 * xm3 + w1 * xm2 + w2 * xm1 + w3 * xt + cb; xm3 = xm2; xm2 = xm1; xm1 = xt;
        Xc[t * 72 + lane] = (bf16_t)(cvt_pk_bf16(xc[t], 0.f) & 0xffffu); }
    asm volatile("s_waitcnt lgkmcnt(0)" ::: "memory");
    float h = 0.f, P = 1.f;
#pragma unroll
    for (int mt = 0; mt < 4; ++mt) {
        const bf16x8 a0 = *(const LAS bf16x8*)(Xc + (16 * mt + i16) * 72 + 8 * g), a1 = *(const LAS bf16x8*)(Xc + (16 * mt + i16) * 72 + 32 + 8 * g);
#pragma unroll
        for (int nt = 0; nt < 4; ++nt) { f32x4 ca = (f32x4){0.f, 0.f, 0.f, 0.f}, cx = (f32x4){0.f, 0.f, 0.f, 0.f};
            ca = MFMA16(a0, bfa[0][nt], ca); ca = MFMA16(a1, bfa[1][nt], ca); cx = MFMA16(a0, bfx[0][nt], cx); cx = MFMA16(a1, bfx[1][nt], cx);
#pragma unroll
            for (int i = 0; i < 4; ++i) { GB[(4 * g + i) * 128 + 16 * nt + i16] = ca[i]; GB[(4 * g + i) * 128 + 64 + 16 * nt + i16] = cx[i]; } }
        asm volatile("s_waitcnt lgkmcnt(0)" ::: "memory");
#pragma unroll
        for (int t = 0; t < 16; ++t) {
            const float r = sigmoidf_(GB[t * 128 + lane] + bav), gi = sigmoidf_(GB[t * 128 + 64 + lane] + bxv);
            const float log_a = c8 * r; const float a = __expf(log_a);
            const float y2 = 2.0f * log_a;
            const float om = (y2 > -0.3f) ? -y2 * (1.0f + y2 * (0.5f + y2 * (0.16666667f + y2 * (0.041666668f + y2 * (0.008333334f + y2 * 0.0013888889f))))) : 1.0f - a * a;
            const float u = sqrtf(fmaxf(om, 0.f)) * (gi * xc[16 * mt + t]);
            h = a * h + u; P *= a;
            const size_t o = (tok0 + 16 * mt + t) * 512 + ch;
            HLOC[o] = h; PCUM[o] = P;
        }
        asm volatile("" ::: "memory");
    }
    SUMA[((size_t)b * 64 + c) * 512 + ch] = P; SUMH[((size_t)b * 64 + c) * 512 + ch] = h;
}
__device__ __forceinline__ void lru_fix_unit(const bf16_t* Z0, const float* HLOC, const float* PCUM, const float* SUMA, const float* SUMH, bf16_t* Y0, int b, int c, int tid) {
    const int ch = tid; float hin = 0.f;
    for (int c0 = 0; c0 < c; c0 += 16) {
        float av[16], hv[16];
#pragma unroll
        for (int j = 0; j < 16; ++j) { const int cc = (c0 + j < c) ? c0 + j : c - 1; const size_t o = ((size_t)b * 64 + cc) * 512 + ch; av[j] = SUMA[o]; hv[j] = SUMH[o]; }
#pragma unroll
        for (int j = 0; j < 16; ++j) if (c0 + j < c) hin = av[j] * hin + hv[j];
    }
    const size_t tok0 = (size_t)b * SEQ + (size_t)c * 64;
#pragma unroll 1
    for (int t0 = 0; t0 < 64; t0 += 16) {
        float hl[16], pc[16], gav[16];
#pragma unroll
        for (int j = 0; j < 16; ++j) { const size_t tok = tok0 + t0 + j; hl[j] = HLOC[tok * 512 + ch]; pc[j] = PCUM[tok * 512 + ch]; gav[j] = bf2f(Z0[tok * EV_INP + ZC_GA + ch]); }
#pragma unroll
        for (int j = 0; j < 16; ++j) { const size_t tok = tok0 + t0 + j; Y0[tok * D + ch] = (bf16_t)(cvt_pk_bf16((hl[j] + pc[j] * hin) * gelu_tanh_(gav[j]), 0.f) & 0xffffu); }
    }
}
template <int NT>
__device__ __forceinline__ void dsa_prep_tokens(bf16_t* Z0, const float* qg, const float* kg, int m, int step, int lane) {
    const int d0 = (lane & 7) * 8;
    if (m + (NT - 1) * step >= M) return;
    u32x4 w[NT][2];
#pragma unroll
    for (int t = 0; t < NT; ++t)
#pragma unroll
        for (int which = 0; which < 2; ++which) w[t][which] = *(const u32x4*)(Z0 + (size_t)(m + t * step) * EV_INP + (which ? ZC_K : ZC_Q) + lane * 8);
#pragma unroll
    for (int t = 0; t < NT; ++t)
#pragma unroll
        for (int which = 0; which < 2; ++which) {
            bf16_t* p = Z0 + (size_t)(m + t * step) * EV_INP + (which ? ZC_K : ZC_Q) + lane * 8; const float* g = (which ? kg : qg) + d0;
            const u32x4 ww = w[t][which]; float v[8] = {bf_lo(ww.x), bf_hi(ww.x), bf_lo(ww.y), bf_hi(ww.y), bf_lo(ww.z), bf_hi(ww.z), bf_lo(ww.w), bf_hi(ww.w)};
            float s = 0.f;
#pragma unroll
            for (int i = 0; i < 8; ++i) s += v[i] * v[i];
            s += __shfl_xor(s, 1); s += __shfl_xor(s, 2); s += __shfl_xor(s, 4);
            const float rstd = 1.0f / sqrtf(s * (1.0f / 64.0f) + RMS_EPS);
            u32x4 o; o.x = cvt_pk_bf16(v[0] * rstd * g[0], v[1] * rstd * g[1]); o.y = cvt_pk_bf16(v[2] * rstd * g[2], v[3] * rstd * g[3]);
            o.z = cvt_pk_bf16(v[4] * rstd * g[4], v[5] * rstd * g[5]); o.w = cvt_pk_bf16(v[6] * rstd * g[6], v[7] * rstd * g[7]);
            *(u32x4*)p = o;
        }
}
__device__ __forceinline__ unsigned f2key(float f) { const unsigned u = __float_as_uint(f); return (u & 0x80000000u) ? ~u : (u | 0x80000000u); }
__device__ __forceinline__ float relu_i(float x) { const int i = __builtin_bit_cast(int, x); return __builtin_bit_cast(float, i > 0 ? i : 0); }
template <int WPL  >
__device__ __forceinline__ void radix_scan_row(LAS unsigned* hrow, LAS unsigned* pref, LAS unsigned* kneed, LAS unsigned* eqcnt, int row, int lane, int bits) {
    unsigned s = 0;
#pragma unroll
    for (int q = 0; q < WPL / 4; ++q) { const u32x4 c4 = *(const LAS u32x4*)(hrow + lane * WPL + 4 * q);
        s += (c4.x & 0xffffu) + (c4.x >> 16) + (c4.y & 0xffffu) + (c4.y >> 16) + (c4.z & 0xffffu) + (c4.z >> 16) + (c4.w & 0xffffu) + (c4.w >> 16); }
    unsigned v = s;
#pragma unroll
    for (int off = 1; off < 64; off <<= 1) { const unsigned t2 = __shfl_down(v, off); if (lane + off < 64) v += t2; }
    const unsigned ex = v - s;
    const unsigned kn = kneed[row];
    if (ex < kn && kn <= ex + s) {
        unsigned cum = ex; int bin = -1; unsigned cb = 0, ab = 0;
        for (int wi = WPL - 1; wi >= 0 && bin < 0; --wi) { const unsigned cw = hrow[lane * WPL + wi]; const unsigned chi = cw >> 16, clo = cw & 0xffffu;
            if (kn <= cum + chi) { bin = 2 * (lane * WPL + wi) + 1; cb = chi; ab = cum; }
            else { cum += chi; if (kn <= cum + clo) { bin = 2 * (lane * WPL + wi); cb = clo; ab = cum; } else cum += clo; } }
        pref[row] = (pref[row] << bits) | (unsigned)bin; kneed[row] = kn - ab; eqcnt[row] = cb;
    }
}
#define HADD(hp, d) __hip_atomic_fetch_add((hp) + ((d) >> 1), ((d) & 1u) ? 0x10000u : 1u, __ATOMIC_RELAXED, __HIP_MEMORY_SCOPE_WORKGROUP)
template <int HALF>
__device__ __forceinline__ void dsa_select_round(unsigned* MASK, ldsp lds, const u32x2 (&ky)[32], size_t tok0, int nt, int tid, int dbg) {
    const int lane = tid & 63, w = __builtin_amdgcn_readfirstlane(tid >> 6), g = lane >> 4;
    LAS unsigned* H0 = (LAS unsigned*)lds; LAS unsigned* H1 = (LAS unsigned*)(lds + 65536); LAS unsigned short* MB = (LAS unsigned short*)(lds + 81920); LAS unsigned* GE = (LAS unsigned*)(lds + 86016);
    LAS unsigned* pref = (LAS unsigned*)(lds + 98304); LAS unsigned* kneed = pref + 8; LAS unsigned* eqcnt = pref + 16; LAS unsigned* lcount = pref + 24; LAS unsigned* flg = pref + 32;
    const int ntw = (nt - w + 7) >> 3;
    if (tid < 8) { pref[tid] = 0u; kneed[tid] = 256u; eqcnt[tid] = 0u; lcount[tid] = 0u; }
    if (tid < 2) flg[tid] = 0u;
    { const u32x4 z4 = (u32x4){0u, 0u, 0u, 0u}; for (int i = tid; i < 256; i += 512) *(LAS u32x4*)((LAS unsigned*)MB + 4 * i) = z4;
      if (nt > 16) for (int i = tid; i < 4096; i += 512) *(LAS u32x4*)(H0 + 4 * i) = z4; }
    __syncthreads();
    if (nt > 16 && !(dbg & 2)) {
        { LAS unsigned* h0 = H0 + (2 * g) * 2048; LAS unsigned* h1 = H0 + (2 * g + 1) * 2048;
          if (!(dbg & 16))
#pragma unroll
          for (int tt = 0; tt < 32; ++tt) if (tt < ntw) { const unsigned da = ky[tt].x >> 20, db = ky[tt].y >> 20; HADD(h0, da); HADD(h1, db); } }
        __syncthreads();
        radix_scan_row<32>(H0 + w * 2048, pref, kneed, eqcnt, w, lane, 12);
        if (eqcnt[w] > 2048u && lane == 0) flg[0] = 1u;
        __syncthreads();
        if (flg[0] == 0u) {
            { const unsigned pf0 = pref[2 * g], pf1 = pref[2 * g + 1];
              if (!(dbg & 32))
#pragma unroll
              for (int tt = 0; tt < 32; ++tt) if (tt < ntw) { const unsigned ka = ky[tt].x, kb = ky[tt].y;
                  if ((ka >> 20) == pf0) { const unsigned p = __hip_atomic_fetch_add(lcount + 2 * g, 1u, __ATOMIC_RELAXED, __HIP_MEMORY_SCOPE_WORKGROUP); H0[(2 * g) * 2048 + p] = ka; }
                  if ((kb >> 20) == pf1) { const unsigned p = __hip_atomic_fetch_add(lcount + 2 * g + 1, 1u, __ATOMIC_RELAXED, __HIP_MEMORY_SCOPE_WORKGROUP); H0[(2 * g + 1) * 2048 + p] = kb; } } }
            __syncthreads();
            { const int n = (int)lcount[w]; LAS unsigned* hr = H1 + w * 512; const LAS unsigned* lst = H0 + w * 2048;
#pragma unroll 1
              for (int pass = ((dbg & 64) ? 3 : 1); pass < 3; ++pass) { const int shift = pass == 1 ? 10 : 0;
                  *(LAS u32x4*)(hr + 8 * lane) = (u32x4){0u, 0u, 0u, 0u}; *(LAS u32x4*)(hr + 8 * lane + 4) = (u32x4){0u, 0u, 0u, 0u};
                  const unsigned pw = pref[w];
                  asm volatile("" ::: "memory");
                  for (int i = lane; i < n; i += 64) { const unsigned key = lst[i]; const unsigned d = (key >> shift) & 1023u; if (pass == 1 || (key >> 10) == pw) HADD(hr, d); }
                  asm volatile("s_waitcnt lgkmcnt(0)" ::: "memory");
                  radix_scan_row<8>(hr, pref, kneed, eqcnt, w, lane, 10);
                  asm volatile("s_waitcnt lgkmcnt(0)" ::: "memory"); } }
        } else {
#pragma unroll 1
            for (int pass = 1; pass < 3; ++pass) { const int shift = pass == 1 ? 10 : 0;
                for (int i = tid; i < 1024; i += 512) *(LAS u32x4*)(H1 + 4 * i) = (u32x4){0u, 0u, 0u, 0u};
                __syncthreads();
                const unsigned pf0 = pref[2 * g], pf1 = pref[2 * g + 1];
#pragma unroll
                for (int tt = 0; tt < 32; ++tt) if (tt < ntw) { const unsigned ka = ky[tt].x, kb = ky[tt].y;
                    if ((ka >> (shift + 10)) == pf0) { const unsigned d = (ka >> shift) & 1023u; HADD(H1 + (2 * g) * 512, d); }
                    if ((kb >> (shift + 10)) == pf1) { const unsigned d = (kb >> shift) & 1023u; HADD(H1 + (2 * g + 1) * 512, d); } }
                __syncthreads();
                radix_scan_row<8>(H1 + w * 512, pref, kneed, eqcnt, w, lane, 10);
                __syncthreads(); }
        }
        __syncthreads();
        if (tid < 8 && kneed[tid] < eqcnt[tid]) flg[1] = 1u;
    }
    __syncthreads();
    {
        const unsigned T0 = pref[2 * g], T1 = pref[2 * g + 1];
        if (dbg & 8) { } else if (flg[1] == 0u) {
#pragma unroll
            for (int tt = 0; tt < 32; ++tt) if (tt < ntw) { const int t = w + 8 * tt;
                const unsigned long long b0 = __ballot(ky[tt].x >= T0), b1 = __ballot(ky[tt].y >= T1);
                if (lane == 0) { *(LAS unsigned long long*)(MB + (t * 2 + 0) * 4) = b0; *(LAS unsigned long long*)(MB + (t * 2 + 1) * 4) = b1; } }
            __syncthreads();
        } else {
            for (int i = tid; i < 2048; i += 512) GE[i] = 0u;
            __syncthreads();
#pragma unroll
            for (int tt = 0; tt < 32; ++tt) if (tt < ntw) { const int t = w + 8 * tt;
                const unsigned long long gt0 = __ballot(ky[tt].x > T0), eq0 = __ballot(ky[tt].x == T0), gt1 = __ballot(ky[tt].y > T1), eq1 = __ballot(ky[tt].y == T1);
                if (lane < 4) { GE[(2 * lane) * 256 + t] = (unsigned)((gt0 >> (16 * lane)) & 0xffffull) | ((unsigned)((eq0 >> (16 * lane)) & 0xffffull) << 16);
                                GE[(2 * lane + 1) * 256 + t] = (unsigned)((gt1 >> (16 * lane)) & 0xffffull) | ((unsigned)((eq1 >> (16 * lane)) & 0xffffull) << 16); } }
            __syncthreads();
            if (tid < 8) { const int q = tid; unsigned rem = kneed[q];
                for (int t = 0; t < nt; ++t) { unsigned x = GE[q * 256 + t]; unsigned e = x >> 16; const unsigned pc = __popc(e);
                    if (pc <= rem) rem -= pc;
                    else { unsigned keep = 0; while (rem) { const unsigned low = e & (0u - e); keep |= low; e ^= low; --rem; } x = (x & 0xffffu) | (keep << 16); GE[q * 256 + t] = x; } } }
            __syncthreads();
            for (int i = tid; i < 2048; i += 512) { const int r8 = i >> 8, t = i & 255; const unsigned x = GE[i]; MB[(t * 2 + (r8 & 1)) * 4 + (r8 >> 1)] = (unsigned short)((x | (x >> 16)) & 0xffffu); }
            __syncthreads();
        }
    }
    for (int i = tid; i < 1024; i += 512) { const int r8 = i >> 7, t2 = i & 127, gg = r8 >> 1, j = r8 & 1; const int q = 4 * gg + 2 * HALF + j;
        const unsigned m0 = MB[((2 * t2) * 2 + j) * 4 + gg], m1 = MB[((2 * t2 + 1) * 2 + j) * 4 + gg];
        MASK[(tok0 + q) * 128 + t2] = m0 | (m1 << 16); }
    __syncthreads();
}
__device__ __forceinline__ void dsa_select_unit(const bf16_t* Z0, unsigned* MASK, unsigned char* PARK, ldsp lds, int b, int qt, int tid, int dbg) {
    const int lane = tid & 63, w = __builtin_amdgcn_readfirstlane(tid >> 6), i16 = lane & 15, g = lane >> 4;
    const int c = qt >> 2, nt = 4 * (c + 1);
    const size_t tok0 = (size_t)b * SEQ + (size_t)qt * 16;
    bf16x8 qf[8][2];
#pragma unroll
    for (int h = 0; h < 8; ++h)
#pragma unroll
        for (int ks = 0; ks < 2; ++ks) qf[h][ks] = *(const bf16x8*)(Z0 + (tok0 + i16) * EV_INP + ZC_IQ + h * 64 + 32 * ks + 8 * g);
    const unsigned loff = (unsigned)(i16 * EV_INP + ZC_IK + 8 * g) * 2u;
    const bf16_t* kbase = Z0 + ((size_t)b * SEQ + (size_t)w * 16) * EV_INP;
    float wq[4][8];
#pragma unroll
    for (int r = 0; r < 4; ++r) { const u32x4 w4 = *(const u32x4*)(Z0 + (tok0 + 4 * g + r) * EV_INP + ZC_IW); const float k0 = 0.04419417382415922f;
        wq[r][0] = bf_lo(w4.x) * k0; wq[r][1] = bf_hi(w4.x) * k0; wq[r][2] = bf_lo(w4.y) * k0; wq[r][3] = bf_hi(w4.y) * k0; wq[r][4] = bf_lo(w4.z) * k0; wq[r][5] = bf_hi(w4.z) * k0; wq[r][6] = bf_lo(w4.w) * k0; wq[r][7] = bf_hi(w4.w) * k0; }
    u32x2 ky[32];
    const int ntw = (nt - w + 7) >> 3;
    LAS unsigned char* ring = lds + w * 16384; const unsigned ring_rd = (unsigned)(size_t)(ring + lane * 16);
    unsigned char* parkb = PARK + (size_t)blockIdx.x * 131072; const unsigned parko = (unsigned)tid * 8u;
#pragma unroll
    for (int h = 0; h < 8; ++h) asm volatile("" :: "v"(qf[h][0]), "v"(qf[h][1]), "v"(wq[0][h]), "v"(wq[1][h]), "v"(wq[2][h]), "v"(wq[3][h]));
    asm volatile("s_waitcnt vmcnt(0)" ::: "memory");
#define IK_ISSUE(tt_) do { const int tc_ = ((tt_) < ntw) ? (tt_) : (ntw - 1); unsigned long long kb64_ = (unsigned long long)kbase; asm volatile("" : "+s"(kb64_)); \
        const char* gp_ = (const char*)(kb64_ + (unsigned long long)tc_ * (128ull * EV_INP * 2ull)); unsigned lo2_ = loff; asm volatile("" : "+v"(lo2_)); \
        __builtin_amdgcn_global_load_lds((const unsigned*)(gp_ + lo2_), (LAS unsigned*)(ring + (2 * ((tt_) & 7)) * 1024), 16, 0, 0); \
        __builtin_amdgcn_global_load_lds((const unsigned*)(gp_ + lo2_ + 64), (LAS unsigned*)(ring + (2 * ((tt_) & 7) + 1) * 1024), 16, 0, 0); } while (0)
    if (ntw > 0 && !(dbg & 4)) {
#pragma unroll
        for (int tt = 0; tt < 8; ++tt) IK_ISSUE(tt);
    }
#pragma unroll
    for (int tt = 0; tt < 32; ++tt) {
        ky[tt] = (u32x2){0u, 0u};
        if (tt < ntw && !(dbg & 4)) {
            asm volatile("s_waitcnt vmcnt(%0)" :: "i"(tt < 8 ? 14 + tt : 22) : "memory");
            bf16x8 k0f, k1f;
            asm volatile("ds_read_b128 %0, %2 offset:%3\n\tds_read_b128 %1, %2 offset:%4\n\ts_waitcnt lgkmcnt(0)" : "=&v"(k0f), "=&v"(k1f) : "v"(ring_rd), "i"((2 * (tt & 7)) * 1024), "i"((2 * (tt & 7) + 1) * 1024) : "memory");
            IK_ISSUE(tt + 8);
            f32x4 acc[8];
#pragma unroll
            for (int h = 0; h < 8; ++h) acc[h] = MFMA16(qf[h][0], k0f, ((f32x4){0.f, 0.f, 0.f, 0.f}));
#pragma unroll
            for (int h = 0; h < 8; ++h) acc[h] = MFMA16(qf[h][1], k1f, acc[h]);
            float s0 = 0.f, s1 = 0.f, s2 = 0.f, s3 = 0.f;
#pragma unroll
            for (int h = 0; h < 8; ++h) { s0 += relu_i(acc[h][0]) * wq[0][h]; s1 += relu_i(acc[h][1]) * wq[1][h]; s2 += relu_i(acc[h][2]) * wq[2][h]; s3 += relu_i(acc[h][3]) * wq[3][h]; }
            ky[tt] = (u32x2){f2key(s0), f2key(s1)};
            { const u32x2 pk = (u32x2){f2key(s2), f2key(s3)}; unsigned long long pb_ = (unsigned long long)parkb; asm volatile("" : "+s"(pb_)); pb_ += (unsigned long long)tt * 4096ull;
              asm volatile("global_store_dwordx2 %0, %1, %2" :: "v"(parko), "v"(pk), "s"(pb_) : "memory"); }
        }
    }
#undef IK_ISSUE
    asm volatile("s_waitcnt vmcnt(0)" ::: "memory");
    __syncthreads();
    dsa_select_round<0>(MASK, lds, ky, tok0, nt, tid, dbg);
#pragma unroll
    for (int tt = 0; tt < 32; ++tt) if (tt < ntw) { unsigned long long pb_ = (unsigned long long)parkb; asm volatile("" : "+s"(pb_)); ky[tt] = *(const u32x2*)((const unsigned char*)(pb_ + (unsigned long long)tt * 4096ull) + parko); }
    dsa_select_round<1>(MASK, lds, ky, tok0, nt, tid, dbg);
}
__device__ __forceinline__ int t5_bucket(int rel) {
    const int n = rel < 0 ? -rel : rel; const int ret = rel > 0 ? 16 : 0;
    int v;
    if (n < 8) v = n; else { const int val = n < 12 ? 0 : n < 16 ? 1 : n < 23 ? 2 : n < 32 ? 3 : n < 46 ? 4 : n < 64 ? 5 : n < 91 ? 6 : 7; v = 8 + val; if (v > 15) v = 15; }
    return ret + v;
}
__device__ __forceinline__ void dsa_attn_unit(const bf16_t* Z0, const unsigned* MASK, const float* rel_bias, bf16_t* Y0, ldsp lds, int b, int h, int qt, int tid) {
    const int lane = tid & 63, w = __builtin_amdgcn_readfirstlane(tid >> 6), i16 = lane & 15, g = lane >> 4;
    LAS float* lut = (LAS float*)(lds + 73728);
    __syncthreads();
    if (tid < 192) lut[tid] = rel_bias[t5_bucket(tid - 128) * 8 + h] * LOG2E;
    int qpos[2]; size_t tokq[2]; bf16x8 qf[2][2]; const unsigned long long* mrow[2];
    const float scale = 0.125f * LOG2E;
#pragma unroll
    for (int nt = 0; nt < 2; ++nt) { qpos[nt] = qt * 256 + w * 32 + nt * 16 + i16; tokq[nt] = (size_t)b * SEQ + qpos[nt]; mrow[nt] = (const unsigned long long*)(MASK + tokq[nt] * 128);
#pragma unroll
        for (int ks = 0; ks < 2; ++ks) { const u32x4 q4 = *(const u32x4*)(Z0 + tokq[nt] * EV_INP + ZC_Q + h * 64 + 32 * ks + 8 * g);
            u32x4 r; r.x = cvt_pk_bf16(bf_lo(q4.x) * scale, bf_hi(q4.x) * scale); r.y = cvt_pk_bf16(bf_lo(q4.y) * scale, bf_hi(q4.y) * scale); r.z = cvt_pk_bf16(bf_lo(q4.z) * scale, bf_hi(q4.z) * scale); r.w = cvt_pk_bf16(bf_lo(q4.w) * scale, bf_hi(q4.w) * scale);
            qf[nt][ks] = __builtin_bit_cast(bf16x8, r); } }
    const int nkb = 2 * qt + 2;
    float mrun[2] = {-1e30f, -1e30f}, lsum[2] = {0.f, 0.f}; f32x4 o[2][4];
#pragma unroll
    for (int nt = 0; nt < 2; ++nt)
#pragma unroll
        for (int dt = 0; dt < 4; ++dt) o[nt][dt] = (f32x4){0.f, 0.f, 0.f, 0.f};
    const int srow = tid >> 3, sch = tid & 7;
    const bf16_t* sbase = Z0 + ((size_t)b * SEQ + srow) * EV_INP + h * 64 + sch * 8;
    const int soff = srow * 72 + sch * 8;
    u32x4 kreg[2], vreg[2];
#define ATT_LOAD(kb_) do { const bf16_t* src_ = sbase + (size_t)(kb_) * 128 * EV_INP; kreg[0] = *(const u32x4*)(src_ + ZC_K); vreg[0] = *(const u32x4*)(src_ + ZC_V); \
        kreg[1] = *(const u32x4*)(src_ + (size_t)64 * EV_INP + ZC_K); vreg[1] = *(const u32x4*)(src_ + (size_t)64 * EV_INP + ZC_V); } while (0)
#define ATT_STORE(buf_) do { LAS bf16_t* Kn_ = (LAS bf16_t*)(lds + (buf_) * 36864); LAS bf16_t* Vn_ = (LAS bf16_t*)(lds + (buf_) * 36864 + 18432); \
        *(LAS u32x4*)(Kn_ + soff) = kreg[0]; *(LAS u32x4*)(Kn_ + 64 * 72 + soff) = kreg[1]; *(LAS u32x4*)(Vn_ + soff) = vreg[0]; *(LAS u32x4*)(Vn_ + 64 * 72 + soff) = vreg[1]; } while (0)
    ATT_LOAD(0); ATT_STORE(0); ATT_LOAD(1);
    unsigned long long mcur[2][2] = {{mrow[0][0], mrow[0][1]}, {mrow[1][0], mrow[1][1]}}, mnx[2][2] = {{mrow[0][2], mrow[0][3]}, {mrow[1][2], mrow[1][3]}};
    __syncthreads();
    for (int kb = 0; kb < nkb; ++kb) {
#pragma unroll
        for (int sb = 0; sb < 2; ++sb) {
            const LAS bf16_t* Ks = (const LAS bf16_t*)(lds + (kb & 1) * 36864) + sb * 64 * 72; const LAS bf16_t* Vs = (const LAS bf16_t*)(lds + (kb & 1) * 36864 + 18432) + sb * 64 * 72;
            const int key0 = kb * 128 + sb * 64;
            const bool far = (key0 + 63 + 128 <= qt * 256);
            const float bfar = lut[0];
            f32x4 s[2][4];
#pragma unroll
            for (int nt = 0; nt < 2; ++nt) { const unsigned mlo = (unsigned)mcur[nt][sb] >> (4 * g), mhi = (unsigned)(mcur[nt][sb] >> 32) >> (4 * g);
#pragma unroll
                for (int kt = 0; kt < 4; ++kt)
#pragma unroll
                    for (int i = 0; i < 4; ++i) { float bias = bfar;
                        if (!far) { int idx = key0 + kt * 16 + 4 * g + i - qpos[nt]; idx = idx < -128 ? -128 : idx; bias = lut[idx + 128]; }
                        const int mbit = __builtin_amdgcn_sbfe((int)((kt & 2) ? mhi : mlo), 16 * (kt & 1) + i, 1);
                        s[nt][kt][i] = __uint_as_float((__float_as_uint(bias) & (unsigned)mbit) | (0xff800000u & ~(unsigned)mbit)); } }
#pragma unroll
            for (int kt = 0; kt < 4; ++kt) { const bf16x8 a0 = *(const LAS bf16x8*)(Ks + (kt * 16 + i16) * 72 + 8 * g), a1 = *(const LAS bf16x8*)(Ks + (kt * 16 + i16) * 72 + 32 + 8 * g);
#pragma unroll
                for (int nt = 0; nt < 2; ++nt) { s[nt][kt] = MFMA16(a0, qf[nt][0], s[nt][kt]); s[nt][kt] = MFMA16(a1, qf[nt][1], s[nt][kt]); } }
            bf16x8 pb[2][2];
#pragma unroll
            for (int nt = 0; nt < 2; ++nt) {
                float mx = fmaxf(fmaxf(s[nt][0][0], s[nt][0][1]), fmaxf(s[nt][0][2], s[nt][0][3]));
#pragma unroll
                for (int kt = 1; kt < 4; ++kt) mx = fmaxf(fmaxf(mx, s[nt][kt][0]), fmaxf(fmaxf(s[nt][kt][1], s[nt][kt][2]), s[nt][kt][3]));
                mx = fmaxf(mx, __shfl_xor(mx, 16)); mx = fmaxf(mx, __shfl_xor(mx, 32));
                const float mnew = fmaxf(mrun[nt], mx); const float alpha = __builtin_amdgcn_exp2f(mrun[nt] - mnew); mrun[nt] = mnew;
                float ps = 0.f;
#pragma unroll
                for (int kt = 0; kt < 4; ++kt)
#pragma unroll
                    for (int i = 0; i < 4; ++i) { const float p = __builtin_amdgcn_exp2f(s[nt][kt][i] - mnew); s[nt][kt][i] = p; ps += p; }
                lsum[nt] = lsum[nt] * alpha + ps;
#pragma unroll
                for (int dt = 0; dt < 4; ++dt) o[nt][dt] = o[nt][dt] * alpha;
                pb[nt][0] = pack_frag(s[nt][0], s[nt][1]); pb[nt][1] = pack_frag(s[nt][2], s[nt][3]); }
#pragma unroll
            for (int dt = 0; dt < 4; ++dt)
#pragma unroll
                for (int kk = 0; kk < 2; ++kk) { const bf16x8 vf = frag_tr(Vs, 72, 32 * kk, 16 * dt, lane);
#pragma unroll
                    for (int nt = 0; nt < 2; ++nt) o[nt][dt] = MFMA16(vf, pb[nt][kk], o[nt][dt]); }
        }
        if (kb + 1 < nkb) { ATT_STORE((kb + 1) & 1); mcur[0][0] = mnx[0][0]; mcur[0][1] = mnx[0][1]; mcur[1][0] = mnx[1][0]; mcur[1][1] = mnx[1][1]; }
        if (kb + 2 < nkb) { ATT_LOAD(kb + 2); mnx[0][0] = mrow[0][2 * kb + 4]; mnx[0][1] = mrow[0][2 * kb + 5]; mnx[1][0] = mrow[1][2 * kb + 4]; mnx[1][1] = mrow[1][2 * kb + 5]; }
        __syncthreads();
    }
#undef ATT_LOAD
#undef ATT_STORE
#pragma unroll
    for (int nt = 0; nt < 2; ++nt) { float ls = lsum[nt]; ls += __shfl_xor(ls, 16); ls += __shfl_xor(ls, 32); const float inv = 1.0f / ls;
#pragma unroll
        for (int dt = 0; dt < 4; ++dt) { u32x2 wv; wv.x = cvt_pk_bf16(o[nt][dt][0] * inv, o[nt][dt][1] * inv); wv.y = cvt_pk_bf16(o[nt][dt][2] * inv, o[nt][dt][3] * inv);
            *(u32x2*)(Y0 + tokq[nt] * D + 512 + h * 64 + 16 * dt + 4 * g) = wv; } }
}
__device__ __forceinline__ void moe_route_block(const bf16_t* hbuf, const float* gain, const float* RT  , bf16_t* XN, unsigned* RE, f32x2* RW, unsigned* CNT, ldsp lds, int vb, int tid) {
    const int lane = tid & 63, w = __builtin_amdgcn_readfirstlane(tid >> 6), i16 = lane & 15, g = lane >> 4;
    LAS float* Yc = (LAS float*)lds; LAS float* Wc = (LAS float*)(lds + 33792); LAS float* PART = (LAS float*)(lds + 59136); LAS float* LG = (LAS float*)(lds + 71424); LAS unsigned* lcnt = (LAS unsigned*)(lds + 83712);
    __syncthreads();
    if (tid < 32) lcnt[tid] = 0u;
    for (int i = tid; i < 12 * 132; i += 512) Wc[36 * 132 + i] = 0.f;
    f32x4 y[8][4];
    { f32x4 gv[4];
#pragma unroll
      for (int j = 0; j < 4; ++j) gv[j] = *((const f32x4*)gain + lane + 64 * j);
#pragma unroll
      for (int t = 0; t < 8; ++t) { const size_t tok = (size_t)vb * 64 + w * 8 + t; const u32x2* xr = (const u32x2*)(hbuf + tok * D) + lane; float s = 0.f;
#pragma unroll
          for (int j = 0; j < 4; ++j) { const u32x2 q = xr[64 * j]; y[t][j] = (f32x4){bf_lo(q.x), bf_hi(q.x), bf_lo(q.y), bf_hi(q.y)}; s += (y[t][j][0] * y[t][j][0] + y[t][j][1] * y[t][j][1]) + (y[t][j][2] * y[t][j][2] + y[t][j][3] * y[t][j][3]); }
          const float rstd = 1.0f / sqrtf(wave_sum(s) * (1.0f / D) + RMS_EPS);
          u32x2* o8 = (u32x2*)(XN + tok * D) + lane;
#pragma unroll
          for (int j = 0; j < 4; ++j) { y[t][j] = y[t][j] * rstd * gv[j]; u32x2 wv; wv.x = cvt_pk_bf16(y[t][j][0], y[t][j][1]); wv.y = cvt_pk_bf16(y[t][j][2], y[t][j][3]); o8[64 * j] = wv; } } }
    f32x4 acc[3];
#pragma unroll
    for (int nt = 0; nt < 3; ++nt) acc[nt] = (f32x4){0.f, 0.f, 0.f, 0.f};
    const int tt4 = w & 3, kh = w >> 2;
#pragma unroll
    for (int c = 0; c < 8; ++c) {
        __syncthreads();
        if ((lane >> 5) == (c & 1)) {
#pragma unroll
            for (int t = 0; t < 8; ++t) *(LAS f32x4*)(Yc + (8 * w + t) * 132 + 4 * (lane & 31)) = y[t][c >> 1]; }
        for (int idx = tid; idx < 36 * 32; idx += 512) { const int row = idx >> 5, q = idx & 31; *(LAS f32x4*)(Wc + row * 132 + 4 * q) = *(const f32x4*)(RT + (size_t)row * D + 128 * c + 4 * q); }
        __syncthreads();
#pragma unroll
        for (int S = 0; S < 4; ++S) { const int k0 = 64 * kh + 16 * S + 4 * g;
            const f32x4 a = *(const LAS f32x4*)(Yc + (16 * tt4 + i16) * 132 + k0);
#pragma unroll
            for (int nt = 0; nt < 3; ++nt) { const f32x4 bq = *(const LAS f32x4*)(Wc + (16 * nt + i16) * 132 + k0);
#pragma unroll
                for (int e = 0; e < 4; ++e) acc[nt] = __builtin_amdgcn_mfma_f32_16x16x4f32(a[e], bq[e], acc[nt], 0, 0, 0); } }
    }
    if (kh == 1) {
#pragma unroll
        for (int nt = 0; nt < 3; ++nt) *(LAS f32x4*)(PART + ((tt4 * 3 + nt) * 64 + lane) * 4) = acc[nt]; }
    __syncthreads();
    if (kh == 0) {
#pragma unroll
        for (int nt = 0; nt < 3; ++nt) { const f32x4 p = *(const LAS f32x4*)(PART + ((tt4 * 3 + nt) * 64 + lane) * 4);
#pragma unroll
            for (int i = 0; i < 4; ++i) LG[(16 * tt4 + 4 * g + i) * 48 + 16 * nt + i16] = acc[nt][i] + p[i]; } }
    __syncthreads();
    if (tid < 64) {
        const LAS float* lg = LG + tid * 48; const size_t tok = (size_t)vb * 64 + tid;
        int gs = 0; float gm = lg[0];
#pragma unroll
        for (int i = 1; i < 4; ++i) if (lg[i] > gm) { gm = lg[i]; gs = i; }
        float den = 0.f;
#pragma unroll
        for (int i = 0; i < 4; ++i) den += __expf(lg[i] - gm);
        const float gw = 1.0f / den;
        int i1 = 0; float v1 = lg[4 + gs * 8];
#pragma unroll
        for (int i = 1; i < 8; ++i) { const float v = lg[4 + gs * 8 + i]; if (v > v1) { v1 = v; i1 = i; } }
        int i2 = -1; float v2 = -INFINITY;
#pragma unroll
        for (int i = 0; i < 8; ++i) { const float v = lg[4 + gs * 8 + i]; if (i != i1 && v > v2) { v2 = v; i2 = i; } }
        const float e2 = __expf(v2 - v1); const float w1 = gw / (1.0f + e2), w2 = gw * e2 / (1.0f + e2);
        const unsigned ex1 = gs * 8 + i1, ex2 = gs * 8 + i2;
        RE[tok] = ex1 | (ex2 << 8); RW[tok] = (f32x2){w1, w2};
        __hip_atomic_fetch_add(lcnt + ex1, 1u, __ATOMIC_RELAXED, __HIP_MEMORY_SCOPE_WORKGROUP); __hip_atomic_fetch_add(lcnt + ex2, 1u, __ATOMIC_RELAXED, __HIP_MEMORY_SCOPE_WORKGROUP);
    }
    __syncthreads();
    if (tid < 32) CNT[vb * 32 + tid] = lcnt[tid];
}
__device__ __forceinline__ void moe_scatter_block(const unsigned* RE, const unsigned* CNT, const bf16_t* XN, bf16_t* XS, unsigned* SLOT, int* TILEE, ldsp lds, int vb, int tid) {
    const int lane = tid & 63, w = __builtin_amdgcn_readfirstlane(tid >> 6);
    LAS unsigned* part = (LAS unsigned*)lds; LAS unsigned* tot = (LAS unsigned*)(lds + 4096); LAS unsigned* bef = tot + 32; LAS unsigned* base = tot + 64;
    LAS unsigned* ent = (LAS unsigned*)(lds + 4608); LAS unsigned* slots = (LAS unsigned*)(lds + 5120);
    __syncthreads();
    { const int e = tid & 31, pt = tid >> 5; unsigned st = 0, sb = 0;
        for (int i = 0; i < 16; ++i) { const int v = pt * 16 + i; const unsigned cval = CNT[v * 32 + e]; st += cval; if (v < vb) sb += cval; }
        part[(pt * 32 + e) * 2] = st; part[(pt * 32 + e) * 2 + 1] = sb; }
    if (tid < 128) { const unsigned r = RE[(size_t)vb * 64 + (tid >> 1)]; ent[tid] = (tid & 1) ? ((r >> 8) & 255u) : (r & 255u); }
    __syncthreads();
    if (tid < 32) { unsigned st = 0, sb = 0; for (int p = 0; p < 16; ++p) { st += part[(p * 32 + tid) * 2]; sb += part[(p * 32 + tid) * 2 + 1]; } tot[tid] = st; bef[tid] = sb; }
    __syncthreads();
    if (tid == 0) { unsigned acc = 0; for (int e = 0; e < 32; ++e) { base[e] = acc * 256u; const unsigned nt = (tot[e] + 255u) >> 8;
            if (vb == 0) for (unsigned i = 0; i < nt; ++i) TILEE[acc + i] = e;
            acc += nt; }
        if (vb == 0) TILEE[MOE_TILES] = (int)acc; }
    __syncthreads();
    if (tid < 128) { const unsigned e = ent[tid]; unsigned rank = 0; for (int i = 0; i < tid; ++i) rank += (ent[i] == e) ? 1u : 0u;
        const unsigned s = base[e] + bef[e] + rank; slots[tid] = s; SLOT[(size_t)vb * 128 + tid] = s; }
    __syncthreads();
    for (int t = 0; t < 8; ++t) { const int tl = w * 8 + t; const size_t tok = (size_t)vb * 64 + tl;
        const u32x4* src = (const u32x4*)(XN + tok * D) + lane; const u32x4 a = src[0], bq = src[64];
        const unsigned s0 = slots[2 * tl], s1 = slots[2 * tl + 1];
        u32x4* d0 = (u32x4*)(XS + (size_t)s0 * D) + lane; u32x4* d1 = (u32x4*)(XS + (size_t)s1 * D) + lane;
        d0[0] = a; d0[64] = bq; d1[0] = a; d1[64] = bq; }
}
template <int NT>
__device__ __forceinline__ void moe_combine_tokens(const bf16_t* hin, const bf16_t* YD, const unsigned* SLOT, const f32x2* RW, bf16_t* hout, const bf16_t* ERAW_, float* ERSTD_, int m, int step, int lane) {
    if (m + (NT - 1) * step >= M) return;
    unsigned s0[NT], s1[NT]; f32x2 wv[NT];
#pragma unroll
    for (int t = 0; t < NT; ++t) { const size_t tok = (size_t)(m + t * step); s0[t] = SLOT[tok * 2]; s1[t] = SLOT[tok * 2 + 1]; wv[t] = RW[tok]; }
    f32x4 hv[NT][4]; u32x2 ya[NT][4], yb[NT][4], ye[NT][4];
#pragma unroll
    for (int t = 0; t < NT; ++t) { const size_t tok = (size_t)(m + t * step);
        const u32x2* hr = (const u32x2*)(hin + tok * D) + lane; const u32x2* y0 = (const u32x2*)(YD + (size_t)s0[t] * D) + lane; const u32x2* y1 = (const u32x2*)(YD + (size_t)s1[t] * D) + lane; const u32x2* er = (const u32x2*)(ERAW_ + tok * D) + lane;
#pragma unroll
        for (int j = 0; j < 4; ++j) { const u32x2 q = hr[64 * j]; hv[t][j] = (f32x4){bf_lo(q.x), bf_hi(q.x), bf_lo(q.y), bf_hi(q.y)}; ya[t][j] = y0[64 * j]; yb[t][j] = y1[64 * j]; ye[t][j] = er[64 * j]; } }
#pragma unroll
    for (int t = 0; t < NT; ++t) { const size_t tok = (size_t)(m + t * step);
        u32x2* hb = (u32x2*)(hout + tok * D) + lane; float es = 0.f;
#pragma unroll
        for (int j = 0; j < 4; ++j) { f32x4 v = hv[t][j]; const u32x2 a = ya[t][j], bq = yb[t][j], e2 = ye[t][j];
            v[0] += wv[t][0] * bf_lo(a.x) + wv[t][1] * bf_lo(bq.x); v[1] += wv[t][0] * bf_hi(a.x) + wv[t][1] * bf_hi(bq.x); v[2] += wv[t][0] * bf_lo(a.y) + wv[t][1] * bf_lo(bq.y); v[3] += wv[t][0] * bf_hi(a.y) + wv[t][1] * bf_hi(bq.y);
            u32x2 o; o.x = cvt_pk_bf16(v[0], v[1]); o.y = cvt_pk_bf16(v[2], v[3]); hb[64 * j] = o;
            es += (bf_lo(e2.x) * bf_lo(e2.x) + bf_hi(e2.x) * bf_hi(e2.x)) + (bf_lo(e2.y) * bf_lo(e2.y) + bf_hi(e2.y) * bf_hi(e2.y)); }
        es = wave_sum(es);
        if (lane == 0) ERSTD_[tok] = 1.0f / sqrtf(es * (1.0f / D) + RMS_EPS); }
}
__device__ __forceinline__ float ret_log2g(int h) { const float x = __builtin_ldexpf(1.0f, -5 - h); const float ln = -(x + x * x * 0.5f + x * x * x * (1.0f / 3.0f) + x * x * x * x * 0.25f + x * x * x * x * x * 0.2f + x * x * x * x * x * x * (1.0f / 6.0f)); return ln * LOG2E; }
__device__ __forceinline__ void ret_kv_unit(const bf16_t* Z1, float* SKV, ldsp lds, int b, int h, int sc, int tid) {
    const int lane = tid & 63, w = __builtin_amdgcn_readfirstlane(tid >> 6), i16 = lane & 15, g = lane >> 4;
    LAS bf16_t* Vs = (LAS bf16_t*)lds; LAS bf16_t* Ks = (LAS bf16_t*)(lds + 33792);
    const float l2g = ret_log2g(h);
    f32x4 acc[2][8];
#pragma unroll
    for (int mt = 0; mt < 2; ++mt)
#pragma unroll
        for (int nt = 0; nt < 8; ++nt) acc[mt][nt] = (f32x4){0.f, 0.f, 0.f, 0.f};
    const size_t tok0 = (size_t)b * SEQ + (size_t)sc * 256;
    for (int jb = 0; jb < 4; ++jb) {
        __syncthreads();
#pragma unroll
        for (int q = 0; q < 4; ++q) { const int idx = tid + 512 * q, row = idx >> 5, chn = idx & 31;
            *(LAS u32x4*)(Vs + row * 264 + chn * 8) = *(const u32x4*)(Z1 + (tok0 + jb * 64 + row) * OD_IN + 2048 + h * 256 + chn * 8); }
#pragma unroll
        for (int q = 0; q < 2; ++q) { const int idx = tid + 512 * q, row = idx >> 4, chn = idx & 15;
            const u32x4 kw = *(const u32x4*)(Z1 + (tok0 + jb * 64 + row) * OD_IN + 1024 + h * 128 + chn * 8);
            const float dk = exp2f(l2g * (float)(255 - (jb * 64 + row)));
            u32x4 o; o.x = cvt_pk_bf16(bf_lo(kw.x) * dk, bf_hi(kw.x) * dk); o.y = cvt_pk_bf16(bf_lo(kw.y) * dk, bf_hi(kw.y) * dk); o.z = cvt_pk_bf16(bf_lo(kw.z) * dk, bf_hi(kw.z) * dk); o.w = cvt_pk_bf16(bf_lo(kw.w) * dk, bf_hi(kw.w) * dk);
            *(LAS u32x4*)(Ks + row * 136 + chn * 8) = o; }
        __syncthreads();
#pragma unroll
        for (int kk = 0; kk < 2; ++kk) {
            bf16x8 af[2];
#pragma unroll
            for (int mt = 0; mt < 2; ++mt) af[mt] = frag_tr(Vs, 264, 32 * kk, 32 * w + 16 * mt, lane);
#pragma unroll
            for (int nt = 0; nt < 8; ++nt) { const bf16x8 bfr = frag_tr(Ks, 136, 32 * kk, 16 * nt, lane);
#pragma unroll
                for (int mt = 0; mt < 2; ++mt) acc[mt][nt] = MFMA16(af[mt], bfr, acc[mt][nt]); }
        }
    }
    float* out = SKV + ((size_t)((b * 8 + h) * 16 + sc)) * 32768;
#pragma unroll
    for (int mt = 0; mt < 2; ++mt)
#pragma unroll
        for (int nt = 0; nt < 8; ++nt)
#pragma unroll
            for (int i = 0; i < 4; ++i) out[(size_t)(32 * w + 16 * mt + 4 * g + i) * 128 + 16 * nt + i16] = acc[mt][nt][i];
}
__device__ __forceinline__ void ret_out_unit(const bf16_t* Z1, const bf16_t* SST, const float* gn_g, bf16_t* Y, ldsp lds, int b, int h, int sc, int tid, int dbg) {
    const int w = __builtin_amdgcn_readfirstlane(tid >> 6);
    const float l2g = ret_log2g(h);
    const size_t tok0 = (size_t)b * SEQ + (size_t)sc * 256;
    LAS bf16_t* RA = (LAS bf16_t*)lds; LAS bf16_t* RB = (LAS bf16_t*)(lds + 69632);
    const int tq0 = w, tq1 = 15 - w;
#define FRESH_LANE() int ln_ = tid & 63; asm volatile("" : "+v"(ln_)); const int i16 = ln_ & 15, g = ln_ >> 4; (void)i16; (void)g
#define RET_LOAD(jb_) do { unsigned t_ = (unsigned)tid; asm volatile("" : "+v"(t_)); \
        const char* vb_ = (const char*)(Z1 + (tok0 + (jb_) * 64) * OD_IN + 2048 + h * 256); const char* kb_ = (const char*)(Z1 + (tok0 + (jb_) * 64) * OD_IN + 1024 + h * 128); \
        _Pragma("unroll") for (int q = 0; q < 4; ++q) { const unsigned idx = t_ + 512u * q, row = idx >> 5, chn = idx & 31u; vr[q] = *(const u32x4*)(vb_ + (size_t)((row * OD_IN + chn * 8u) * 2u)); } \
        _Pragma("unroll") for (int q = 0; q < 2; ++q) { const unsigned idx = t_ + 512u * q, row = idx >> 4, chn = idx & 15u; kr[q] = *(const u32x4*)(kb_ + (size_t)((row * OD_IN + chn * 8u) * 2u)); } } while (0)
#define RET_STORE() do { unsigned t_ = (unsigned)tid; asm volatile("" : "+v"(t_)); \
        _Pragma("unroll") for (int q = 0; q < 4; ++q) { const unsigned idx = t_ + 512u * q, row = idx >> 5, chn = idx & 31u; *(LAS u32x4*)(RA + row * 264 + chn * 8) = vr[q]; } \
        _Pragma("unroll") for (int q = 0; q < 2; ++q) { const unsigned idx = t_ + 512u * q, row = idx >> 4, chn = idx & 15u; *(LAS u32x4*)(RA + 16896 + row * 136 + chn * 8) = kr[q]; } } while (0)
    __syncthreads();
    {
        const char* S = (const char*)(SST + ((size_t)((b * 8 + h) * 16 + sc)) * 32768); const char* Q = (const char*)(Z1 + tok0 * OD_IN + h * 128);
        unsigned t_ = (unsigned)tid; asm volatile("" : "+v"(t_));
        u32x4 sr[8], qr[8];
#pragma unroll
        for (int q = 0; q < 8; ++q) { const unsigned idx = t_ + 512u * q, row = idx >> 4, chn = idx & 15u; sr[q] = *(const u32x4*)(S + (size_t)(idx * 16u)); qr[q] = *(const u32x4*)(Q + (size_t)((row * OD_IN + chn * 8u) * 2u)); }
#pragma unroll
        for (int q = 0; q < 8; ++q) { const unsigned idx = t_ + 512u * q, row = idx >> 4, chn = idx & 15u; *(LAS u32x4*)(RA + row * 136 + chn * 8) = sr[q]; *(LAS u32x4*)(RB + row * 136 + chn * 8) = qr[q]; }
    }
    u32x4 vr[4], kr[2];
    RET_LOAD(0);
    __syncthreads();
    f32x4 o[2][16];
    {
        FRESH_LANE();
        bf16x8 qf[2][4];
#pragma unroll
        for (int ks = 0; ks < 4; ++ks) { qf[0][ks] = *(const LAS bf16x8*)(RB + (16 * tq0 + i16) * 136 + 32 * ks + 8 * g); qf[1][ks] = *(const LAS bf16x8*)(RB + (16 * tq1 + i16) * 136 + 32 * ks + 8 * g); }
#pragma unroll
        for (int et = 0; et < 16; ++et) {
            if ((et & 1) == 0) asm volatile("" ::: "memory");
#pragma unroll
            for (int ks = 0; ks < 4; ++ks) { const bf16x8 a = *(const LAS bf16x8*)(RA + (16 * et + i16) * 136 + 32 * ks + 8 * g);
                if (ks == 0) { o[0][et] = MFMA16(a, qf[0][0], ((f32x4){0.f, 0.f, 0.f, 0.f})); o[1][et] = MFMA16(a, qf[1][0], ((f32x4){0.f, 0.f, 0.f, 0.f})); }
                else { o[0][et] = MFMA16(a, qf[0][ks], o[0][et]); o[1][et] = MFMA16(a, qf[1][ks], o[1][et]); } } }
        const float dq0 = __builtin_amdgcn_exp2f(l2g * (float)(16 * tq0 + i16 + 1)), dq1 = __builtin_amdgcn_exp2f(l2g * (float)(16 * tq1 + i16 + 1));
#pragma unroll
        for (int et = 0; et < 16; ++et) { o[0][et] = o[0][et] * dq0; o[1][et] = o[1][et] * dq1; }
    }
    __syncthreads();
    RET_STORE(); RET_LOAD(1);
    __syncthreads();
#pragma unroll 1
    for (int jb = 0; jb < 4; ++jb) {
        {
            FRESH_LANE();
            const LAS bf16_t* Vs = RA; const LAS bf16_t* Ks = RA + 16896;
            bf16x8 pb[2][2];
#pragma unroll
            for (int nt = 0; nt < 2; ++nt) { const int tq = nt ? tq1 : tq0; pb[nt][0] = (bf16x8){0, 0, 0, 0, 0, 0, 0, 0}; pb[nt][1] = pb[nt][0];
                if (jb <= (tq >> 2)) {
                    const int ipos = 16 * tq + i16;
                    bf16x8 qf1[4];
#pragma unroll
                    for (int ks = 0; ks < 4; ++ks) qf1[ks] = *(const LAS bf16x8*)(RB + ipos * 136 + 32 * ks + 8 * g);
                    f32x4 s[4];
#pragma unroll
                    for (int kt = 0; kt < 4; ++kt) { f32x4 a4 = (f32x4){0.f, 0.f, 0.f, 0.f};
#pragma unroll
                        for (int ks = 0; ks < 4; ++ks) { const bf16x8 a = *(const LAS bf16x8*)(Ks + (kt * 16 + i16) * 136 + 32 * ks + 8 * g); a4 = MFMA16(a, qf1[ks], a4); }
#pragma unroll
                        for (int i = 0; i < 4; ++i) { const int j = jb * 64 + kt * 16 + 4 * g + i; const int df = ipos - j; a4[i] = (df >= 0) ? a4[i] * __builtin_amdgcn_exp2f(l2g * (float)df) : 0.f; }
                        s[kt] = a4; }
                    pb[nt][0] = pack_frag(s[0], s[1]); pb[nt][1] = pack_frag(s[2], s[3]); } }
            asm volatile("" ::: "memory");
#pragma unroll
            for (int et = 0; et < 16; ++et)
#pragma unroll
                for (int kk = 0; kk < 2; ++kk) { const bf16x8 vf = frag_tr(Vs, 264, 32 * kk, 16 * et, ln_); o[0][et] = MFMA16(vf, pb[0][kk], o[0][et]); o[1][et] = MFMA16(vf, pb[1][kk], o[1][et]); }
        }
        __syncthreads();
        if (jb + 1 < 4) { RET_STORE(); if (jb + 2 < 4) RET_LOAD(jb + 2); __syncthreads(); }
    }
#undef RET_LOAD
#undef RET_STORE
    {
        LAS bf16_t* T = (LAS bf16_t*)(lds + w * 16896);
#pragma unroll
        for (int nt = 0; nt < 2; ++nt) {
            FRESH_LANE();
            float sm = 0.f;
#pragma unroll
            for (int et = 0; et < 16; ++et) sm += (o[nt][et][0] + o[nt][et][1]) + (o[nt][et][2] + o[nt][et][3]);
            sm += __shfl_xor(sm, 16); sm += __shfl_xor(sm, 32);
            const float mean = sm * (1.0f / 256.0f); float vq = 0.f;
#pragma unroll
            for (int et = 0; et < 16; ++et) { const f32x4 dd = o[nt][et] - mean; vq += (dd[0] * dd[0] + dd[1] * dd[1]) + (dd[2] * dd[2] + dd[3] * dd[3]); }
            vq += __shfl_xor(vq, 16); vq += __shfl_xor(vq, 32);
            const float rstd = 1.0f / sqrtf(vq * (1.0f / 256.0f) + GN_EPS);
#pragma unroll
            for (int et = 0; et < 16; ++et) { u32x2 pv; pv.x = cvt_pk_bf16((o[nt][et][0] - mean) * rstd, (o[nt][et][1] - mean) * rstd); pv.y = cvt_pk_bf16((o[nt][et][2] - mean) * rstd, (o[nt][et][3] - mean) * rstd);
                *(LAS u32x2*)(T + (16 * nt + i16) * 264 + 16 * et + 4 * g) = pv; }
        }
        asm volatile("s_waitcnt lgkmcnt(0)" ::: "memory");
        {
            FRESH_LANE();
            const int ch = ln_ & 31, rh = ln_ >> 5;
            const f32x4 ga = *(const f32x4*)(gn_g + h * 256 + 8 * ch), gb = *(const f32x4*)(gn_g + h * 256 + 8 * ch + 4);
#pragma unroll 4
            for (int r = 0; r < 16; ++r) { const int q = 2 * r + rh; const int tq = (q < 16) ? tq0 : tq1; const size_t tok = tok0 + 16 * tq + (q & 15);
                const u32x4 nv = *(const LAS u32x4*)(T + q * 264 + 8 * ch); const u32x4 gv = *(const u32x4*)(Z1 + tok * OD_IN + 4096 + h * 256 + 8 * ch);
                u32x4 ov;
                ov.x = cvt_pk_bf16(bf_lo(nv.x) * ga[0] * siluf_(bf_lo(gv.x)), bf_hi(nv.x) * ga[1] * siluf_(bf_hi(gv.x))); ov.y = cvt_pk_bf16(bf_lo(nv.y) * ga[2] * siluf_(bf_lo(gv.y)), bf_hi(nv.y) * ga[3] * siluf_(bf_hi(gv.y)));
                ov.z = cvt_pk_bf16(bf_lo(nv.z) * gb[0] * siluf_(bf_lo(gv.z)), bf_hi(nv.z) * gb[1] * siluf_(bf_hi(gv.z))); ov.w = cvt_pk_bf16(bf_lo(nv.w) * gb[2] * siluf_(bf_lo(gv.w)), bf_hi(nv.w) * gb[3] * siluf_(bf_hi(gv.w)));
                *(u32x4*)(Y + tok * 2048 + h * 256 + 8 * ch) = ov; }
        }
    }
#undef FRESH_LANE
}
enum InIdx { I_X = 0, I_P, I_RELB, I_MIXG, I_FFNG, I_PLEG, I_EVWIN, I_CONVW, I_CONVB, I_WA, I_BA, I_WX, I_BX, I_LAM, I_QG, I_KG, I_EVWOUT, I_ODWIN, I_GNG, I_ODWOUT,
             I_WGROUP, I_WEXPERT, I_WGATE, I_WUP, I_WDOWN, I_PLEUP, I_PLEGATE, N_IN };
struct Args { const float* in[N_IN]; float* out; unsigned char* ws; int ph_lo, ph_hi, flags, pad; };
static_assert(sizeof(Args) == N_IN * 8 + 8 + 8 + 16, "Args has no padding");
constexpr int N_PHASES = 24;

__global__ void __launch_bounds__(512, 2) mk_fwd(Args args) {
    extern __shared__ __attribute__((aligned(16))) unsigned char lds_raw[];
    const ldsp lds = (ldsp)lds_raw;
    volatile LAS unsigned* MISC = (volatile LAS unsigned*)(lds + LDS_MISC_OFF);
    const int tid = threadIdx.x, lane = tid & 63, wave = __builtin_amdgcn_readfirstlane(tid >> 6);
    const int G = gridDim.x, bid = blockIdx.x;
    const int gw = bid * 8 + wave, ngw = G * 8;
    unsigned char* ws0 = args.ws;
#define FRESH_WS() size_t wsz_ = 0; asm volatile("" : "+s"(wsz_)); unsigned char* ws = ws0 + wsz_
    for (int u = tid; u < 64; u += 512) MISC[u] = 0u;
    __syncthreads();
#if MK_N_LAUNCHES == 1
    XcdBarrier bar = xcd_barrier_post((unsigned*)(ws0 + WS_CTL) + CW_BAR, MISC + 8);
#define GRID_BAR() xcd_barrier(bar)
#else
#define GRID_BAR() do { } while (0)
#endif
    const int lo = args.ph_lo, hi = args.ph_hi;
#ifndef ONLY_PHASE
#define ONLY_PHASE (-1)
#endif
#define IN(k) ((ONLY_PHASE < 0 || ONLY_PHASE == (k)) && lo <= (k) && (k) < hi)
#define SEAM(k) do { if (IN(k) && IN((k) + 1)) GRID_BAR(); } while (0)

    const float* x = args.in[I_X];
#define H_A ((bf16_t*)(ws + WS_HA))
#define H_B ((bf16_t*)(ws + WS_HB))
#define XN ((bf16_t*)(ws + WS_XN))
#define PB ((bf16_t*)(ws + WS_PB))
#define ERAW ((bf16_t*)(ws + WS_ERAW))
#define ESS ((float*)(ws + MS_ESS))
#define ERSTD ((float*)(ws + MS_ERSTD))
#define Z ((bf16_t*)(ws + WS_Z))
#define Y ((bf16_t*)(ws + WS_Y))
#define ROPE ((float*)(ws + WS_ROPE))
#define RT ((float*)(ws + WS_RT))
#define W_GU ((bf16_t*)(ws + WS_W_GU))
#define W_DN ((bf16_t*)(ws + WS_W_DN))
    LAS float* scr = (LAS float*)(lds + wave * 16640);

    if (IN(0)) { FRESH_WS();
        tr_matrix<0>(args.in[I_EVWIN], nullptr, D, EV_IN, (bf16_t*)(ws + WS_W_EVIN), EV_INP, scr, lane, gw, ngw);
        tr_matrix<0>(args.in[I_EVWOUT], nullptr, D, D, (bf16_t*)(ws + WS_W_EVOUT), D, scr, lane, gw, ngw);
        tr_matrix<1>(args.in[I_ODWIN], nullptr, D, OD_IN, (bf16_t*)(ws + WS_W_ODIN), OD_IN, scr, lane, gw, ngw);
        tr_matrix<0>(args.in[I_ODWOUT], nullptr, 2048, D, (bf16_t*)(ws + WS_W_ODOUT), D, scr, lane, gw, ngw);
        for (int l = 0; l < 2; ++l) {
            tr_matrix<0>(args.in[I_PLEUP] + (size_t)l * PLE * D, nullptr, PLE, D, (bf16_t*)(ws + WS_W_PLEUP) + (size_t)l * D * PLE, D, scr, lane, gw, ngw);
            tr_matrix<0>(args.in[I_PLEGATE] + (size_t)l * D * D, nullptr, D, D, (bf16_t*)(ws + WS_W_PLEGATE) + (size_t)l * D * D, D, scr, lane, gw, ngw); }
        convert_moe_layer(args.in[I_WGATE], args.in[I_WUP], args.in[I_WDOWN], W_GU, W_DN, scr, lane, gw, ngw);
        for (int m = gw; m < M; m += 4 * ngw) rms_rows_to_bf16<4, true>(x, args.in[I_MIXG], XN, m, ngw, lane);
        { const float* p = args.in[I_P]; const size_t n4 = (size_t)2 * M * PLE / 4;
          for (size_t i = (size_t)bid * 512 + tid; i < n4; i += (size_t)G * 512) { const f32x4 v = ((const f32x4*)p)[i]; u32x2 o; o.x = cvt_pk_bf16(v[0], v[1]); o.y = cvt_pk_bf16(v[2], v[3]); ((u32x2*)PB)[i] = o; } }
        for (int i = bid * 512 + tid; i < SEQ * 64; i += G * 512) { const int pos = i >> 6, f = i & 63;
            const float inv = powf(10000.0f, -(float)f / 64.0f); const float ang = (float)pos * inv; ROPE[i] = cosf(ang); ROPE[SEQ * 64 + i] = sinf(ang); }
        for (int i = bid * 512 + tid; i < 2 * 36 * D; i += G * 512) { const int l = i / (36 * D), r = i % (36 * D), o = r / D, k = r % D;
            RT[i] = (o < 4) ? args.in[I_WGROUP][(size_t)l * D * 4 + k * 4 + o] : args.in[I_WEXPERT][(size_t)l * D * 32 + k * 32 + (o - 4)]; }
    }
    SEAM(0);
    if (IN(1)) { FRESH_WS();
        { pg8::Gemm gm{XN, (const bf16_t*)(ws + WS_W_EVIN), M, EV_INP, D}; pg8::StaticOrder S; S.init(M, EV_INP, G, bid); EpiPlainBf16<EV_INP, 13> E{Z};
          pg8::gemm_phase<EpiPlainBf16<EV_INP, 13>, pg8::StaticOrder>(lds, gm, S, E, nullptr); }
        __syncthreads();
        { pg8::Gemm gm{PB, (const bf16_t*)(ws + WS_W_PLEUP), M, D, PLE}; pg8::StaticOrder S; S.init(M, D, G, bid); EpiPlainBf16<D, 4> E{ERAW};
          pg8::gemm_phase<EpiPlainBf16<D, 4>, pg8::StaticOrder>(lds, gm, S, E, nullptr); }
    }
    SEAM(1);
    if (IN(2)) { FRESH_WS();
        for (int u = bid; u < 256; u += G)
            lru_local_unit(Z, args.in[I_CONVW], args.in[I_CONVB], args.in[I_WA], args.in[I_BA], args.in[I_WX], args.in[I_BX], args.in[I_LAM],
                           (float*)(ws + WS_HLOC), (float*)(ws + WS_PCUM), (float*)(ws + MS_SUMA), (float*)(ws + MS_SUMH), lds, u >> 6, u & 63, tid);
        if (!(args.flags & 1)) for (int m = gw; m < M; m += 4 * ngw) dsa_prep_tokens<4>(Z, args.in[I_QG], args.in[I_KG], m, ngw, lane);
    }
    SEAM(2);
    if (IN(3)) { FRESH_WS();
        for (int idx = bid; idx < 1024; idx += G) { const int r = idx >> 8, v = idx & 255; const int qt = (r & 1) ? 255 - v : v;
            dsa_select_unit(Z, (unsigned*)(ws + ((args.flags & 1) ? WS_Y + 32 * MiB : WS_MASK)), ws + WS_Y + 32 * MiB, lds, r, qt, tid, args.flags); }
    }
    SEAM(3);
    if (IN(4)) { FRESH_WS();
        for (int idx = bid; idx < 512; idx += G) { const int r = idx >> 8, v = idx & 255; const int bh = v >> 3; const int qt = r ? 15 - (v & 7) : (v & 7);
            dsa_attn_unit(Z, (const unsigned*)(ws + WS_MASK), args.in[I_RELB], Y, lds, bh >> 3, bh & 7, qt, tid); }
        __syncthreads();
        for (int u = bid; u < 256; u += G)
            lru_fix_unit(Z, (const float*)(ws + WS_HLOC), (const float*)(ws + WS_PCUM), (const float*)(ws + MS_SUMA), (const float*)(ws + MS_SUMH), Y, u >> 6, u & 63, tid);
    }
    SEAM(4);
    if (IN(5)) { FRESH_WS();
        __syncthreads();
        pg8::Gemm gm{Y, (const bf16_t*)(ws + WS_W_EVOUT), M, D, D}; pg8::StaticOrder S; S.init(M, D, G, bid); EpiResid<true> E{x, H_A};
        pg8::gemm_phase<EpiResid<true>, pg8::StaticOrder>(lds, gm, S, E, nullptr);
    }
    SEAM(5);
    if (IN(6 + 0)) { FRESH_WS();
        __syncthreads();
        if (false) convert_moe_layer(args.in[I_WGATE] + (size_t)NEXP * D * FF, args.in[I_WUP] + (size_t)NEXP * D * FF, args.in[I_WDOWN] + (size_t)NEXP * FF * D, W_GU, W_DN, scr, lane, gw, ngw);
        for (int vb = bid; vb < 256; vb += G)
            moe_route_block(H_A, args.in[I_FFNG] + 0 * D, RT + (size_t)0 * 36 * D, XN, (unsigned*)(ws + MS_RE), (f32x2*)(ws + MS_RW), (unsigned*)(ws + MS_CNT), lds, vb, tid);
    }
    SEAM(6 + 0);
    if (IN(6 + 1)) { FRESH_WS(); for (int vb = bid; vb < 256; vb += G) moe_scatter_block((const unsigned*)(ws + MS_RE), (const unsigned*)(ws + MS_CNT), XN, (bf16_t*)(ws + WS_XS), (unsigned*)(ws + MS_SLOT), (int*)(ws + MS_TILEE), lds, vb, tid); }
    SEAM(6 + 1);
    if (IN(6 + 2)) { FRESH_WS();
        __syncthreads();
        pg8::Gemm gm{(const bf16_t*)(ws + WS_XS), W_GU, MOE_ROWS, NEXP * 1024, D}; MoeOrder S; S.init((const int*)(ws + MS_TILEE), G, bid); EpiSwiglu E{Y};
        pg8::gemm_phase<EpiSwiglu, MoeOrder>(lds, gm, S, E, nullptr);
    }
    SEAM(6 + 2);
    if (IN(6 + 3)) { FRESH_WS();
        __syncthreads();
        pg8::Gemm gm{Y, W_DN, MOE_ROWS, NEXP * 1024, FF}; MoeOrder S; S.init((const int*)(ws + MS_TILEE), G, bid); EpiPlainBf16<D, 4> E{(bf16_t*)(ws + WS_YD)};
        pg8::gemm_phase<EpiPlainBf16<D, 4>, MoeOrder>(lds, gm, S, E, nullptr);
    }
    SEAM(6 + 3);
    if (IN(6 + 4)) { FRESH_WS(); for (int m = gw; m < M; m += 2 * ngw) moe_combine_tokens<2>(H_A, (const bf16_t*)(ws + WS_YD), (const unsigned*)(ws + MS_SLOT), (const f32x2*)(ws + MS_RW), H_B, ERAW, ERSTD, m, ngw, lane); }
    SEAM(6 + 4);
    if (IN(6 + 5)) { FRESH_WS();
        __syncthreads();
        pg8::Gemm gm{H_B, (const bf16_t*)(ws + WS_W_PLEGATE) + (size_t)0 * D * D, M, D, D}; pg8::StaticOrder S; S.init(M, D, G, bid); EpiPleGate<false> E{H_B, H_A, ERAW, ERSTD, args.in[I_PLEG] + 0 * D};
        pg8::gemm_phase<EpiPleGate<false>, pg8::StaticOrder>(lds, gm, S, E, nullptr);
    }
    SEAM(11);
        if (IN(12)) { FRESH_WS(); for (int m = gw; m < M; m += 4 * ngw) rms_rows_to_bf16<4, false>(H_A, args.in[I_MIXG] + D, XN, m, ngw, lane); }
        SEAM(12);
        if (IN(13)) { FRESH_WS();
            __syncthreads();
            { pg8::Gemm gm{XN, (const bf16_t*)(ws + WS_W_ODIN), M, OD_IN, D}; pg8::StaticOrder S; S.init(M, OD_IN, G, bid); EpiRet E{Z, ROPE};
              pg8::gemm_phase<EpiRet, pg8::StaticOrder>(lds, gm, S, E, nullptr); }
            __syncthreads();
            { pg8::Gemm gm{PB + (size_t)M * PLE, (const bf16_t*)(ws + WS_W_PLEUP) + (size_t)D * PLE, M, D, PLE}; pg8::StaticOrder S; S.init(M, D, G, bid); EpiPlainBf16<D, 4> E{ERAW};
              pg8::gemm_phase<EpiPlainBf16<D, 4>, pg8::StaticOrder>(lds, gm, S, E, nullptr); }
        }
        SEAM(13);
        if (IN(14)) { FRESH_WS(); for (int u = bid; u < 512; u += G) ret_kv_unit(Z, (float*)(ws + WS_W_GU), lds, u >> 7, (u >> 4) & 7, u & 15, tid); }
        SEAM(14);
        if (IN(15)) { FRESH_WS();
            const float* SKV = (const float*)(ws + WS_W_GU); bf16_t* SST = (bf16_t*)(ws + WS_W_DN);
            for (int i = bid * 512 + tid; i < 32 * 32768; i += G * 512) { const int bh = i >> 15, el = i & 32767; const float g256 = exp2f(ret_log2g(bh & 7) * 256.0f); float run = 0.f;
#pragma unroll 4
                for (int sc = 0; sc < 16; ++sc) { const size_t o = ((size_t)(bh * 16 + sc)) * 32768 + el; const float v = SKV[o]; SST[o] = (bf16_t)(cvt_pk_bf16(run, 0.f) & 0xffffu); run = run * g256 + v; } }
        }
        SEAM(15);
        if (IN(16)) { FRESH_WS();
            for (int u = bid; u < 512; u += G) ret_out_unit(Z, (const bf16_t*)(ws + WS_W_DN), args.in[I_GNG], (args.flags & 1) ? (bf16_t*)(ws + WS_W_GU) : Y, lds, u >> 7, (u >> 4) & 7, u & 15, tid, args.flags);
            __syncthreads();
        }
        SEAM(16);
        if (IN(17)) { FRESH_WS();
            __syncthreads();
            pg8::Gemm gm{Y, (const bf16_t*)(ws + WS_W_ODOUT), M, D, 2048}; pg8::StaticOrder S; S.init(M, D, G, bid); EpiResid<false> E{H_A, H_B};
            pg8::gemm_phase<EpiResid<false>, pg8::StaticOrder>(lds, gm, S, E, nullptr);
        }
        SEAM(17);
    if (IN(18 + 0)) { FRESH_WS();
        __syncthreads();
        convert_moe_layer(args.in[I_WGATE] + (size_t)NEXP * D * FF, args.in[I_WUP] + (size_t)NEXP * D * FF, args.in[I_WDOWN] + (size_t)NEXP * FF * D, W_GU, W_DN, scr, lane, gw, ngw);
        for (int vb = bid; vb < 256; vb += G)
            moe_route_block(H_B, args.in[I_FFNG] + 1 * D, RT + (size_t)1 * 36 * D, XN, (unsigned*)(ws + MS_RE), (f32x2*)(ws + MS_RW), (unsigned*)(ws + MS_CNT), lds, vb, tid);
    }
    SEAM(18 + 0);
    if (IN(18 + 1)) { FRESH_WS(); for (int vb = bid; vb < 256; vb += G) moe_scatter_block((const unsigned*)(ws + MS_RE), (const unsigned*)(ws + MS_CNT), XN, (bf16_t*)(ws + WS_XS), (unsigned*)(ws + MS_SLOT), (int*)(ws + MS_TILEE), lds, vb, tid); }
    SEAM(18 + 1);
    if (IN(18 + 2)) { FRESH_WS();
        __syncthreads();
        pg8::Gemm gm{(const bf16_t*)(ws + WS_XS), W_GU, MOE_ROWS, NEXP * 1024, D}; MoeOrder S; S.init((const int*)(ws + MS_TILEE), G, bid); EpiSwiglu E{Y};
        pg8::gemm_phase<EpiSwiglu, MoeOrder>(lds, gm, S, E, nullptr);
    }
    SEAM(18 + 2);
    if (IN(18 + 3)) { FRESH_WS();
        __syncthreads();
        pg8::Gemm gm{Y, W_DN, MOE_ROWS, NEXP * 1024, FF}; MoeOrder S; S.init((const int*)(ws + MS_TILEE), G, bid); EpiPlainBf16<D, 4> E{(bf16_t*)(ws + WS_YD)};
        pg8::gemm_phase<EpiPlainBf16<D, 4>, MoeOrder>(lds, gm, S, E, nullptr);
    }
    SEAM(18 + 3);
    if (IN(18 + 4)) { FRESH_WS(); for (int m = gw; m < M; m += 2 * ngw) moe_combine_tokens<2>(H_B, (const bf16_t*)(ws + WS_YD), (const unsigned*)(ws + MS_SLOT), (const f32x2*)(ws + MS_RW), H_A, ERAW, ERSTD, m, ngw, lane); }
    SEAM(18 + 4);
    if (IN(18 + 5)) { FRESH_WS();
        __syncthreads();
        pg8::Gemm gm{H_A, (const bf16_t*)(ws + WS_W_PLEGATE) + (size_t)1 * D * D, M, D, D}; pg8::StaticOrder S; S.init(M, D, G, bid); EpiPleGate<true> E{H_A, args.out, ERAW, ERSTD, args.in[I_PLEG] + 1 * D};
        pg8::gemm_phase<EpiPleGate<true>, pg8::StaticOrder>(lds, gm, S, E, nullptr);
    }
}

extern "C" void kernel_launch(void* const* d_in, const int* in_sizes, int n_in, void* d_out, int out_size, void* d_ws, size_t ws_size, hipStream_t stream) {
    static int grid = 0;
    if (grid == 0) {
        if (n_in != N_IN || out_size != M * D || ws_size < WS_END) { fprintf(stderr, "kernel_launch: unexpected problem (n_in %d, out %d, ws %zu)\n", n_in, out_size, ws_size); grid = -1; return; }
        int dev = 0, cus = 0, per_cu = 0;
        if (hipGetDevice(&dev) != hipSuccess || hipDeviceGetAttribute(&cus, hipDeviceAttributeMultiprocessorCount, dev) != hipSuccess) { grid = -1; return; }
        if (hipFuncSetAttribute((const void*)mk_fwd, hipFuncAttributeMaxDynamicSharedMemorySize, LDS_BYTES) != hipSuccess) { fprintf(stderr, "kernel_launch: hipFuncSetAttribute failed\n"); grid = -1; return; }
        if (hipOccupancyMaxActiveBlocksPerMultiprocessor(&per_cu, (const void*)mk_fwd, 512, LDS_BYTES) != hipSuccess || per_cu < 1) fprintf(stderr, "kernel_launch: occupancy query reports %d\n", per_cu);
        (void)hipGetLastError();
        grid = cus;
    }
    if (grid < 0) return;
    (void)hipMemsetAsync((char*)d_ws + WS_CTL, 0, CTL_ZERO_BYTES, stream);
    Args a{};
    for (int i = 0; i < N_IN; ++i) a.in[i] = (const float*)d_in[i];
    a.out = (float*)d_out; a.ws = (unsigned char*)d_ws;
#if MK_N_LAUNCHES == 1
    a.ph_lo = 0; a.ph_hi = N_PHASES;
    hipLaunchKernelGGL(mk_fwd, dim3(grid), dim3(512), LDS_BYTES, stream, a);
#else
    for (int p = 0; p < N_PHASES; ++p) { a.ph_lo = p; a.ph_hi = p + 1; a.flags = 0; hipLaunchKernelGGL(mk_fwd, dim3(grid), dim3(512), LDS_BYTES, stream, a);
#if defined(PROBE_PHASE)
#ifndef PROBE_FLAGS
#define PROBE_FLAGS 0
#endif
        if (p == PROBE_PHASE) { a.flags = 1 | PROBE_FLAGS; for (int r = 0; r < PROBE_REPS; ++r) hipLaunchKernelGGL(mk_fwd, dim3(grid), dim3(512), LDS_BYTES, stream, a); }
#endif
    }
#endif
}
```

```cpp
#include <hip/hip_runtime.h>
#include <cstdio>
#include <cstdint>

#define GAS __attribute__((address_space(1)))
#define LAS __attribute__((address_space(3)))
#ifndef MK_N_LAUNCHES
#define MK_N_LAUNCHES 1
#endif

constexpr int D = 1024, BATCH = 4, SEQ = 4096, M = BATCH * SEQ, PLE = 256;
constexpr int EV_IN = 3144, EV_INP = 3328;
constexpr int OD_IN = 6144;
constexpr int ZC_XA = 0, ZC_GA = 512, ZC_Q = 1024, ZC_K = 1536, ZC_V = 2048, ZC_IQ = 2560, ZC_IK = 3072, ZC_IW = 3136;
constexpr int NEXP = 32, FF = 512;
constexpr int MOE_ROWS = 40960, MOE_TILES = 160;
constexpr float RMS_EPS = 1e-6f, GN_EPS = 1e-5f;
constexpr float LOG2E = 1.4426950408889634f;

constexpr size_t MiB = 1u << 20;
constexpr size_t WS_CTL = 0, CTL_ZERO_BYTES = 1 * MiB;
constexpr size_t WS_RT = 1 * MiB;
constexpr size_t WS_WGT = 1 * MiB + 512 * 1024;
constexpr size_t WS_ROPE = 2 * MiB;
constexpr size_t WS_W_EVIN = 4 * MiB;
constexpr size_t WS_W_EVOUT = 11 * MiB;
constexpr size_t WS_W_ODIN = 13 * MiB;
constexpr size_t WS_W_ODOUT = 25 * MiB;
constexpr size_t WS_W_PLEUP = 29 * MiB;
constexpr size_t WS_W_PLEGATE = 30 * MiB;
constexpr size_t WS_W_GU = 34 * MiB;
constexpr size_t WS_W_DN = 98 * MiB;
constexpr size_t WS_XN = 130 * MiB;
constexpr size_t WS_PB = 162 * MiB;
constexpr size_t WS_ERAW = 178 * MiB;
constexpr size_t WS_MISC = 210 * MiB;
constexpr size_t WS_MASK = 214 * MiB;
constexpr size_t WS_Y = 222 * MiB;
constexpr size_t WS_Z = 286 * MiB;
constexpr size_t WS_XS = WS_Z, WS_YD = WS_Z + 80 * MiB;
constexpr size_t WS_HLOC = WS_Z + 104 * MiB, WS_PCUM = WS_HLOC + 32 * MiB;
constexpr size_t WS_HB = 446 * MiB;
constexpr size_t WS_HA = 478 * MiB;
constexpr size_t WS_END = 510 * MiB;
constexpr size_t MS_ESS = WS_MISC, MS_ERSTD = WS_MISC + 1 * MiB, MS_RE = MS_ERSTD + 65536, MS_RW = MS_RE + 65536, MS_SLOT = MS_RW + 131072, MS_CNT = MS_SLOT + 131072,
                 MS_TILEE = MS_CNT + 32768, MS_SUMA = MS_TILEE + 4096, MS_SUMH = MS_SUMA + 524288;
static_assert(MS_SUMH + 524288 <= WS_MASK, "misc map");
constexpr int CW_BAR = 4096;

constexpr int LDS_BYTES = 147456;
constexpr int LDS_MISC_OFF = 144 * 1024 - 256;

typedef unsigned short bf16_t;
typedef short bf16x8 __attribute__((ext_vector_type(8)));
typedef short s16x4 __attribute__((ext_vector_type(4)));
typedef float f32x4 __attribute__((ext_vector_type(4)));
typedef float f32x2 __attribute__((ext_vector_type(2)));
typedef unsigned u32x4 __attribute__((ext_vector_type(4)));
typedef unsigned u32x2 __attribute__((ext_vector_type(2)));
typedef LAS unsigned char* ldsp;
namespace pg8 {
#define PG8_LAS __attribute__((address_space(3)))
typedef unsigned short bf16_t;
typedef short bf16x8 __attribute__((ext_vector_type(8)));
typedef float f32x4 __attribute__((ext_vector_type(4)));
typedef unsigned u32x4 __attribute__((ext_vector_type(4)));
constexpr int BM = 256, BK = 64, HALF = 128, HTB = HALF * BK * 2  , STAGE_BYTES = 8 * HTB, NXCD = 8, WGM = 8;

__host__ __device__ __forceinline__ int lds_byte(int r, int c) { const int st = (r >> 4) * 2 + (c >> 5), rr = r & 15, cc = c & 31, ob = rr * 64 + cc * 2; return st * 1024 + (ob ^ (((ob >> 9) & 1) << 5)); }
__host__ __device__ __forceinline__ void stage_rc(int b, int& R, int& C) { const int st = b / 1024, sb = b % 1024, swz = sb ^ (((sb >> 9) & 1) << 5); R = (st >> 1) * 16 + swz / 64; C = (st & 1) * 32 + (swz % 64) / 2; }
__host__ __device__ __forceinline__ int perm32(int rho) { const int n = rho >> 4, i = rho & 15; return 8 * (i >> 2) + 4 * n + (i & 3); }

struct Unit { int pm, pn; };
struct Gemm { const bf16_t* A; const bf16_t* Bt; int M, N, K; };

struct StaticOrder {
    int nM, nN, nwg, G, c;
    __host__ __device__ void init(int M, int N, int G_, int c_) { nM = M / BM; nN = N / BM; nwg = nM * nN; G = G_; c = c_; }
    __host__ __device__ bool next(int i, Unit& u) const {
        const long L = (long)i * G + c; if (L >= nwg) return false;
        int wgid = (int)L; { const int q = nwg / NXCD, r = nwg % NXCD, xcd = wgid % NXCD, off = wgid / NXCD; wgid = (xcd < r ? xcd * (q + 1) : r * (q + 1) + (xcd - r) * q) + off; }
        const int nig = WGM * nN, gid = wgid / nig, fm = gid * WGM, gsz = (nM - fm) < WGM ? (nM - fm) : WGM;
        u.pm = fm + ((wgid % nig) % gsz); u.pn = (wgid % nig) / gsz; return true;
    }
    __device__ __forceinline__ void a_ready(const Unit&) const {}
    __device__ __forceinline__ void done(const Unit&) const {}
};
__device__ __forceinline__ unsigned cvt_pk_bf16(float lo, float hi) { unsigned r; asm volatile("v_cvt_pk_bf16_f32 %0, %1, %2" : "=v"(r) : "v"(lo), "v"(hi)); return r; }
template <class Epi, class Sched, bool STAMP = false>
__device__ __forceinline__ void gemm_phase(PG8_LAS unsigned char* lds, const Gemm g, const Sched& S, const Epi& E, unsigned long long* stamps) {
    const int tid = threadIdx.x, wid = __builtin_amdgcn_readfirstlane(tid >> 6), lane = tid & 63, wr = wid >> 2, wc = wid & 3, fr = lane & 15, fq = lane >> 4;
    const int K = g.K, nt = K / BK;
    int ts_lo = 0, ts_hi = 0, nts = 0; const unsigned long long rt_entry = STAMP ? (unsigned long long)wall_clock64() : 0ull;
#define PG8_STAMP() do { if (STAMP && wid == 0 && nts < 64) { const unsigned long long _c = (unsigned long long)clock64(); \
        ts_lo = (lane == nts) ? (int)(unsigned)_c : ts_lo; ts_hi = (lane == nts) ? (int)(unsigned)(_c >> 32) : ts_hi; ++nts; } } while (0)
    PG8_STAMP();
    unsigned voffA[2], voffB[2];
#pragma unroll
    for (int i = 0; i < 2; ++i) { int R, C; stage_rc(tid * 16 + i * 8192, R, C); const int Rb = Epi::PERM ? ((R & ~31) + perm32(R & 31)) : R;
        voffA[i] = (unsigned)(R * K + C) * 2u; voffB[i] = (unsigned)(Rb * K + C) * 2u; }
    const size_t kstep = (size_t)(BK * 2);
    const size_t hstep = (size_t)HALF * K * 2;
    const size_t tstep = 2 * hstep;
    const unsigned ldsw = (unsigned)wid * 1024u;
    const int aoff = lds_byte(wr * 64 + fr, fq * 8), boff = lds_byte(wc * 32 + fr, fq * 8);
#define PG8_SA(b, h) (((b) * 2 + (h)) * HTB)
#define PG8_SB(b, h) ((4 + (b) * 2 + (h)) * HTB)
#define PG8_STAGE(bufoff, gbase, voff) do { _Pragma("unroll") for (int _i = 0; _i < 2; ++_i) \
        __builtin_amdgcn_global_load_lds((const unsigned*)((const char*)(gbase) + (voff)[_i]), (PG8_LAS unsigned*)(lds + (bufoff) + ldsw + _i * 8192), 16, 0, 0); } while (0)
#define PG8_LDA(dst, b, h) do { _Pragma("unroll") for (int m = 0; m < 4; ++m) _Pragma("unroll") for (int k = 0; k < 2; ++k) dst[m][k] = *(const PG8_LAS bf16x8*)(lds + PG8_SA(b, h) + aoff + m * 2048 + k * 1024); } while (0)
#define PG8_LDB(dst, b, h) do { _Pragma("unroll") for (int n = 0; n < 2; ++n) _Pragma("unroll") for (int k = 0; k < 2; ++k) dst[n][k] = *(const PG8_LAS bf16x8*)(lds + PG8_SB(b, h) + boff + n * 2048 + k * 1024); } while (0)
#define PG8_MMA(ai, bj, At, Bt) do { __builtin_amdgcn_s_setprio(1); _Pragma("unroll") for (int m = 0; m < 4; ++m) _Pragma("unroll") for (int n = 0; n < 2; ++n) _Pragma("unroll") for (int k = 0; k < 2; ++k) \
        acc[ai][bj][m][n] = __builtin_amdgcn_mfma_f32_16x16x32_bf16(Bt[n][k], At[m][k], acc[ai][bj][m][n], 0, 0, 0); __builtin_amdgcn_s_setprio(0); } while (0)
#define PG8_WAIT_V(n) asm volatile("s_waitcnt vmcnt(" #n ")" ::: "memory")
#define PG8_WAIT_L(n) asm volatile("s_waitcnt lgkmcnt(" #n ")" ::: "memory")
#define PG8_BAR __builtin_amdgcn_s_barrier()
#define PG8_SCHED __builtin_amdgcn_sched_barrier(0)
    Unit cur, nxt; int ui = 0;
    if (!S.next(0, cur)) return;
    f32x4 acc[2][2][4][2];
#pragma unroll
    for (int a = 0; a < 2; ++a)
#pragma unroll
        for (int b = 0; b < 2; ++b)
#pragma unroll
            for (int m = 0; m < 4; ++m)
#pragma unroll
                for (int n = 0; n < 2; ++n) acc[a][b][m][n] = (f32x4){0.f, 0.f, 0.f, 0.f};
    bf16x8 At[4][2], B0[2][2], B1[2][2];
    const char* cA = (const char*)g.A + (size_t)cur.pm * tstep; const char* cB = (const char*)g.Bt + (size_t)cur.pn * tstep;
    S.a_ready(cur);
    PG8_STAGE(PG8_SB(0, 0), cB, voffB); PG8_STAGE(PG8_SA(0, 0), cA, voffA); PG8_STAGE(PG8_SB(0, 1), cB + hstep, voffB); PG8_STAGE(PG8_SA(0, 1), cA + hstep, voffA);
    if (wr == 1) PG8_BAR;
    PG8_WAIT_V(4); PG8_BAR;
    PG8_STAGE(PG8_SB(1, 0), cB + kstep, voffB); PG8_STAGE(PG8_SA(1, 0), cA + kstep, voffA); PG8_STAGE(PG8_SB(1, 1), cB + hstep + kstep, voffB);
    PG8_WAIT_V(6); PG8_BAR;
    PG8_STAMP();
    for (;;) {
        const bool has_next = S.next(ui + 1, nxt);
        const char* nA = has_next ? (const char*)g.A + (size_t)nxt.pm * tstep : cA; const char* nB = has_next ? (const char*)g.Bt + (size_t)nxt.pn * tstep : cB;
        for (int t = 0; t < nt; t += 2) {
            const bool last = (t == nt - 2);
            const char* a1 = cA + (size_t)(t + 1) * kstep;
            const char* a2 = last ? nA : cA + (size_t)(t + 2) * kstep; const char* b2 = last ? nB : cB + (size_t)(t + 2) * kstep;
            const char* a3 = a2 + kstep; const char* b3 = b2 + kstep;
            if (last && has_next) S.a_ready(nxt);
            PG8_LDB(B0, 0, 0); PG8_SCHED; PG8_LDA(At, 0, 0); PG8_STAGE(PG8_SA(1, 1), a1 + hstep, voffA);
            PG8_WAIT_L(8); PG8_BAR; PG8_WAIT_L(0); PG8_MMA(0, 0, At, B0); PG8_BAR; PG8_SCHED;
            PG8_LDB(B1, 0, 1); PG8_STAGE(PG8_SB(0, 0), b2, voffB);
            PG8_BAR; PG8_WAIT_L(0); PG8_MMA(0, 1, At, B1); PG8_BAR;
            PG8_LDA(At, 0, 1); PG8_STAGE(PG8_SA(0, 0), a2, voffA);
            PG8_BAR; PG8_WAIT_L(0); PG8_MMA(1, 0, At, B0); PG8_BAR; PG8_SCHED;
            PG8_STAGE(PG8_SB(0, 1), b2 + hstep, voffB);
            PG8_WAIT_V(6); PG8_BAR; PG8_MMA(1, 1, At, B1); PG8_BAR;
            PG8_LDB(B0, 1, 0); PG8_SCHED; PG8_LDA(At, 1, 0); PG8_STAGE(PG8_SA(0, 1), a2 + hstep, voffA);
            PG8_WAIT_L(8); PG8_BAR; PG8_WAIT_L(0); PG8_MMA(0, 0, At, B0); PG8_BAR; PG8_SCHED;
            PG8_LDB(B1, 1, 1); PG8_STAGE(PG8_SB(1, 0), b3, voffB);
            PG8_BAR; PG8_WAIT_L(0); PG8_MMA(0, 1, At, B1); PG8_BAR;
            PG8_LDA(At, 1, 1); PG8_STAGE(PG8_SA(1, 0), a3, voffA);
            PG8_BAR; PG8_WAIT_L(0); PG8_MMA(1, 0, At, B0); PG8_BAR; PG8_SCHED;
            PG8_STAGE(PG8_SB(1, 1), b3 + hstep, voffB);
            PG8_WAIT_V(6); PG8_BAR; PG8_MMA(1, 1, At, B1); PG8_BAR;
        }
        PG8_STAMP();
        if constexpr (!Epi::AFTER_DRAIN) { E(acc, cur, wr, wc, fr, fq); S.done(cur); }
        PG8_STAMP();
        if (!has_next) break;
#pragma unroll
        for (int a = 0; a < 2; ++a)
#pragma unroll
            for (int b = 0; b < 2; ++b)
#pragma unroll
                for (int m = 0; m < 4; ++m)
#pragma unroll
                    for (int n = 0; n < 2; ++n) acc[a][b][m][n] = (f32x4){0.f, 0.f, 0.f, 0.f};
        cur = nxt; cA = nA; cB = nB; ++ui;
    }
    PG8_WAIT_V(0);
    if (wr == 0) PG8_BAR;
    PG8_BAR;
    if constexpr (Epi::AFTER_DRAIN) { E.fused(acc, cur, wr, wc, fr, fq, lds, wid, lane); S.done(cur); }
    PG8_STAMP();
    if (STAMP && wid == 0) { stamps[lane] = lane < nts ? (((unsigned long long)(unsigned)ts_hi << 32) | (unsigned)ts_lo) : 0ull;
        if (lane == 62) stamps[62] = rt_entry; if (lane == 63) stamps[63] = (unsigned long long)wall_clock64(); }
#undef PG8_STAMP
#undef PG8_SA
#undef PG8_SB
#undef PG8_STAGE
#undef PG8_LDA
#undef PG8_LDB
#undef PG8_MMA
#undef PG8_WAIT_V
#undef PG8_WAIT_L
#undef PG8_BAR
#undef PG8_SCHED
}
}
#define XB_TMO      128
#define XB_XCNT(j)  (256  + 64 * (j))
#define XB_XSUB(j)  (1280 + 64 * (j))
#define XB_XGEN(j)  (2304 + 64 * (j))
#define XB_TOP      3328
#define XB_TOPGEN   3392
#define XCD_BAR_WORDS 3456
#define XB_SPIN_CAP (1u << 18)
__device__ __forceinline__ unsigned xb_ld(unsigned* p)              { return __hip_atomic_load(p, __ATOMIC_RELAXED, __HIP_MEMORY_SCOPE_AGENT); }
__device__ __forceinline__ unsigned xb_add(unsigned* p, unsigned v) { return __hip_atomic_fetch_add(p, v, __ATOMIC_RELAXED, __HIP_MEMORY_SCOPE_AGENT); }
__device__ __forceinline__ unsigned xb_xcc_id() { return (unsigned)__builtin_amdgcn_s_getreg((3 << 11) | 20) & 0xFu; }
#define XB_SPIN(cond, bar) do { unsigned _sp = 0; while (cond) { __builtin_amdgcn_s_sleep(1); \
    if ((++_sp & 255u) == 0u) { if (xb_ld(&(bar)[XB_TMO])) break; if (_sp > XB_SPIN_CAP) { atomicAdd(&(bar)[XB_TMO], 1u); break; } } } } while (0)

struct XcdBarrier {
    unsigned* bar; unsigned x;
    volatile LAS unsigned* st;
};

__device__ __forceinline__ XcdBarrier xcd_barrier_post(unsigned* bar, volatile LAS unsigned* st) {
    XcdBarrier b; b.bar = bar; b.x = xb_xcc_id(); b.st = st;
    if (threadIdx.x == 0) (void)xb_add(&bar[XB_XCNT(b.x)], 1u);
    return b;
}
__device__ __forceinline__ void xcd_barrier_complete(unsigned* bar, unsigned x, unsigned& nloc, unsigned& nx) {
    const unsigned G = gridDim.x * gridDim.y * gridDim.z;
    unsigned sum, cnt, mine, sp = 0u;
    for (;;) {
        sum = 0u; cnt = 0u; mine = 0u;
#pragma unroll
        for (unsigned j = 0; j < 16; ++j) { const unsigned c = xb_ld(&bar[XB_XCNT(j)]); sum += c; cnt += (c > 0u) ? 1u : 0u; mine = (j == x) ? c : mine; }
        if (sum == G) break;
        __builtin_amdgcn_s_sleep(1);
        if ((++sp & 255u) == 0u) { if (xb_ld(&bar[XB_TMO])) break; if (sp > XB_SPIN_CAP) { atomicAdd(&bar[XB_TMO], 1u); break; } }
    }
    nloc = mine > 0u ? mine : 1u; nx = cnt > 0u ? cnt : 1u;
}

__device__ __forceinline__ void xcd_barrier(const XcdBarrier& b) {
    asm volatile("s_waitcnt vmcnt(0)" ::: "memory");
    __syncthreads();
    if (threadIdx.x == 0) {
        unsigned* bar = b.bar;
        __builtin_amdgcn_s_waitcnt(0);
        unsigned nloc = b.st[0], nx = b.st[1];
        if (nloc == 0u) { xcd_barrier_complete(bar, b.x, nloc, nx); b.st[0] = nloc; b.st[1] = nx; }
        const unsigned old = xb_add(&bar[XB_XSUB(b.x)], 1u);
        const unsigned gen = old / nloc;
        if (old + 1u == (gen + 1u) * nloc) {
            __builtin_amdgcn_fence(__ATOMIC_RELEASE, "agent");
            asm volatile("s_waitcnt vmcnt(0)" ::: "memory");
            const unsigned og = xb_add(&bar[XB_TOP], 1u);
            const unsigned tg = og / nx;
            if (og + 1u == (tg + 1u) * nx) xb_add(&bar[XB_TOPGEN], 1u);
            else XB_SPIN(xb_ld(&bar[XB_TOPGEN]) == tg, bar);
            __builtin_amdgcn_fence(__ATOMIC_ACQUIRE, "agent");
            xb_add(&bar[XB_XGEN(b.x)], 1u);
            asm volatile("s_waitcnt vmcnt(0)" ::: "memory");
        } else {
            XB_SPIN(xb_ld(&bar[XB_XGEN(b.x)]) == gen, bar);
            __builtin_amdgcn_fence(__ATOMIC_ACQUIRE, "agent");
            asm volatile("s_waitcnt vmcnt(0)" ::: "memory");
        }
    }
    __syncthreads();
}
typedef short v4i16_t __attribute__((ext_vector_type(4)));
__device__ __forceinline__ unsigned cvt_pk_bf16(float lo, float hi) { return pg8::cvt_pk_bf16(lo, hi); }
__device__ __forceinline__ float bf_lo(unsigned u) { return __uint_as_float(u << 16); }
__device__ __forceinline__ float bf_hi(unsigned u) { return __uint_as_float(u & 0xffff0000u); }
__device__ __forceinline__ float bf2f(bf16_t b) { return __uint_as_float(((unsigned)b) << 16); }
__device__ __forceinline__ float wave_sum(float v) {
#pragma unroll
    for (int o = 1; o < 64; o <<= 1) v += __shfl_xor(v, o);
    return v;
}
__device__ __forceinline__ float sigmoidf_(float x) { return __builtin_amdgcn_rcpf(1.0f + __expf(-x)); }
__device__ __forceinline__ float siluf_(float x) { return x * __builtin_amdgcn_rcpf(1.0f + __expf(-x)); }
__device__ __forceinline__ float gelu_tanh_(float x) { const float y = 0.7978845608028654f * (x + 0.044715f * x * x * x); const float t = 1.0f - 2.0f * __builtin_amdgcn_rcpf(1.0f + __expf(2.0f * y)); return 0.5f * x * (1.0f + t); }
__device__ __forceinline__ s16x4 vtr(const LAS bf16_t* p) { return __builtin_bit_cast(s16x4, __builtin_amdgcn_ds_read_tr16_b64_v4i16((LAS v4i16_t*)p)); }
__device__ __forceinline__ bf16x8 frag_tr(const LAS bf16_t* tile, int pitch, int k0, int n0, int lane) {
    const int i16 = lane & 15, g = lane >> 4;
    const LAS bf16_t* a = tile + (k0 + 4 * g + (i16 >> 2)) * pitch + n0 + 4 * (i16 & 3);
    const s16x4 lo = vtr(a), hi = vtr(a + 16 * pitch);
    bf16x8 r; r[0] = lo[0]; r[1] = lo[1]; r[2] = lo[2]; r[3] = lo[3]; r[4] = hi[0]; r[5] = hi[1]; r[6] = hi[2]; r[7] = hi[3]; return r;
}
__device__ __forceinline__ bf16x8 pack_frag(const f32x4 a, const f32x4 b) {
    u32x4 w; w.x = cvt_pk_bf16(a[0], a[1]); w.y = cvt_pk_bf16(a[2], a[3]); w.z = cvt_pk_bf16(b[0], b[1]); w.w = cvt_pk_bf16(b[2], b[3]);
    return __builtin_bit_cast(bf16x8, w);
}
#define MFMA16(a, b, c) __builtin_amdgcn_mfma_f32_16x16x32_bf16((a), (b), (c), 0, 0, 0)
#define LDS_BARRIER() do { asm volatile("s_waitcnt lgkmcnt(0)" ::: "memory"); __builtin_amdgcn_s_barrier(); asm volatile("" ::: "memory"); } while (0)

typedef const f32x4 (&AccRef)[2][2][4][2];
#define EPI_ROWS() _Pragma("unroll") for (int ai = 0; ai < 2; ++ai) _Pragma("unroll") for (int m = 0; m < 4; ++m)
#define EPI_BJ() _Pragma("unroll") for (int bj = 0; bj < 2; ++bj)

template <int LDC, int NTN> struct EpiPlainBf16 {
    static constexpr bool PERM = true, AFTER_DRAIN = false; static constexpr int ldc = LDC, ntn = NTN;
    bf16_t* O;
    __device__ __forceinline__ void operator()(AccRef acc, const pg8::Unit& u, int wr, int wc, int fr_, int fq_) const {
        int fr = fr_, fq = fq_; asm volatile("" : "+v"(fr), "+v"(fq));
        const int row0 = u.pm * 256 + wr * 64 + fr, col0 = (u.pn % ntn) * 256 + wc * 32 + 8 * fq;
        EPI_ROWS() { bf16_t* rowp = O + (size_t)(row0 + ai * 128 + m * 16) * ldc + col0;
            EPI_BJ() { const f32x4 v0 = acc[ai][bj][m][0], v1 = acc[ai][bj][m][1];
                u32x4 w; w.x = cvt_pk_bf16(v0[0], v0[1]); w.y = cvt_pk_bf16(v0[2], v0[3]); w.z = cvt_pk_bf16(v1[0], v1[1]); w.w = cvt_pk_bf16(v1[2], v1[3]);
                *(u32x4*)(rowp + bj * 128) = w; } }
    }
};
struct EpiPleUp {
    static constexpr bool PERM = true, AFTER_DRAIN = false;
    bf16_t* O; float* ess;
    __device__ __forceinline__ void operator()(AccRef acc, const pg8::Unit& u, int wr, int wc, int fr_, int fq_) const {
        int fr = fr_, fq = fq_; asm volatile("" : "+v"(fr), "+v"(fq));
        const int row0 = u.pm * 256 + wr * 64 + fr, col0 = u.pn * 256 + wc * 32 + 8 * fq;
        EPI_ROWS() { const int row = row0 + ai * 128 + m * 16; bf16_t* rowp = O + (size_t)row * D + col0; float s = 0.f;
            EPI_BJ() { const f32x4 v0 = acc[ai][bj][m][0], v1 = acc[ai][bj][m][1];
                s += (v0[0] * v0[0] + v0[1] * v0[1]) + (v0[2] * v0[2] + v0[3] * v0[3]) + (v1[0] * v1[0] + v1[1] * v1[1]) + (v1[2] * v1[2] + v1[3] * v1[3]);
                u32x4 w; w.x = cvt_pk_bf16(v0[0], v0[1]); w.y = cvt_pk_bf16(v0[2], v0[3]); w.z = cvt_pk_bf16(v1[0], v1[1]); w.w = cvt_pk_bf16(v1[2], v1[3]);
                *(u32x4*)(rowp + bj * 128) = w; }
            s += __shfl_xor(s, 16); s += __shfl_xor(s, 32);
            if (fq == 0) ess[(size_t)row * 16 + u.pn * 4 + wc] = s;
            asm volatile("" ::: "memory"); }
    }
};
template <bool BASE_F32> struct EpiResid {
    static constexpr bool PERM = true, AFTER_DRAIN = false;
    const void* base; bf16_t* out;
    __device__ __forceinline__ void operator()(AccRef acc, const pg8::Unit& u, int wr, int wc, int fr_, int fq_) const {
        int fr = fr_, fq = fq_; asm volatile("" : "+v"(fr), "+v"(fq));
        const int row0 = u.pm * 256 + wr * 64 + fr, col0 = u.pn * 256 + wc * 32 + 8 * fq;
        EPI_ROWS() { const size_t ro = (size_t)(row0 + ai * 128 + m * 16) * D + col0;
            EPI_BJ() { const size_t o = ro + bj * 128; f32x4 b0, b1;
                if (BASE_F32) { b0 = *(const f32x4*)((const float*)base + o); b1 = *(const f32x4*)((const float*)base + o + 4); }
                else { const u32x4 hb = *(const u32x4*)((const bf16_t*)base + o); b0 = (f32x4){bf_lo(hb.x), bf_hi(hb.x), bf_lo(hb.y), bf_hi(hb.y)}; b1 = (f32x4){bf_lo(hb.z), bf_hi(hb.z), bf_lo(hb.w), bf_hi(hb.w)}; }
                const f32x4 v0 = b0 + acc[ai][bj][m][0], v1 = b1 + acc[ai][bj][m][1];
                u32x4 w; w.x = cvt_pk_bf16(v0[0], v0[1]); w.y = cvt_pk_bf16(v0[2], v0[3]); w.z = cvt_pk_bf16(v1[0], v1[1]); w.w = cvt_pk_bf16(v1[2], v1[3]);
                *(u32x4*)(out + o) = w; } }
    }
};
struct EpiSwiglu {
    static constexpr bool PERM = true, AFTER_DRAIN = false;
    bf16_t* H;
    __device__ __forceinline__ void operator()(AccRef acc, const pg8::Unit& u, int wr, int wc, int fr_, int fq_) const {
        int fr = fr_, fq = fq_; asm volatile("" : "+v"(fr), "+v"(fq));
        const int row0 = u.pm * 256 + wr * 64 + fr, ct = u.pn & 3;
        EPI_ROWS() { bf16_t* rowp = H + (size_t)(row0 + ai * 128 + m * 16) * FF;
            EPI_BJ() { const f32x4 g = acc[ai][bj][m][0], up = acc[ai][bj][m][1]; const int ff = 128 * ct + 64 * bj + 16 * wc + 4 * fq;
                u32x2 w; w.x = cvt_pk_bf16(siluf_(g[0]) * up[0], siluf_(g[1]) * up[1]); w.y = cvt_pk_bf16(siluf_(g[2]) * up[2], siluf_(g[3]) * up[3]);
                *(u32x2*)(rowp + ff) = w; } }
    }
};
template <bool FINAL> struct EpiPleGate {
    static constexpr bool PERM = true, AFTER_DRAIN = false;
    const bf16_t* hin; void* hout; const bf16_t* eraw; const float* erstd; const float* gple;
    __device__ __forceinline__ void operator()(AccRef acc, const pg8::Unit& u, int wr, int wc, int fr_, int fq_) const {
        int fr = fr_, fq = fq_; asm volatile("" : "+v"(fr), "+v"(fq));
        const int row0 = u.pm * 256 + wr * 64 + fr, col0 = u.pn * 256 + wc * 32 + 8 * fq;
        EPI_ROWS() { const int row = row0 + ai * 128 + m * 16; const float rs = erstd[row]; const size_t ro = (size_t)row * D + col0;
            EPI_BJ() { const size_t o = ro + bj * 128; const int c = col0 + bj * 128;
                const u32x4 hb = *(const u32x4*)(hin + o), ew = *(const u32x4*)(eraw + o); const f32x4 g0 = *(const f32x4*)(gple + c), g1 = *(const f32x4*)(gple + c + 4);
                const f32x4 a0 = acc[ai][bj][m][0], a1 = acc[ai][bj][m][1];
                f32x4 r0, r1;
                r0[0] = bf_lo(hb.x) + bf_lo(ew.x) * rs * g0[0] * sigmoidf_(a0[0]); r0[1] = bf_hi(hb.x) + bf_hi(ew.x) * rs * g0[1] * sigmoidf_(a0[1]);
                r0[2] = bf_lo(hb.y) + bf_lo(ew.y) * rs * g0[2] * sigmoidf_(a0[2]); r0[3] = bf_hi(hb.y) + bf_hi(ew.y) * rs * g0[3] * sigmoidf_(a0[3]);
                r1[0] = bf_lo(hb.z) + bf_lo(ew.z) * rs * g1[0] * sigmoidf_(a1[0]); r1[1] = bf_hi(hb.z) + bf_hi(ew.z) * rs * g1[1] * sigmoidf_(a1[1]);
                r1[2] = bf_lo(hb.w) + bf_lo(ew.w) * rs * g1[2] * sigmoidf_(a1[2]); r1[3] = bf_hi(hb.w) + bf_hi(ew.w) * rs * g1[3] * sigmoidf_(a1[3]);
                if (FINAL) { *(f32x4*)((float*)hout + o) = r0; *(f32x4*)((float*)hout + o + 4) = r1; }
                else { u32x4 w; w.x = cvt_pk_bf16(r0[0], r0[1]); w.y = cvt_pk_bf16(r0[2], r0[3]); w.z = cvt_pk_bf16(r1[0], r1[1]); w.w = cvt_pk_bf16(r1[2], r1[3]); *(u32x4*)((bf16_t*)hout + o) = w; } }
            asm volatile("" ::: "memory"); }
    }
};
struct EpiRet {
    static constexpr bool PERM = true, AFTER_DRAIN = false;
    bf16_t* Z; const float* rope;
    __device__ __forceinline__ void operator()(AccRef acc, const pg8::Unit& u, int wr, int wc, int fr_, int fq_) const {
        int fr = fr_, fq = fq_; asm volatile("" : "+v"(fr), "+v"(fq));
        const int row0 = u.pm * 256 + wr * 64 + fr;
        const bool rot = u.pn < 8;
        const float sc = (rot && u.pn >= 4) ? 0.08838834764831845f : 1.0f;
        const int i0 = 4 * (4 * wc + fq);
        const int ca = rot ? (2 * u.pn) * 128 + i0 : u.pn * 256 + wc * 32 + 8 * fq, dcb = rot ? 64 : 4;
        EPI_ROWS() { const int row = row0 + ai * 128 + m * 16; const int pos = row & (SEQ - 1);
            f32x4 cs = (f32x4){1.f, 1.f, 1.f, 1.f}, sn = (f32x4){0.f, 0.f, 0.f, 0.f};
            if (rot) { cs = *(const f32x4*)(rope + (size_t)pos * 64 + i0); sn = *(const f32x4*)(rope + (size_t)SEQ * 64 + (size_t)pos * 64 + i0); }
            bf16_t* rowp = Z + (size_t)row * OD_IN + ca;
            EPI_BJ() { const f32x4 x1 = acc[ai][bj][m][0], x2 = acc[ai][bj][m][1];
                u32x2 a, b;
                a.x = cvt_pk_bf16((x1[0] * cs[0] - x2[0] * sn[0]) * sc, (x1[1] * cs[1] - x2[1] * sn[1]) * sc); a.y = cvt_pk_bf16((x1[2] * cs[2] - x2[2] * sn[2]) * sc, (x1[3] * cs[3] - x2[3] * sn[3]) * sc);
                b.x = cvt_pk_bf16((x2[0] * cs[0] + x1[0] * sn[0]) * sc, (x2[1] * cs[1] + x1[1] * sn[1]) * sc); b.y = cvt_pk_bf16((x2[2] * cs[2] + x1[2] * sn[2]) * sc, (x2[3] * cs[3] + x1[3] * sn[3]) * sc);
                if (rot) { *(u32x2*)(rowp + bj * 128) = a; *(u32x2*)(rowp + bj * 128 + 64) = b; }
                else { u32x4 w4; w4.x = a.x; w4.y = a.y; w4.z = b.x; w4.w = b.y; *(u32x4*)(rowp + bj * 128) = w4; } }
            asm volatile("" ::: "memory"); }
    }
};
struct MoeOrder {
    const int* tile_e; int ntiles, G, c;
    __device__ __forceinline__ void init(const int* te, int G_, int c_) { tile_e = te; ntiles = te[MOE_TILES]; G = G_; c = c_; }
    __device__ __forceinline__ bool next(int i, pg8::Unit& u) const {
        const int nwg = ntiles * 4; int L = i * G + c; if (L >= nwg) return false;
        { const int q = nwg / 8, r = nwg % 8, xcd = L % 8, off = L / 8; L = (xcd < r ? xcd * (q + 1) : r * (q + 1) + (xcd - r) * q) + off; }
        const int rt = L >> 2; u.pm = rt; u.pn = tile_e[rt] * 4 + (L & 3); return true;
    }
    __device__ __forceinline__ void a_ready(const pg8::Unit&) const {}
    __device__ __forceinline__ void done(const pg8::Unit&) const {}
};
template <int MODE>
__device__ __forceinline__ void tr_load(const float* W, const float* W2, int Nsrc, int r0, int k0, int lane, f32x4 (&v)[16]) {
    const int kr = lane >> 4, c4 = lane & 15, r = r0 + 4 * c4;
    const float* src = W; int col = r; bool ok = true;
    if (MODE == 0) { ok = r < Nsrc; }
    if (MODE == 1) { if (r < 2048) { const int hh = r >> 7, w = r & 127, w8 = w >> 3, rr = w & 7; col = hh * 128 + ((rr < 4) ? 4 * w8 : 64 + 4 * w8); } }
    if (MODE == 2) { const int w8 = r >> 3; src = ((r >> 2) & 1) ? W2 : W; col = 4 * w8; }
    const char* p = (const char*)(src + (size_t)(k0 + kr) * Nsrc + col); const size_t stride = (size_t)Nsrc * 16;
#pragma unroll
    for (int i = 0; i < 16; ++i) { v[i] = (f32x4){0.f, 0.f, 0.f, 0.f}; if (ok) v[i] = __builtin_nontemporal_load((const f32x4*)p); p += stride; asm volatile("" : "+v"(p)); }
}
__device__ __forceinline__ void tr_store(bf16_t* WT, int K, int r0, int k0, LAS float* scr, int lane, const f32x4 (&v)[16]) {
    const int kr = lane >> 4, c4 = lane & 15;
#pragma unroll
    for (int i = 0; i < 16; ++i) { LAS float* d = scr + (kr + 4 * i) * 65 + 4 * c4; d[0] = v[i][0]; d[1] = v[i][1]; d[2] = v[i][2]; d[3] = v[i][3]; }
    asm volatile("s_waitcnt lgkmcnt(0)" ::: "memory");
    const int c = lane & 7;
#pragma unroll
    for (int j = 0; j < 8; ++j) { const int n = (lane >> 3) + 8 * j; const LAS float* s = scr + (8 * c) * 65 + n;
        u32x4 o; o.x = cvt_pk_bf16(s[0 * 65], s[1 * 65]); o.y = cvt_pk_bf16(s[2 * 65], s[3 * 65]); o.z = cvt_pk_bf16(s[4 * 65], s[5 * 65]); o.w = cvt_pk_bf16(s[6 * 65], s[7 * 65]);
        *(u32x4*)(WT + (size_t)(r0 + n) * K + k0 + 8 * c) = o; }
    asm volatile("s_waitcnt lgkmcnt(0)" ::: "memory");
}
template <int MODE>
__device__ __forceinline__ void tr_matrix(const float* W, const float* W2, int K, int Nsrc, bf16_t* WT, int rows, LAS float* scr, int lane, int gw, int ngw) {
    const int nkb = K / 64, nitems = (rows / 64) * nkb;
    f32x4 va[16], vb[16];
    int it = gw;
    if (it < nitems) tr_load<MODE>(W, W2, Nsrc, (it / nkb) * 64, (it % nkb) * 64, lane, va);
    while (it < nitems) {
        const int n1 = it + ngw;
        if (n1 < nitems) tr_load<MODE>(W, W2, Nsrc, (n1 / nkb) * 64, (n1 % nkb) * 64, lane, vb);
        tr_store(WT, K, (it / nkb) * 64, (it % nkb) * 64, scr, lane, va);
        if (n1 >= nitems) break;
        const int n2 = n1 + ngw;
        if (n2 < nitems) tr_load<MODE>(W, W2, Nsrc, (n2 / nkb) * 64, (n2 % nkb) * 64, lane, va);
        tr_store(WT, K, (n1 / nkb) * 64, (n1 % nkb) * 64, scr, lane, vb);
        it = n2;
    }
}
__device__ __forceinline__ void moe_item_load(const float* wg, const float* wu, const float* wd, int it, int lane, f32x4 (&v)[16]) {
    const int n_gu = NEXP * 256;
    if (it < n_gu) { const int e = it >> 8, r = it & 255, rb = r >> 4, kb = r & 15; tr_load<2>(wg + (size_t)e * D * FF, wu + (size_t)e * D * FF, FF, rb * 64, kb * 64, lane, v); }
    else { const int q = it - n_gu, e = q >> 7, r = q & 127, rb = r >> 3, kb = r & 7; tr_load<0>(wd + (size_t)e * FF * D, nullptr, D, rb * 64, kb * 64, lane, v); }
}
__device__ __forceinline__ void moe_item_store(bf16_t* GU, bf16_t* DN, int it, LAS float* scr, int lane, const f32x4 (&v)[16]) {
    const int n_gu = NEXP * 256;
    if (it < n_gu) { const int e = it >> 8, r = it & 255, rb = r >> 4, kb = r & 15; tr_store(GU + (size_t)e * 1024 * D, D, rb * 64, kb * 64, scr, lane, v); }
    else { const int q = it - n_gu, e = q >> 7, r = q & 127, rb = r >> 3, kb = r & 7; tr_store(DN + (size_t)e * 1024 * FF, FF, rb * 64, kb * 64, scr, lane, v); }
}
__device__ __forceinline__ void convert_moe_layer(const float* wg, const float* wu, const float* wd, bf16_t* GU, bf16_t* DN, LAS float* scr, int lane, int gw, int ngw) {
    const int nitems = NEXP * 256 + NEXP * 128;
    f32x4 va[16], vb[16];
    int it = gw;
    if (it < nitems) moe_item_load(wg, wu, wd, it, lane, va);
    while (it < nitems) {
        const int n1 = it + ngw;
        if (n1 < nitems) moe_item_load(wg, wu, wd, n1, lane, vb);
        moe_item_store(GU, DN, it, scr, lane, va);
        if (n1 >= nitems) break;
        const int n2 = n1 + ngw;
        if (n2 < nitems) moe_item_load(wg, wu, wd, n2, lane, va);
        moe_item_store(GU, DN, n1, scr, lane, vb);
        it = n2;
    }
}
template <int NR, bool IN_F32>
__device__ __forceinline__ void rms_rows_to_bf16(const void* xbase, const float* gain, bf16_t* obase, int m, int step, int lane) {
    f32x4 v[NR][4];
#pragma unroll
    for (int r = 0; r < NR; ++r) { const int row = (m + r * step < M) ? m + r * step : m;
        if (IN_F32) { const f32x4* xr = (const f32x4*)((const float*)xbase + (size_t)row * D) + lane;
#pragma unroll
            for (int j = 0; j < 4; ++j) v[r][j] = xr[64 * j]; }
        else { const u32x2* xr = (const u32x2*)((const bf16_t*)xbase + (size_t)row * D) + lane;
#pragma unroll
            for (int j = 0; j < 4; ++j) { const u32x2 q = xr[64 * j]; v[r][j] = (f32x4){bf_lo(q.x), bf_hi(q.x), bf_lo(q.y), bf_hi(q.y)}; } } }
    f32x4 g[4];
#pragma unroll
    for (int j = 0; j < 4; ++j) g[j] = *((const f32x4*)gain + lane + 64 * j);
#pragma unroll
    for (int r = 0; r < NR; ++r) { float s = 0.f;
#pragma unroll
        for (int j = 0; j < 4; ++j) s += (v[r][j][0] * v[r][j][0] + v[r][j][1] * v[r][j][1]) + (v[r][j][2] * v[r][j][2] + v[r][j][3] * v[r][j][3]);
        const float rstd = 1.0f / sqrtf(wave_sum(s) * (1.0f / D) + RMS_EPS);
        u32x2* o8 = (u32x2*)(obase + (size_t)(m + r * step) * D) + lane;
        if (m + r * step < M)
#pragma unroll
        for (int j = 0; j < 4; ++j) { u32x2 w; w.x = cvt_pk_bf16(v[r][j][0] * rstd * g[j][0], v[r][j][1] * rstd * g[j][1]); w.y = cvt_pk_bf16(v[r][j][2] * rstd * g[j][2], v[r][j][3] * rstd * g[j][3]); o8[64 * j] = w; } }
}
__device__ __forceinline__ void lru_local_unit(const bf16_t* Z0, const float* conv_w, const float* conv_b, const bf16_t* wgt, const float* ba, const float* bx, const float* lam,
                                               float* HLOC, float* PCUM, float* SUMA, float* SUMH, ldsp lds, int b, int c, int tid) {
    const int ch = tid, lane = tid & 63, blk = __builtin_amdgcn_readfirstlane(tid >> 6), i16 = lane & 15, g = lane >> 4;
    LAS bf16_t* Xc = (LAS bf16_t*)(lds + blk * 17408); LAS float* GB = (LAS float*)(lds + blk * 17408 + 9216);
    const float w0 = conv_w[ch], w1 = conv_w[512 + ch], w2 = conv_w[1024 + ch], w3 = conv_w[1536 + ch], cb = conv_b[ch];
    const float bav = ba[ch], bxv = bx[ch];
    const float l = lam[ch]; const float z = __expf(-l);
    const float sp = (z < 0.02f) ? z * (1.0f - z * (0.5f - z * (0.33333334f - 0.25f * z))) : __logf(1.0f + z);
    const float c8 = -8.0f * sp;
    const size_t tok0 = (size_t)b * SEQ + (size_t)c * 64;
    float xm3 = 0.f, xm2 = 0.f, xm1 = 0.f;
    if (c > 0) { xm3 = bf2f(Z0[(tok0 - 3) * EV_INP + ZC_XA + ch]); xm2 = bf2f(Z0[(tok0 - 2) * EV_INP + ZC_XA + ch]); xm1 = bf2f(Z0[(tok0 - 1) * EV_INP + ZC_XA + ch]); }
    bf16x8 bfa[2][4], bfx[2][4];
#pragma unroll
    for (int ks = 0; ks < 2; ++ks)
#pragma unroll
        for (int nt = 0; nt < 4; ++nt) { const bf16_t* pa = wgt + ((size_t)blk * 64 + 16 * nt + i16) * 64 + 32 * ks + 8 * g;
            bfa[ks][nt] = *(const bf16x8*)pa; bfx[ks][nt] = *(const bf16x8*)(pa + 8 * 4096); }
    float xc[64];
#pragma unroll
    for (int t = 0; t < 64; ++t) { const float xt = bf2f(Z0[(tok0 + t) * EV_INP + ZC_XA + ch]);
        xc[t] = w0 * xm3 + w1 * xm2 + w2 * xm1 + w3 * xt + cb; xm3 = xm2; xm2 = xm1; xm1 = xt;
        Xc[t * 72 + lane] = (bf16_t)(cvt_pk_bf16(xc[t], 0.f) & 0xffffu); }
    asm volatile("s_waitcnt lgkmcnt(0)" ::: "memory");
    float h = 0.f, P = 1.f;
#pragma unroll
    for (int mt = 0; mt < 4; ++mt) {
        const bf16x8 a0 = *(const LAS bf16x8*)(Xc + (16 * mt + i16) * 72 + 8 * g), a1 = *(const LAS bf16x8*)(Xc + (16 * mt + i16) * 72 + 32 + 8 * g);
#pragma unroll
        for (int nt = 0; nt < 4; ++nt) { f32x4 ca = (f32x4){0.f, 0.f, 0.f, 0.f}, cx = (f32x4){0.f, 0.f, 0.f, 0.f};
            ca = MFMA16(a0, bfa[0][nt], ca); ca = MFMA16(a1, bfa[1][nt], ca); cx = MFMA16(a0, bfx[0][nt], cx); cx = MFMA16(a1, bfx[1][nt], cx);
#pragma unroll
            for (int i = 0; i < 4; ++i) { GB[(4 * g + i) * 128 + 16 * nt + i16] = ca[i]; GB[(4 * g + i) * 128 + 64 + 16 * nt + i16] = cx[i]; } }
        asm volatile("s_waitcnt lgkmcnt(0)" ::: "memory");
#pragma unroll
        for (int t = 0; t < 16; ++t) {
            const float r = sigmoidf_(GB[t * 128 + lane] + bav), gi = sigmoidf_(GB[t * 128 + 64 + lane] + bxv);
            const float log_a = c8 * r; const float a = __expf(log_a);
            const float om = 1.0f - a * a;
            const float u = __builtin_amdgcn_sqrtf(fmaxf(om, 0.f)) * (gi * xc[16 * mt + t]);
            h = a * h + u; P *= a;
            const size_t o = (tok0 + 16 * mt + t) * 512 + ch;
            ((unsigned*)HLOC)[o] = cvt_pk_bf16(h, P);
        }
        asm volatile("" ::: "memory");
    }
    SUMA[((size_t)b * 64 + c) * 512 + ch] = P; SUMH[((size_t)b * 64 + c) * 512 + ch] = h;
}
__device__ __forceinline__ void lru_fix_unit(const bf16_t* Z0, const float* HLOC, const float* PCUM, const float* SUMA, const float* SUMH, bf16_t* Y0, int b, int c, int tid) {
    const int ch = tid; float hin = 0.f;
    for (int c0 = 0; c0 < c; c0 += 16) {
        float av[16], hv[16];
#pragma unroll
        for (int j = 0; j < 16; ++j) { const int cc = (c0 + j < c) ? c0 + j : c - 1; const size_t o = ((size_t)b * 64 + cc) * 512 + ch; av[j] = SUMA[o]; hv[j] = SUMH[o]; }
#pragma unroll
        for (int j = 0; j < 16; ++j) if (c0 + j < c) hin = av[j] * hin + hv[j];
    }
    const size_t tok0 = (size_t)b * SEQ + (size_t)c * 64;
#pragma unroll 1
    for (int t0 = 0; t0 < 64; t0 += 16) {
        float hl[16], pc[16], gav[16];
#pragma unroll
        for (int j = 0; j < 16; ++j) { const size_t tok = tok0 + t0 + j; const unsigned hp = ((const unsigned*)HLOC)[tok * 512 + ch]; hl[j] = bf_lo(hp); pc[j] = bf_hi(hp); gav[j] = bf2f(Z0[tok * EV_INP + ZC_GA + ch]); }
#pragma unroll
        for (int j = 0; j < 16; ++j) { const size_t tok = tok0 + t0 + j; Y0[tok * D + ch] = (bf16_t)(cvt_pk_bf16((hl[j] + pc[j] * hin) * gelu_tanh_(gav[j]), 0.f) & 0xffffu); }
    }
}
template <int NT>
__device__ __forceinline__ void dsa_prep_tokens(bf16_t* Z0, const float* qg, const float* kg, int m, int step, int lane) {
    const int d0 = (lane & 7) * 8;
    if (m + (NT - 1) * step >= M) return;
    u32x4 w[NT][2];
#pragma unroll
    for (int t = 0; t < NT; ++t)
#pragma unroll
        for (int which = 0; which < 2; ++which) w[t][which] = *(const u32x4*)(Z0 + (size_t)(m + t * step) * EV_INP + (which ? ZC_K : ZC_Q) + lane * 8);
#pragma unroll
    for (int t = 0; t < NT; ++t)
#pragma unroll
        for (int which = 0; which < 2; ++which) {
            bf16_t* p = Z0 + (size_t)(m + t * step) * EV_INP + (which ? ZC_K : ZC_Q) + lane * 8; const float* g = (which ? kg : qg) + d0;
            const u32x4 ww = w[t][which]; float v[8] = {bf_lo(ww.x), bf_hi(ww.x), bf_lo(ww.y), bf_hi(ww.y), bf_lo(ww.z), bf_hi(ww.z), bf_lo(ww.w), bf_hi(ww.w)};
            float s = 0.f;
#pragma unroll
            for (int i = 0; i < 8; ++i) s += v[i] * v[i];
            s += __shfl_xor(s, 1); s += __shfl_xor(s, 2); s += __shfl_xor(s, 4);
            const float rstd = 1.0f / sqrtf(s * (1.0f / 64.0f) + RMS_EPS);
            u32x4 o; o.x = cvt_pk_bf16(v[0] * rstd * g[0], v[1] * rstd * g[1]); o.y = cvt_pk_bf16(v[2] * rstd * g[2], v[3] * rstd * g[3]);
            o.z = cvt_pk_bf16(v[4] * rstd * g[4], v[5] * rstd * g[5]); o.w = cvt_pk_bf16(v[6] * rstd * g[6], v[7] * rstd * g[7]);
            *(u32x4*)p = o;
        }
}
__device__ __forceinline__ unsigned f2key(float f) { const unsigned u = __float_as_uint(f); return (u & 0x80000000u) ? ~u : (u | 0x80000000u); }
__device__ __forceinline__ float relu_i(float x) { const int i = __builtin_bit_cast(int, x); return __builtin_bit_cast(float, i > 0 ? i : 0); }
template <int WPL  >
__device__ __forceinline__ void radix_scan_row(LAS unsigned* hrow, LAS unsigned* pref, LAS unsigned* kneed, LAS unsigned* eqcnt, int row, int lane, int bits) {
    unsigned s = 0;
#pragma unroll
    for (int q = 0; q < WPL / 4; ++q) { const u32x4 c4 = *(const LAS u32x4*)(hrow + lane * WPL + 4 * q);
        s += (c4.x & 0xffffu) + (c4.x >> 16) + (c4.y & 0xffffu) + (c4.y >> 16) + (c4.z & 0xffffu) + (c4.z >> 16) + (c4.w & 0xffffu) + (c4.w >> 16); }
    unsigned v = s;
#pragma unroll
    for (int off = 1; off < 64; off <<= 1) { const unsigned t2 = __shfl_down(v, off); if (lane + off < 64) v += t2; }
    const unsigned ex = v - s;
    const unsigned kn = kneed[row];
    if (ex < kn && kn <= ex + s) {
        unsigned cum = ex; int bin = -1; unsigned cb = 0, ab = 0;
        for (int wi = WPL - 1; wi >= 0 && bin < 0; --wi) { const unsigned cw = hrow[lane * WPL + wi]; const unsigned chi = cw >> 16, clo = cw & 0xffffu;
            if (kn <= cum + chi) { bin = 2 * (lane * WPL + wi) + 1; cb = chi; ab = cum; }
            else { cum += chi; if (kn <= cum + clo) { bin = 2 * (lane * WPL + wi); cb = clo; ab = cum; } else cum += clo; } }
        pref[row] = (pref[row] << bits) | (unsigned)bin; kneed[row] = kn - ab; eqcnt[row] = cb;
    }
}
#define HADD(hp, d) __hip_atomic_fetch_add((hp) + ((d) >> 1), ((d) & 1u) ? 0x10000u : 1u, __ATOMIC_RELAXED, __HIP_MEMORY_SCOPE_WORKGROUP)
template <int HALF>
__device__ __forceinline__ void dsa_select_round(unsigned* MASK, ldsp lds, const u32x2 (&ky)[32], size_t tok0, int nt, int tid, int dbg) {
    const int lane = tid & 63, w = __builtin_amdgcn_readfirstlane(tid >> 6), g = lane >> 4;
    LAS unsigned* H0 = (LAS unsigned*)lds; LAS unsigned* H1 = (LAS unsigned*)(lds + 65536); LAS unsigned short* MB = (LAS unsigned short*)(lds + 81920); LAS unsigned* GE = (LAS unsigned*)(lds + 86016);
    LAS unsigned* pref = (LAS unsigned*)(lds + 98304); LAS unsigned* kneed = pref + 8; LAS unsigned* eqcnt = pref + 16; LAS unsigned* lcount = pref + 24; LAS unsigned* flg = pref + 32;
    const int ntw = (nt - w + 7) >> 3;
    if (tid < 8) { pref[tid] = 0u; kneed[tid] = 256u; eqcnt[tid] = 0u; lcount[tid] = 0u; }
    if (tid < 2) flg[tid] = 0u;
    { const u32x4 z4 = (u32x4){0u, 0u, 0u, 0u}; for (int i = tid; i < 256; i += 512) *(LAS u32x4*)((LAS unsigned*)MB + 4 * i) = z4;
      if (nt > 16) for (int i = tid; i < 4096; i += 512) *(LAS u32x4*)(H0 + 4 * i) = z4; }
    __syncthreads();
    if (nt > 16 && !(dbg & 2)) {
        { LAS unsigned* h0 = H0 + (2 * g) * 2048; LAS unsigned* h1 = H0 + (2 * g + 1) * 2048;
          if (!(dbg & 16))
#pragma unroll
          for (int tt = 0; tt < 32; ++tt) if (tt < ntw) { const unsigned da = ky[tt].x >> 20, db = ky[tt].y >> 20; HADD(h0, da); HADD(h1, db); } }
        __syncthreads();
        radix_scan_row<32>(H0 + w * 2048, pref, kneed, eqcnt, w, lane, 12);
        if (eqcnt[w] > 2048u && lane == 0) flg[0] = 1u;
        __syncthreads();
        if (flg[0] == 0u) {
            { const unsigned pf0 = pref[2 * g], pf1 = pref[2 * g + 1];
              if (!(dbg & 32))
#pragma unroll
              for (int tt = 0; tt < 32; ++tt) if (tt < ntw) { const unsigned ka = ky[tt].x, kb = ky[tt].y;
                  if ((ka >> 20) == pf0) { const unsigned p = __hip_atomic_fetch_add(lcount + 2 * g, 1u, __ATOMIC_RELAXED, __HIP_MEMORY_SCOPE_WORKGROUP); H0[(2 * g) * 2048 + p] = ka; }
                  if ((kb >> 20) == pf1) { const unsigned p = __hip_atomic_fetch_add(lcount + 2 * g + 1, 1u, __ATOMIC_RELAXED, __HIP_MEMORY_SCOPE_WORKGROUP); H0[(2 * g + 1) * 2048 + p] = kb; } } }
            __syncthreads();
            { const int n = (int)lcount[w]; LAS unsigned* hr = H1 + w * 512; const LAS unsigned* lst = H0 + w * 2048;
#pragma unroll 1
              for (int pass = ((dbg & 64) ? 3 : 1); pass < 3; ++pass) { const int shift = pass == 1 ? 10 : 0;
                  *(LAS u32x4*)(hr + 8 * lane) = (u32x4){0u, 0u, 0u, 0u}; *(LAS u32x4*)(hr + 8 * lane + 4) = (u32x4){0u, 0u, 0u, 0u};
                  const unsigned pw = pref[w];
                  asm volatile("" ::: "memory");
                  for (int i = lane; i < n; i += 64) { const unsigned key = lst[i]; const unsigned d = (key >> shift) & 1023u; if (pass == 1 || (key >> 10) == pw) HADD(hr, d); }
                  asm volatile("s_waitcnt lgkmcnt(0)" ::: "memory");
                  radix_scan_row<8>(hr, pref, kneed, eqcnt, w, lane, 10);
                  asm volatile("s_waitcnt lgkmcnt(0)" ::: "memory"); } }
        } else {
#pragma unroll 1
            for (int pass = 1; pass < 3; ++pass) { const int shift = pass == 1 ? 10 : 0;
                for (int i = tid; i < 1024; i += 512) *(LAS u32x4*)(H1 + 4 * i) = (u32x4){0u, 0u, 0u, 0u};
                __syncthreads();
                const unsigned pf0 = pref[2 * g], pf1 = pref[2 * g + 1];
#pragma unroll
                for (int tt = 0; tt < 32; ++tt) if (tt < ntw) { const unsigned ka = ky[tt].x, kb = ky[tt].y;
                    if ((ka >> (shift + 10)) == pf0) { const unsigned d = (ka >> shift) & 1023u; HADD(H1 + (2 * g) * 512, d); }
                    if ((kb >> (shift + 10)) == pf1) { const unsigned d = (kb >> shift) & 1023u; HADD(H1 + (2 * g + 1) * 512, d); } }
                __syncthreads();
                radix_scan_row<8>(H1 + w * 512, pref, kneed, eqcnt, w, lane, 10);
                __syncthreads(); }
        }
        __syncthreads();
        if (tid < 8 && kneed[tid] < eqcnt[tid]) flg[1] = 1u;
    }
    __syncthreads();
    {
        const unsigned T0 = pref[2 * g], T1 = pref[2 * g + 1];
        if (dbg & 8) { } else if (flg[1] == 0u) {
#pragma unroll
            for (int tt = 0; tt < 32; ++tt) if (tt < ntw) { const int t = w + 8 * tt;
                const unsigned long long b0 = __ballot(ky[tt].x >= T0), b1 = __ballot(ky[tt].y >= T1);
                if (lane == 0) { *(LAS unsigned long long*)(MB + (t * 2 + 0) * 4) = b0; *(LAS unsigned long long*)(MB + (t * 2 + 1) * 4) = b1; } }
            __syncthreads();
        } else {
            for (int i = tid; i < 2048; i += 512) GE[i] = 0u;
            __syncthreads();
#pragma unroll
            for (int tt = 0; tt < 32; ++tt) if (tt < ntw) { const int t = w + 8 * tt;
                const unsigned long long gt0 = __ballot(ky[tt].x > T0), eq0 = __ballot(ky[tt].x == T0), gt1 = __ballot(ky[tt].y > T1), eq1 = __ballot(ky[tt].y == T1);
                if (lane < 4) { GE[(2 * lane) * 256 + t] = (unsigned)((gt0 >> (16 * lane)) & 0xffffull) | ((unsigned)((eq0 >> (16 * lane)) & 0xffffull) << 16);
                                GE[(2 * lane + 1) * 256 + t] = (unsigned)((gt1 >> (16 * lane)) & 0xffffull) | ((unsigned)((eq1 >> (16 * lane)) & 0xffffull) << 16); } }
            __syncthreads();
            if (tid < 8) { const int q = tid; unsigned rem = kneed[q];
                for (int t = 0; t < nt; ++t) { unsigned x = GE[q * 256 + t]; unsigned e = x >> 16; const unsigned pc = __popc(e);
                    if (pc <= rem) rem -= pc;
                    else { unsigned keep = 0; while (rem) { const unsigned low = e & (0u - e); keep |= low; e ^= low; --rem; } x = (x & 0xffffu) | (keep << 16); GE[q * 256 + t] = x; } } }
            __syncthreads();
            for (int i = tid; i < 2048; i += 512) { const int r8 = i >> 8, t = i & 255; const unsigned x = GE[i]; MB[(t * 2 + (r8 & 1)) * 4 + (r8 >> 1)] = (unsigned short)((x | (x >> 16)) & 0xffffu); }
            __syncthreads();
        }
    }
    for (int i = tid; i < 1024; i += 512) { const int r8 = i >> 7, t2 = i & 127, gg = r8 >> 1, j = r8 & 1; const int q = 4 * gg + 2 * HALF + j;
        const unsigned m0 = MB[((2 * t2) * 2 + j) * 4 + gg], m1 = MB[((2 * t2 + 1) * 2 + j) * 4 + gg];
        MASK[(tok0 + q) * 128 + t2] = m0 | (m1 << 16); }
    __syncthreads();
}
__device__ __forceinline__ void dsa_select_unit(const bf16_t* Z0, unsigned* MASK, unsigned char* PARK, ldsp lds, int b, int qt, int tid, int dbg) {
    const int lane = tid & 63, w = __builtin_amdgcn_readfirstlane(tid >> 6), i16 = lane & 15, g = lane >> 4;
    const int c = qt >> 2, nt = 4 * (c + 1);
    const size_t tok0 = (size_t)b * SEQ + (size_t)qt * 16;
    bf16x8 qf[8][2];
#pragma unroll
    for (int h = 0; h < 8; ++h)
#pragma unroll
        for (int ks = 0; ks < 2; ++ks) qf[h][ks] = *(const bf16x8*)(Z0 + (tok0 + i16) * EV_INP + ZC_IQ + h * 64 + 32 * ks + 8 * g);
    const unsigned loff = (unsigned)(i16 * EV_INP + ZC_IK + 8 * g) * 2u;
    const bf16_t* kbase = Z0 + ((size_t)b * SEQ + (size_t)w * 16) * EV_INP;
    float wq[4][8];
#pragma unroll
    for (int r = 0; r < 4; ++r) { const u32x4 w4 = *(const u32x4*)(Z0 + (tok0 + 4 * g + r) * EV_INP + ZC_IW); const float k0 = 0.04419417382415922f;
        wq[r][0] = bf_lo(w4.x) * k0; wq[r][1] = bf_hi(w4.x) * k0; wq[r][2] = bf_lo(w4.y) * k0; wq[r][3] = bf_hi(w4.y) * k0; wq[r][4] = bf_lo(w4.z) * k0; wq[r][5] = bf_hi(w4.z) * k0; wq[r][6] = bf_lo(w4.w) * k0; wq[r][7] = bf_hi(w4.w) * k0; }
    u32x2 ky[32];
    const int ntw = (nt - w + 7) >> 3;
    LAS unsigned char* ring = lds + w * 16384; const unsigned ring_rd = (unsigned)(size_t)(ring + lane * 16);
    unsigned char* parkb = PARK + (size_t)blockIdx.x * 131072; const unsigned parko = (unsigned)tid * 8u;
#pragma unroll
    for (int h = 0; h < 8; ++h) asm volatile("" :: "v"(qf[h][0]), "v"(qf[h][1]), "v"(wq[0][h]), "v"(wq[1][h]), "v"(wq[2][h]), "v"(wq[3][h]));
    asm volatile("s_waitcnt vmcnt(0)" ::: "memory");
#define IK_ISSUE(tt_) do { const int tc_ = ((tt_) < ntw) ? (tt_) : (ntw - 1); unsigned long long kb64_ = (unsigned long long)kbase; asm volatile("" : "+s"(kb64_)); \
        const char* gp_ = (const char*)(kb64_ + (unsigned long long)tc_ * (128ull * EV_INP * 2ull)); unsigned lo2_ = loff; asm volatile("" : "+v"(lo2_)); \
        __builtin_amdgcn_global_load_lds((const unsigned*)(gp_ + lo2_), (LAS unsigned*)(ring + (2 * ((tt_) & 7)) * 1024), 16, 0, 0); \
        __builtin_amdgcn_global_load_lds((const unsigned*)(gp_ + lo2_ + 64), (LAS unsigned*)(ring + (2 * ((tt_) & 7) + 1) * 1024), 16, 0, 0); } while (0)
    if (ntw > 0 && !(dbg & 4)) {
#pragma unroll
        for (int tt = 0; tt < 8; ++tt) IK_ISSUE(tt);
    }
#pragma unroll
    for (int tt = 0; tt < 32; ++tt) {
        ky[tt] = (u32x2){0u, 0u};
        if (tt < ntw && !(dbg & 4)) {
            asm volatile("s_waitcnt vmcnt(%0)" :: "i"(tt < 8 ? 14 + tt : 22) : "memory");
            bf16x8 k0f, k1f;
            asm volatile("ds_read_b128 %0, %2 offset:%3\n\tds_read_b128 %1, %2 offset:%4\n\ts_waitcnt lgkmcnt(0)" : "=&v"(k0f), "=&v"(k1f) : "v"(ring_rd), "i"((2 * (tt & 7)) * 1024), "i"((2 * (tt & 7) + 1) * 1024) : "memory");
            IK_ISSUE(tt + 8);
            f32x4 acc[8];
#pragma unroll
            for (int h = 0; h < 8; ++h) acc[h] = MFMA16(qf[h][0], k0f, ((f32x4){0.f, 0.f, 0.f, 0.f}));
#pragma unroll
            for (int h = 0; h < 8; ++h) acc[h] = MFMA16(qf[h][1], k1f, acc[h]);
            float s0 = 0.f, s1 = 0.f, s2 = 0.f, s3 = 0.f;
#pragma unroll
            for (int h = 0; h < 8; ++h) { s0 += relu_i(acc[h][0]) * wq[0][h]; s1 += relu_i(acc[h][1]) * wq[1][h]; s2 += relu_i(acc[h][2]) * wq[2][h]; s3 += relu_i(acc[h][3]) * wq[3][h]; }
            ky[tt] = (u32x2){f2key(s0), f2key(s1)};
            { const u32x2 pk = (u32x2){f2key(s2), f2key(s3)}; unsigned long long pb_ = (unsigned long long)parkb; asm volatile("" : "+s"(pb_)); pb_ += (unsigned long long)tt * 4096ull;
              asm volatile("global_store_dwordx2 %0, %1, %2" :: "v"(parko), "v"(pk), "s"(pb_) : "memory"); }
        }
    }
#undef IK_ISSUE
    asm volatile("s_waitcnt vmcnt(0)" ::: "memory");
    __syncthreads();
    dsa_select_round<0>(MASK, lds, ky, tok0, nt, tid, dbg);
#pragma unroll
    for (int tt = 0; tt < 32; ++tt) if (tt < ntw) { unsigned long long pb_ = (unsigned long long)parkb; asm volatile("" : "+s"(pb_)); ky[tt] = *(const u32x2*)((const unsigned char*)(pb_ + (unsigned long long)tt * 4096ull) + parko); }
    dsa_select_round<1>(MASK, lds, ky, tok0, nt, tid, dbg);
}
__device__ __forceinline__ int t5_bucket(int rel) {
    const int n = rel < 0 ? -rel : rel; const int ret = rel > 0 ? 16 : 0;
    int v;
    if (n < 8) v = n; else { const int val = n < 12 ? 0 : n < 16 ? 1 : n < 23 ? 2 : n < 32 ? 3 : n < 46 ? 4 : n < 64 ? 5 : n < 91 ? 6 : 7; v = 8 + val; if (v > 15) v = 15; }
    return ret + v;
}
__device__ __forceinline__ void dsa_attn_unit(const bf16_t* Z0, const unsigned* MASK, const float* rel_bias, bf16_t* Y0, ldsp lds, int b, int h, int qt, int tid) {
    const int lane = tid & 63, w = __builtin_amdgcn_readfirstlane(tid >> 6), i16 = lane & 15, g = lane >> 4;
    LAS float* lut = (LAS float*)(lds + 73728);
    __syncthreads();
    if (tid < 192) lut[tid] = rel_bias[t5_bucket(tid - 128) * 8 + h] * LOG2E;
    int qpos[2]; size_t tokq[2]; bf16x8 qf[2][2]; const unsigned long long* mrow[2];
    const float scale = 0.125f * LOG2E;
#pragma unroll
    for (int nt = 0; nt < 2; ++nt) { qpos[nt] = qt * 256 + w * 32 + nt * 16 + i16; tokq[nt] = (size_t)b * SEQ + qpos[nt]; mrow[nt] = (const unsigned long long*)(MASK + tokq[nt] * 128);
#pragma unroll
        for (int ks = 0; ks < 2; ++ks) { const u32x4 q4 = *(const u32x4*)(Z0 + tokq[nt] * EV_INP + ZC_Q + h * 64 + 32 * ks + 8 * g);
            u32x4 r; r.x = cvt_pk_bf16(bf_lo(q4.x) * scale, bf_hi(q4.x) * scale); r.y = cvt_pk_bf16(bf_lo(q4.y) * scale, bf_hi(q4.y) * scale); r.z = cvt_pk_bf16(bf_lo(q4.z) * scale, bf_hi(q4.z) * scale); r.w = cvt_pk_bf16(bf_lo(q4.w) * scale, bf_hi(q4.w) * scale);
            qf[nt][ks] = __builtin_bit_cast(bf16x8, r); } }
    const int nkb = 2 * qt + 2;
    float mrun[2] = {-1e30f, -1e30f}, lsum[2] = {0.f, 0.f}; f32x4 o[2][4];
#pragma unroll
    for (int nt = 0; nt < 2; ++nt)
#pragma unroll
        for (int dt = 0; dt < 4; ++dt) o[nt][dt] = (f32x4){0.f, 0.f, 0.f, 0.f};
    const int srow = tid >> 3, sch = tid & 7;
    const bf16_t* sbase = Z0 + ((size_t)b * SEQ + srow) * EV_INP + h * 64 + sch * 8;
    const int soff = srow * 72 + sch * 8;
    u32x4 kreg[2], vreg[2];
#define ATT_LOAD(kb_) do { const bf16_t* src_ = sbase + (size_t)(kb_) * 128 * EV_INP; kreg[0] = *(const u32x4*)(src_ + ZC_K); vreg[0] = *(const u32x4*)(src_ + ZC_V); \
        kreg[1] = *(const u32x4*)(src_ + (size_t)64 * EV_INP + ZC_K); vreg[1] = *(const u32x4*)(src_ + (size_t)64 * EV_INP + ZC_V); } while (0)
#define ATT_STORE(buf_) do { LAS bf16_t* Kn_ = (LAS bf16_t*)(lds + (buf_) * 36864); LAS bf16_t* Vn_ = (LAS bf16_t*)(lds + (buf_) * 36864 + 18432); \
        *(LAS u32x4*)(Kn_ + soff) = kreg[0]; *(LAS u32x4*)(Kn_ + 64 * 72 + soff) = kreg[1]; *(LAS u32x4*)(Vn_ + soff) = vreg[0]; *(LAS u32x4*)(Vn_ + 64 * 72 + soff) = vreg[1]; } while (0)
    ATT_LOAD(0); ATT_STORE(0); ATT_LOAD(1);
    unsigned long long mcur[2][2] = {{mrow[0][0], mrow[0][1]}, {mrow[1][0], mrow[1][1]}}, mnx[2][2] = {{mrow[0][2], mrow[0][3]}, {mrow[1][2], mrow[1][3]}};
    __syncthreads();
    for (int kb = 0; kb < nkb; ++kb) {
#pragma unroll
        for (int sb = 0; sb < 2; ++sb) {
            const LAS bf16_t* Ks = (const LAS bf16_t*)(lds + (kb & 1) * 36864) + sb * 64 * 72; const LAS bf16_t* Vs = (const LAS bf16_t*)(lds + (kb & 1) * 36864 + 18432) + sb * 64 * 72;
            const int key0 = kb * 128 + sb * 64;
            const bool far = (key0 + 63 + 128 <= qt * 256);
            const float bfar = lut[0];
            f32x4 s[2][4];
#pragma unroll
            for (int nt = 0; nt < 2; ++nt) { const unsigned mlo = (unsigned)mcur[nt][sb] >> (4 * g), mhi = (unsigned)(mcur[nt][sb] >> 32) >> (4 * g);
#pragma unroll
                for (int kt = 0; kt < 4; ++kt)
#pragma unroll
                    for (int i = 0; i < 4; ++i) { float bias = bfar;
                        if (!far) { int idx = key0 + kt * 16 + 4 * g + i - qpos[nt]; idx = idx < -128 ? -128 : idx; bias = lut[idx + 128]; }
                        const int mbit = __builtin_amdgcn_sbfe((int)((kt & 2) ? mhi : mlo), 16 * (kt & 1) + i, 1);
                        s[nt][kt][i] = __uint_as_float((__float_as_uint(bias) & (unsigned)mbit) | (0xff800000u & ~(unsigned)mbit)); } }
#pragma unroll
            for (int kt = 0; kt < 4; ++kt) { const bf16x8 a0 = *(const LAS bf16x8*)(Ks + (kt * 16 + i16) * 72 + 8 * g), a1 = *(const LAS bf16x8*)(Ks + (kt * 16 + i16) * 72 + 32 + 8 * g);
#pragma unroll
                for (int nt = 0; nt < 2; ++nt) { s[nt][kt] = MFMA16(a0, qf[nt][0], s[nt][kt]); s[nt][kt] = MFMA16(a1, qf[nt][1], s[nt][kt]); } }
            bf16x8 pb[2][2];
#pragma unroll
            for (int nt = 0; nt < 2; ++nt) {
                float mx = fmaxf(fmaxf(s[nt][0][0], s[nt][0][1]), fmaxf(s[nt][0][2], s[nt][0][3]));
#pragma unroll
                for (int kt = 1; kt < 4; ++kt) mx = fmaxf(fmaxf(mx, s[nt][kt][0]), fmaxf(fmaxf(s[nt][kt][1], s[nt][kt][2]), s[nt][kt][3]));
                mx = fmaxf(mx, __shfl_xor(mx, 16)); mx = fmaxf(mx, __shfl_xor(mx, 32));
                const float mnew = fmaxf(mrun[nt], mx); const float alpha = __builtin_amdgcn_exp2f(mrun[nt] - mnew); mrun[nt] = mnew;
                float ps = 0.f;
#pragma unroll
                for (int kt = 0; kt < 4; ++kt)
#pragma unroll
                    for (int i = 0; i < 4; ++i) { const float p = __builtin_amdgcn_exp2f(s[nt][kt][i] - mnew); s[nt][kt][i] = p; ps += p; }
                lsum[nt] = lsum[nt] * alpha + ps;
#pragma unroll
                for (int dt = 0; dt < 4; ++dt) o[nt][dt] = o[nt][dt] * alpha;
                pb[nt][0] = pack_frag(s[nt][0], s[nt][1]); pb[nt][1] = pack_frag(s[nt][2], s[nt][3]); }
#pragma unroll
            for (int dt = 0; dt < 4; ++dt)
#pragma unroll
                for (int kk = 0; kk < 2; ++kk) { const bf16x8 vf = frag_tr(Vs, 72, 32 * kk, 16 * dt, lane);
#pragma unroll
                    for (int nt = 0; nt < 2; ++nt) o[nt][dt] = MFMA16(vf, pb[nt][kk], o[nt][dt]); }
        }
        if (kb + 1 < nkb) { ATT_STORE((kb + 1) & 1); mcur[0][0] = mnx[0][0]; mcur[0][1] = mnx[0][1]; mcur[1][0] = mnx[1][0]; mcur[1][1] = mnx[1][1]; }
        if (kb + 2 < nkb) { ATT_LOAD(kb + 2); mnx[0][0] = mrow[0][2 * kb + 4]; mnx[0][1] = mrow[0][2 * kb + 5]; mnx[1][0] = mrow[1][2 * kb + 4]; mnx[1][1] = mrow[1][2 * kb + 5]; }
        __syncthreads();
    }
#undef ATT_LOAD
#undef ATT_STORE
#pragma unroll
    for (int nt = 0; nt < 2; ++nt) { float ls = lsum[nt]; ls += __shfl_xor(ls, 16); ls += __shfl_xor(ls, 32); const float inv = 1.0f / ls;
#pragma unroll
        for (int dt = 0; dt < 4; ++dt) { u32x2 wv; wv.x = cvt_pk_bf16(o[nt][dt][0] * inv, o[nt][dt][1] * inv); wv.y = cvt_pk_bf16(o[nt][dt][2] * inv, o[nt][dt][3] * inv);
            *(u32x2*)(Y0 + tokq[nt] * D + 512 + h * 64 + 16 * dt + 4 * g) = wv; } }
}
__device__ __forceinline__ void moe_route_block(const bf16_t* hbuf, const float* gain, const float* RT  , bf16_t* XN, unsigned* RE, f32x2* RW, unsigned* CNT, ldsp lds, int vb, int tid) {
    const int lane = tid & 63, w = __builtin_amdgcn_readfirstlane(tid >> 6), i16 = lane & 15, g = lane >> 4;
    LAS float* Yc = (LAS float*)lds; LAS float* Wc = (LAS float*)(lds + 33792); LAS float* PART = (LAS float*)(lds + 59136); LAS float* LG = (LAS float*)(lds + 71424); LAS unsigned* lcnt = (LAS unsigned*)(lds + 83712);
    __syncthreads();
    if (tid < 32) lcnt[tid] = 0u;
    for (int i = tid; i < 12 * 132; i += 512) Wc[36 * 132 + i] = 0.f;
    f32x4 y[8][4];
    { f32x4 gv[4];
#pragma unroll
      for (int j = 0; j < 4; ++j) gv[j] = *((const f32x4*)gain + lane + 64 * j);
#pragma unroll
      for (int t = 0; t < 8; ++t) { const size_t tok = (size_t)vb * 64 + w * 8 + t; const u32x2* xr = (const u32x2*)(hbuf + tok * D) + lane; float s = 0.f;
#pragma unroll
          for (int j = 0; j < 4; ++j) { const u32x2 q = xr[64 * j]; y[t][j] = (f32x4){bf_lo(q.x), bf_hi(q.x), bf_lo(q.y), bf_hi(q.y)}; s += (y[t][j][0] * y[t][j][0] + y[t][j][1] * y[t][j][1]) + (y[t][j][2] * y[t][j][2] + y[t][j][3] * y[t][j][3]); }
          const float rstd = 1.0f / sqrtf(wave_sum(s) * (1.0f / D) + RMS_EPS);
          u32x2* o8 = (u32x2*)(XN + tok * D) + lane;
#pragma unroll
          for (int j = 0; j < 4; ++j) { y[t][j] = y[t][j] * rstd * gv[j]; u32x2 wv; wv.x = cvt_pk_bf16(y[t][j][0], y[t][j][1]); wv.y = cvt_pk_bf16(y[t][j][2], y[t][j][3]); o8[64 * j] = wv; } } }
    f32x4 acc[3];
#pragma unroll
    for (int nt = 0; nt < 3; ++nt) acc[nt] = (f32x4){0.f, 0.f, 0.f, 0.f};
    const int tt4 = w & 3, kh = w >> 2;
    f32x4 wr[3];
#define RT_LOAD(c_) do { _Pragma("unroll") for (int q = 0; q < 3; ++q) { const int idx = tid + 512 * q; if (idx < 36 * 32) wr[q] = *(const f32x4*)(RT + (size_t)(idx >> 5) * D + 128 * (c_) + 4 * (idx & 31)); } } while (0)
    RT_LOAD(0);
#pragma unroll
    for (int c = 0; c < 8; ++c) {
        __syncthreads();
        if ((lane >> 5) == (c & 1)) {
#pragma unroll
            for (int t = 0; t < 8; ++t) *(LAS f32x4*)(Yc + (8 * w + t) * 132 + 4 * (lane & 31)) = y[t][c >> 1]; }
#pragma unroll
        for (int q = 0; q < 3; ++q) { const int idx = tid + 512 * q; if (idx < 36 * 32) *(LAS f32x4*)(Wc + (idx >> 5) * 132 + 4 * (idx & 31)) = wr[q]; }
        LDS_BARRIER();
        if (c + 1 < 8) RT_LOAD(c + 1);
#pragma unroll
        for (int S = 0; S < 4; ++S) { const int k0 = 64 * kh + 16 * S + 4 * g;
            const f32x4 a = *(const LAS f32x4*)(Yc + (16 * tt4 + i16) * 132 + k0);
#pragma unroll
            for (int nt = 0; nt < 3; ++nt) { const f32x4 bq = *(const LAS f32x4*)(Wc + (16 * nt + i16) * 132 + k0);
#pragma unroll
                for (int e = 0; e < 4; ++e) acc[nt] = __builtin_amdgcn_mfma_f32_16x16x4f32(a[e], bq[e], acc[nt], 0, 0, 0); } }
    }
#undef RT_LOAD
    if (kh == 1) {
#pragma unroll
        for (int nt = 0; nt < 3; ++nt) *(LAS f32x4*)(PART + ((tt4 * 3 + nt) * 64 + lane) * 4) = acc[nt]; }
    __syncthreads();
    if (kh == 0) {
#pragma unroll
        for (int nt = 0; nt < 3; ++nt) { const f32x4 p = *(const LAS f32x4*)(PART + ((tt4 * 3 + nt) * 64 + lane) * 4);
#pragma unroll
            for (int i = 0; i < 4; ++i) LG[(16 * tt4 + 4 * g + i) * 48 + 16 * nt + i16] = acc[nt][i] + p[i]; } }
    __syncthreads();
    if (tid < 64) {
        const LAS float* lg = LG + tid * 48; const size_t tok = (size_t)vb * 64 + tid;
        int gs = 0; float gm = lg[0];
#pragma unroll
        for (int i = 1; i < 4; ++i) if (lg[i] > gm) { gm = lg[i]; gs = i; }
        float den = 0.f;
#pragma unroll
        for (int i = 0; i < 4; ++i) den += __expf(lg[i] - gm);
        const float gw = 1.0f / den;
        int i1 = 0; float v1 = lg[4 + gs * 8];
#pragma unroll
        for (int i = 1; i < 8; ++i) { const float v = lg[4 + gs * 8 + i]; if (v > v1) { v1 = v; i1 = i; } }
        int i2 = -1; float v2 = -INFINITY;
#pragma unroll
        for (int i = 0; i < 8; ++i) { const float v = lg[4 + gs * 8 + i]; if (i != i1 && v > v2) { v2 = v; i2 = i; } }
        const float e2 = __expf(v2 - v1); const float w1 = gw / (1.0f + e2), w2 = gw * e2 / (1.0f + e2);
        const unsigned ex1 = gs * 8 + i1, ex2 = gs * 8 + i2;
        RE[tok] = ex1 | (ex2 << 8); RW[tok] = (f32x2){w1, w2};
        __hip_atomic_fetch_add(lcnt + ex1, 1u, __ATOMIC_RELAXED, __HIP_MEMORY_SCOPE_WORKGROUP); __hip_atomic_fetch_add(lcnt + ex2, 1u, __ATOMIC_RELAXED, __HIP_MEMORY_SCOPE_WORKGROUP);
    }
    __syncthreads();
    if (tid < 32) CNT[vb * 32 + tid] = lcnt[tid];
}
__device__ __forceinline__ void moe_scatter_block(const unsigned* RE, const unsigned* CNT, const bf16_t* XN, bf16_t* XS, unsigned* SLOT, int* TILEE, ldsp lds, int vb, int tid) {
    const int lane = tid & 63, w = __builtin_amdgcn_readfirstlane(tid >> 6);
    LAS unsigned* part = (LAS unsigned*)lds; LAS unsigned* tot = (LAS unsigned*)(lds + 4096); LAS unsigned* bef = tot + 32; LAS unsigned* base = tot + 64;
    LAS unsigned* ent = (LAS unsigned*)(lds + 4608); LAS unsigned* slots = (LAS unsigned*)(lds + 5120);
    __syncthreads();
    { const int e = tid & 31, pt = tid >> 5; unsigned st = 0, sb = 0;
        for (int i = 0; i < 16; ++i) { const int v = pt * 16 + i; const unsigned cval = CNT[v * 32 + e]; st += cval; if (v < vb) sb += cval; }
        part[(pt * 32 + e) * 2] = st; part[(pt * 32 + e) * 2 + 1] = sb; }
    if (tid < 128) { const unsigned r = RE[(size_t)vb * 64 + (tid >> 1)]; ent[tid] = (tid & 1) ? ((r >> 8) & 255u) : (r & 255u); }
    __syncthreads();
    if (tid < 32) { unsigned st = 0, sb = 0; for (int p = 0; p < 16; ++p) { st += part[(p * 32 + tid) * 2]; sb += part[(p * 32 + tid) * 2 + 1]; } tot[tid] = st; bef[tid] = sb; }
    __syncthreads();
    if (tid == 0) { unsigned acc = 0; for (int e = 0; e < 32; ++e) { base[e] = acc * 256u; const unsigned nt = (tot[e] + 255u) >> 8;
            if (vb == 0) for (unsigned i = 0; i < nt; ++i) TILEE[acc + i] = e;
            acc += nt; }
        if (vb == 0) TILEE[MOE_TILES] = (int)acc; }
    __syncthreads();
    if (tid < 128) { const unsigned e = ent[tid]; unsigned rank = 0; for (int i = 0; i < tid; ++i) rank += (ent[i] == e) ? 1u : 0u;
        const unsigned s = base[e] + bef[e] + rank; slots[tid] = s; SLOT[(size_t)vb * 128 + tid] = s; }
    __syncthreads();
    for (int t = 0; t < 8; ++t) { const int tl = w * 8 + t; const size_t tok = (size_t)vb * 64 + tl;
        const u32x4* src = (const u32x4*)(XN + tok * D) + lane; const u32x4 a = src[0], bq = src[64];
        const unsigned s0 = slots[2 * tl], s1 = slots[2 * tl + 1];
        u32x4* d0 = (u32x4*)(XS + (size_t)s0 * D) + lane; u32x4* d1 = (u32x4*)(XS + (size_t)s1 * D) + lane;
        d0[0] = a; d0[64] = bq; d1[0] = a; d1[64] = bq; }
}
template <int NT>
__device__ __forceinline__ void moe_combine_tokens(const bf16_t* hin, const bf16_t* YD, const unsigned* SLOT, const f32x2* RW, bf16_t* hout, const bf16_t* ERAW_, float* ERSTD_, int m, int step, int lane) {
    if (m + (NT - 1) * step >= M) return;
    unsigned s0[NT], s1[NT]; f32x2 wv[NT];
#pragma unroll
    for (int t = 0; t < NT; ++t) { const size_t tok = (size_t)(m + t * step); s0[t] = SLOT[tok * 2]; s1[t] = SLOT[tok * 2 + 1]; wv[t] = RW[tok]; }
    f32x4 hv[NT][4]; u32x2 ya[NT][4], yb[NT][4], ye[NT][4];
#pragma unroll
    for (int t = 0; t < NT; ++t) { const size_t tok = (size_t)(m + t * step);
        const u32x2* hr = (const u32x2*)(hin + tok * D) + lane; const u32x2* y0 = (const u32x2*)(YD + (size_t)s0[t] * D) + lane; const u32x2* y1 = (const u32x2*)(YD + (size_t)s1[t] * D) + lane; const u32x2* er = (const u32x2*)(ERAW_ + tok * D) + lane;
#pragma unroll
        for (int j = 0; j < 4; ++j) { const u32x2 q = hr[64 * j]; hv[t][j] = (f32x4){bf_lo(q.x), bf_hi(q.x), bf_lo(q.y), bf_hi(q.y)}; ya[t][j] = y0[64 * j]; yb[t][j] = y1[64 * j]; ye[t][j] = er[64 * j]; } }
#pragma unroll
    for (int t = 0; t < NT; ++t) { const size_t tok = (size_t)(m + t * step);
        u32x2* hb = (u32x2*)(hout + tok * D) + lane; float es = 0.f;
#pragma unroll
        for (int j = 0; j < 4; ++j) { f32x4 v = hv[t][j]; const u32x2 a = ya[t][j], bq = yb[t][j], e2 = ye[t][j];
            v[0] += wv[t][0] * bf_lo(a.x) + wv[t][1] * bf_lo(bq.x); v[1] += wv[t][0] * bf_hi(a.x) + wv[t][1] * bf_hi(bq.x); v[2] += wv[t][0] * bf_lo(a.y) + wv[t][1] * bf_lo(bq.y); v[3] += wv[t][0] * bf_hi(a.y) + wv[t][1] * bf_hi(bq.y);
            u32x2 o; o.x = cvt_pk_bf16(v[0], v[1]); o.y = cvt_pk_bf16(v[2], v[3]); hb[64 * j] = o;
            es += (bf_lo(e2.x) * bf_lo(e2.x) + bf_hi(e2.x) * bf_hi(e2.x)) + (bf_lo(e2.y) * bf_lo(e2.y) + bf_hi(e2.y) * bf_hi(e2.y)); }
        es = wave_sum(es);
        if (lane == 0) ERSTD_[tok] = 1.0f / sqrtf(es * (1.0f / D) + RMS_EPS); }
}
__device__ __forceinline__ float ret_log2g(int h) { const float x = __builtin_ldexpf(1.0f, -5 - h); const float ln = -(x + x * x * 0.5f + x * x * x * (1.0f / 3.0f) + x * x * x * x * 0.25f + x * x * x * x * x * 0.2f + x * x * x * x * x * x * (1.0f / 6.0f)); return ln * LOG2E; }
__device__ __forceinline__ void ret_kv_unit(const bf16_t* Z1, float* SKV, ldsp lds, int b, int h, int sc, int tid) {
    const int lane = tid & 63, w = __builtin_amdgcn_readfirstlane(tid >> 6), i16 = lane & 15, g = lane >> 4;
    LAS bf16_t* Vs = (LAS bf16_t*)lds; LAS bf16_t* Ks = (LAS bf16_t*)(lds + 33792);
    const float l2g = ret_log2g(h);
    f32x4 acc[2][8];
#pragma unroll
    for (int mt = 0; mt < 2; ++mt)
#pragma unroll
        for (int nt = 0; nt < 8; ++nt) acc[mt][nt] = (f32x4){0.f, 0.f, 0.f, 0.f};
    const size_t tok0 = (size_t)b * SEQ + (size_t)sc * 256;
    u32x4 vr[4], kr[2];
#define KV_LOAD(jb_) do { _Pragma("unroll") for (int q = 0; q < 4; ++q) { const int idx = tid + 512 * q, row = idx >> 5, chn = idx & 31; vr[q] = *(const u32x4*)(Z1 + (tok0 + (jb_) * 64 + row) * OD_IN + 2048 + h * 256 + chn * 8); } \
        _Pragma("unroll") for (int q = 0; q < 2; ++q) { const int idx = tid + 512 * q, row = idx >> 4, chn = idx & 15; kr[q] = *(const u32x4*)(Z1 + (tok0 + (jb_) * 64 + row) * OD_IN + 1024 + h * 128 + chn * 8); } } while (0)
    KV_LOAD(0);
    for (int jb = 0; jb < 4; ++jb) {
        __syncthreads();
#pragma unroll
        for (int q = 0; q < 4; ++q) { const int idx = tid + 512 * q, row = idx >> 5, chn = idx & 31; *(LAS u32x4*)(Vs + row * 264 + chn * 8) = vr[q]; }
#pragma unroll
        for (int q = 0; q < 2; ++q) { const int idx = tid + 512 * q, row = idx >> 4, chn = idx & 15;
            const u32x4 kw = kr[q];
            const float dk = __builtin_amdgcn_exp2f(l2g * (float)(255 - (jb * 64 + row)));
            u32x4 o; o.x = cvt_pk_bf16(bf_lo(kw.x) * dk, bf_hi(kw.x) * dk); o.y = cvt_pk_bf16(bf_lo(kw.y) * dk, bf_hi(kw.y) * dk); o.z = cvt_pk_bf16(bf_lo(kw.z) * dk, bf_hi(kw.z) * dk); o.w = cvt_pk_bf16(bf_lo(kw.w) * dk, bf_hi(kw.w) * dk);
            *(LAS u32x4*)(Ks + row * 136 + chn * 8) = o; }
        __syncthreads();
        if (jb + 1 < 4) KV_LOAD(jb + 1);
#pragma unroll
        for (int kk = 0; kk < 2; ++kk) {
            bf16x8 af[2];
#pragma unroll
            for (int mt = 0; mt < 2; ++mt) af[mt] = frag_tr(Vs, 264, 32 * kk, 32 * w + 16 * mt, lane);
#pragma unroll
            for (int nt = 0; nt < 8; ++nt) { const bf16x8 bfr = frag_tr(Ks, 136, 32 * kk, 16 * nt, lane);
#pragma unroll
                for (int mt = 0; mt < 2; ++mt) acc[mt][nt] = MFMA16(af[mt], bfr, acc[mt][nt]); }
        }
    }
#undef KV_LOAD
    float* out = SKV + ((size_t)((b * 8 + h) * 16 + sc)) * 32768;
#pragma unroll
    for (int mt = 0; mt < 2; ++mt)
#pragma unroll
        for (int nt = 0; nt < 8; ++nt)
#pragma unroll
            for (int i = 0; i < 4; ++i) out[(size_t)(32 * w + 16 * mt + 4 * g + i) * 128 + 16 * nt + i16] = acc[mt][nt][i];
}
__device__ __forceinline__ void ret_out_unit(const bf16_t* Z1, const bf16_t* SST, const float* gn_g, bf16_t* Y, ldsp lds, int b, int h, int sc, int tid, int dbg) {
    const int w = __builtin_amdgcn_readfirstlane(tid >> 6);
    const float l2g = ret_log2g(h);
    const size_t tok0 = (size_t)b * SEQ + (size_t)sc * 256;
    LAS bf16_t* RA = (LAS bf16_t*)lds; LAS bf16_t* RB = (LAS bf16_t*)(lds + 69632);
    const int tq0 = w, tq1 = 15 - w;
#define FRESH_LANE() int ln_ = tid & 63; asm volatile("" : "+v"(ln_)); const int i16 = ln_ & 15, g = ln_ >> 4; (void)i16; (void)g
#define RET_LOAD(jb_) do { unsigned t_ = (unsigned)tid; asm volatile("" : "+v"(t_)); \
        const char* vb_ = (const char*)(Z1 + (tok0 + (jb_) * 64) * OD_IN + 2048 + h * 256); const char* kb_ = (const char*)(Z1 + (tok0 + (jb_) * 64) * OD_IN + 1024 + h * 128); \
        _Pragma("unroll") for (int q = 0; q < 4; ++q) { const unsigned idx = t_ + 512u * q, row = idx >> 5, chn = idx & 31u; vr[q] = *(const u32x4*)(vb_ + (size_t)((row * OD_IN + chn * 8u) * 2u)); } \
        _Pragma("unroll") for (int q = 0; q < 2; ++q) { const unsigned idx = t_ + 512u * q, row = idx >> 4, chn = idx & 15u; kr[q] = *(const u32x4*)(kb_ + (size_t)((row * OD_IN + chn * 8u) * 2u)); } } while (0)
#define RET_STORE() do { unsigned t_ = (unsigned)tid; asm volatile("" : "+v"(t_)); \
        _Pragma("unroll") for (int q = 0; q < 4; ++q) { const unsigned idx = t_ + 512u * q, row = idx >> 5, chn = idx & 31u; *(LAS u32x4*)(RA + row * 264 + chn * 8) = vr[q]; } \
        _Pragma("unroll") for (int q = 0; q < 2; ++q) { const unsigned idx = t_ + 512u * q, row = idx >> 4, chn = idx & 15u; *(LAS u32x4*)(RA + 16896 + row * 136 + chn * 8) = kr[q]; } } while (0)
    __syncthreads();
    {
        const char* S = (const char*)(SST + ((size_t)((b * 8 + h) * 16 + sc)) * 32768); const char* Q = (const char*)(Z1 + tok0 * OD_IN + h * 128);
        unsigned t_ = (unsigned)tid; asm volatile("" : "+v"(t_));
        u32x4 sr[8], qr[8];
#pragma unroll
        for (int q = 0; q < 8; ++q) { const unsigned idx = t_ + 512u * q, row = idx >> 4, chn = idx & 15u; sr[q] = *(const u32x4*)(S + (size_t)(idx * 16u)); qr[q] = *(const u32x4*)(Q + (size_t)((row * OD_IN + chn * 8u) * 2u)); }
#pragma unroll
        for (int q = 0; q < 8; ++q) { const unsigned idx = t_ + 512u * q, row = idx >> 4, chn = idx & 15u; *(LAS u32x4*)(RA + row * 136 + chn * 8) = sr[q]; *(LAS u32x4*)(RB + row * 136 + chn * 8) = qr[q]; }
    }
    u32x4 vr[4], kr[2];
    RET_LOAD(0);
    __syncthreads();
    f32x4 o[2][16];
    {
        FRESH_LANE();
        bf16x8 qf[2][4];
#pragma unroll
        for (int ks = 0; ks < 4; ++ks) { qf[0][ks] = *(const LAS bf16x8*)(RB + (16 * tq0 + i16) * 136 + 32 * ks + 8 * g); qf[1][ks] = *(const LAS bf16x8*)(RB + (16 * tq1 + i16) * 136 + 32 * ks + 8 * g); }
#pragma unroll
        for (int et = 0; et < 16; ++et) {
            if ((et & 1) == 0) asm volatile("" ::: "memory");
#pragma unroll
            for (int ks = 0; ks < 4; ++ks) { const bf16x8 a = *(const LAS bf16x8*)(RA + (16 * et + i16) * 136 + 32 * ks + 8 * g);
                if (ks == 0) { o[0][et] = MFMA16(a, qf[0][0], ((f32x4){0.f, 0.f, 0.f, 0.f})); o[1][et] = MFMA16(a, qf[1][0], ((f32x4){0.f, 0.f, 0.f, 0.f})); }
                else { o[0][et] = MFMA16(a, qf[0][ks], o[0][et]); o[1][et] = MFMA16(a, qf[1][ks], o[1][et]); } } }
        const float dq0 = __builtin_amdgcn_exp2f(l2g * (float)(16 * tq0 + i16 + 1)), dq1 = __builtin_amdgcn_exp2f(l2g * (float)(16 * tq1 + i16 + 1));
#pragma unroll
        for (int et = 0; et < 16; ++et) { o[0][et] = o[0][et] * dq0; o[1][et] = o[1][et] * dq1; }
    }
    __syncthreads();
    RET_STORE(); RET_LOAD(1);
    __syncthreads();
#pragma unroll 1
    for (int jb = 0; jb < 4; ++jb) {
        {
            FRESH_LANE();
            const LAS bf16_t* Vs = RA; const LAS bf16_t* Ks = RA + 16896;
            bf16x8 pb[2][2];
#pragma unroll
            for (int nt = 0; nt < 2; ++nt) { const int tq = nt ? tq1 : tq0; pb[nt][0] = (bf16x8){0, 0, 0, 0, 0, 0, 0, 0}; pb[nt][1] = pb[nt][0];
                if (jb <= (tq >> 2)) {
                    const int ipos = 16 * tq + i16;
                    bf16x8 qf1[4];
#pragma unroll
                    for (int ks = 0; ks < 4; ++ks) qf1[ks] = *(const LAS bf16x8*)(RB + ipos * 136 + 32 * ks + 8 * g);
                    f32x4 s[4];
#pragma unroll
                    for (int kt = 0; kt < 4; ++kt) { f32x4 a4 = (f32x4){0.f, 0.f, 0.f, 0.f};
#pragma unroll
                        for (int ks = 0; ks < 4; ++ks) { const bf16x8 a = *(const LAS bf16x8*)(Ks + (kt * 16 + i16) * 136 + 32 * ks + 8 * g); a4 = MFMA16(a, qf1[ks], a4); }
#pragma unroll
                        for (int i = 0; i < 4; ++i) { const int j = jb * 64 + kt * 16 + 4 * g + i; const int df = ipos - j; a4[i] = (df >= 0) ? a4[i] * __builtin_amdgcn_exp2f(l2g * (float)df) : 0.f; }
                        s[kt] = a4; }
                    pb[nt][0] = pack_frag(s[0], s[1]); pb[nt][1] = pack_frag(s[2], s[3]); } }
            asm volatile("" ::: "memory");
#pragma unroll
            for (int et = 0; et < 16; ++et)
#pragma unroll
                for (int kk = 0; kk < 2; ++kk) { const bf16x8 vf = frag_tr(Vs, 264, 32 * kk, 16 * et, ln_); o[0][et] = MFMA16(vf, pb[0][kk], o[0][et]); o[1][et] = MFMA16(vf, pb[1][kk], o[1][et]); }
        }
        __syncthreads();
        if (jb + 1 < 4) { RET_STORE(); if (jb + 2 < 4) RET_LOAD(jb + 2); __syncthreads(); }
    }
#undef RET_LOAD
#undef RET_STORE
    {
        LAS bf16_t* T = (LAS bf16_t*)(lds + w * 16896);
#pragma unroll
        for (int nt = 0; nt < 2; ++nt) {
            FRESH_LANE();
            float sm = 0.f;
#pragma unroll
            for (int et = 0; et < 16; ++et) sm += (o[nt][et][0] + o[nt][et][1]) + (o[nt][et][2] + o[nt][et][3]);
            sm += __shfl_xor(sm, 16); sm += __shfl_xor(sm, 32);
            const float mean = sm * (1.0f / 256.0f); float vq = 0.f;
#pragma unroll
            for (int et = 0; et < 16; ++et) { const f32x4 dd = o[nt][et] - mean; vq += (dd[0] * dd[0] + dd[1] * dd[1]) + (dd[2] * dd[2] + dd[3] * dd[3]); }
            vq += __shfl_xor(vq, 16); vq += __shfl_xor(vq, 32);
            const float rstd = 1.0f / sqrtf(vq * (1.0f / 256.0f) + GN_EPS);
#pragma unroll
            for (int et = 0; et < 16; ++et) { u32x2 pv; pv.x = cvt_pk_bf16((o[nt][et][0] - mean) * rstd, (o[nt][et][1] - mean) * rstd); pv.y = cvt_pk_bf16((o[nt][et][2] - mean) * rstd, (o[nt][et][3] - mean) * rstd);
                *(LAS u32x2*)(T + (16 * nt + i16) * 264 + 16 * et + 4 * g) = pv; }
        }
        asm volatile("s_waitcnt lgkmcnt(0)" ::: "memory");
        {
            FRESH_LANE();
            const int ch = ln_ & 31, rh = ln_ >> 5;
            const f32x4 ga = *(const f32x4*)(gn_g + h * 256 + 8 * ch), gb = *(const f32x4*)(gn_g + h * 256 + 8 * ch + 4);
#pragma unroll 4
            for (int r = 0; r < 16; ++r) { const int q = 2 * r + rh; const int tq = (q < 16) ? tq0 : tq1; const size_t tok = tok0 + 16 * tq + (q & 15);
                const u32x4 nv = *(const LAS u32x4*)(T + q * 264 + 8 * ch); const u32x4 gv = *(const u32x4*)(Z1 + tok * OD_IN + 4096 + h * 256 + 8 * ch);
                u32x4 ov;
                ov.x = cvt_pk_bf16(bf_lo(nv.x) * ga[0] * siluf_(bf_lo(gv.x)), bf_hi(nv.x) * ga[1] * siluf_(bf_hi(gv.x))); ov.y = cvt_pk_bf16(bf_lo(nv.y) * ga[2] * siluf_(bf_lo(gv.y)), bf_hi(nv.y) * ga[3] * siluf_(bf_hi(gv.y)));
                ov.z = cvt_pk_bf16(bf_lo(nv.z) * gb[0] * siluf_(bf_lo(gv.z)), bf_hi(nv.z) * gb[1] * siluf_(bf_hi(gv.z))); ov.w = cvt_pk_bf16(bf_lo(nv.w) * gb[2] * siluf_(bf_lo(gv.w)), bf_hi(nv.w) * gb[3] * siluf_(bf_hi(gv.w)));
                *(u32x4*)(Y + tok * 2048 + h * 256 + 8 * ch) = ov; }
        }
    }
#undef FRESH_LANE
}
enum InIdx { I_X = 0, I_P, I_RELB, I_MIXG, I_FFNG, I_PLEG, I_EVWIN, I_CONVW, I_CONVB, I_WA, I_BA, I_WX, I_BX, I_LAM, I_QG, I_KG, I_EVWOUT, I_ODWIN, I_GNG, I_ODWOUT,
             I_WGROUP, I_WEXPERT, I_WGATE, I_WUP, I_WDOWN, I_PLEUP, I_PLEGATE, N_IN };
struct Args { const float* in[N_IN]; float* out; unsigned char* ws; int ph_lo, ph_hi, flags, pad; };
static_assert(sizeof(Args) == N_IN * 8 + 8 + 8 + 16, "Args has no padding");
constexpr int N_PHASES = 24;

__global__ void __launch_bounds__(512, 2) mk_fwd(Args args) {
    extern __shared__ __attribute__((aligned(16))) unsigned char lds_raw[];
    const ldsp lds = (ldsp)lds_raw;
    volatile LAS unsigned* MISC = (volatile LAS unsigned*)(lds + LDS_MISC_OFF);
    const int tid = threadIdx.x, lane = tid & 63, wave = __builtin_amdgcn_readfirstlane(tid >> 6);
    const int G = gridDim.x, bid = blockIdx.x;
    const int gw = bid * 8 + wave, ngw = G * 8;
    unsigned char* ws0 = args.ws;
#define FRESH_WS() size_t wsz_ = 0; asm volatile("" : "+s"(wsz_)); unsigned char* ws = ws0 + wsz_
    for (int u = tid; u < 64; u += 512) MISC[u] = 0u;
    __syncthreads();
#if MK_N_LAUNCHES == 1
    XcdBarrier bar = xcd_barrier_post((unsigned*)(ws0 + WS_CTL) + CW_BAR, MISC + 8);
#define GRID_BAR() xcd_barrier(bar)
#else
#define GRID_BAR() do { } while (0)
#endif
    const int lo = args.ph_lo, hi = args.ph_hi;
#ifndef ONLY_PHASE
#define ONLY_PHASE (-1)
#endif
#define IN(k) ((ONLY_PHASE < 0 || ONLY_PHASE == (k)) && lo <= (k) && (k) < hi)
#define SEAM(k) do { if (IN(k) && IN((k) + 1)) GRID_BAR(); } while (0)

    const float* x = args.in[I_X];
#define H_A ((bf16_t*)(ws + WS_HA))
#define H_B ((bf16_t*)(ws + WS_HB))
#define XN ((bf16_t*)(ws + WS_XN))
#define PB ((bf16_t*)(ws + WS_PB))
#define ERAW ((bf16_t*)(ws + WS_ERAW))
#define ESS ((float*)(ws + MS_ESS))
#define ERSTD ((float*)(ws + MS_ERSTD))
#define Z ((bf16_t*)(ws + WS_Z))
#define Y ((bf16_t*)(ws + WS_Y))
#define ROPE ((float*)(ws + WS_ROPE))
#define RT ((float*)(ws + WS_RT))
#define W_GU ((bf16_t*)(ws + WS_W_GU))
#define W_DN ((bf16_t*)(ws + WS_W_DN))
    LAS float* scr = (LAS float*)(lds + wave * 16640);

    if (IN(0)) { FRESH_WS();
        tr_matrix<0>(args.in[I_EVWIN], nullptr, D, EV_IN, (bf16_t*)(ws + WS_W_EVIN), EV_INP, scr, lane, gw, ngw);
        tr_matrix<0>(args.in[I_EVWOUT], nullptr, D, D, (bf16_t*)(ws + WS_W_EVOUT), D, scr, lane, gw, ngw);
        tr_matrix<1>(args.in[I_ODWIN], nullptr, D, OD_IN, (bf16_t*)(ws + WS_W_ODIN), OD_IN, scr, lane, gw, ngw);
        tr_matrix<0>(args.in[I_ODWOUT], nullptr, 2048, D, (bf16_t*)(ws + WS_W_ODOUT), D, scr, lane, gw, ngw);
        for (int l = 0; l < 2; ++l) {
            tr_matrix<0>(args.in[I_PLEUP] + (size_t)l * PLE * D, nullptr, PLE, D, (bf16_t*)(ws + WS_W_PLEUP) + (size_t)l * D * PLE, D, scr, lane, gw, ngw);
            tr_matrix<0>(args.in[I_PLEGATE] + (size_t)l * D * D, nullptr, D, D, (bf16_t*)(ws + WS_W_PLEGATE) + (size_t)l * D * D, D, scr, lane, gw, ngw); }
        convert_moe_layer(args.in[I_WGATE], args.in[I_WUP], args.in[I_WDOWN], W_GU, W_DN, scr, lane, gw, ngw);
        for (int m = gw; m < M; m += 4 * ngw) rms_rows_to_bf16<4, true>(x, args.in[I_MIXG], XN, m, ngw, lane);
        { const float* p = args.in[I_P]; const size_t n4 = (size_t)2 * M * PLE / 4;
          const size_t stride = (size_t)G * 512;
          for (size_t i = (size_t)bid * 512 + tid; i < n4; i += 4 * stride) { f32x4 v[4];
#pragma unroll
              for (int q = 0; q < 4; ++q) if (i + q * stride < n4) v[q] = ((const f32x4*)p)[i + q * stride];
#pragma unroll
              for (int q = 0; q < 4; ++q) if (i + q * stride < n4) { u32x2 o; o.x = cvt_pk_bf16(v[q][0], v[q][1]); o.y = cvt_pk_bf16(v[q][2], v[q][3]); ((u32x2*)PB)[i + q * stride] = o; } } }
        for (int i = bid * 512 + tid; i < SEQ * 64; i += G * 512) { const int pos = i >> 6, f = i & 63;
            const float inv = powf(10000.0f, -(float)f / 64.0f); const float ang = (float)pos * inv; ROPE[i] = cosf(ang); ROPE[SEQ * 64 + i] = sinf(ang); }
        for (int i = bid * 512 + tid; i < 2 * 8 * 4096; i += G * 512) { const int mat = i >> 15, r = i & 32767, blk = r >> 12, j = (r >> 6) & 63, ii = r & 63;
            const float v = (mat ? args.in[I_WX] : args.in[I_WA])[(size_t)blk * 4096 + ii * 64 + j]; ((bf16_t*)(ws + WS_WGT))[i] = (bf16_t)(cvt_pk_bf16(v, 0.f) & 0xffffu); }
        for (int i = bid * 512 + tid; i < 2 * 36 * D; i += G * 512) { const int l = i / (36 * D), r = i % (36 * D), o = r / D, k = r % D;
            RT[i] = (o < 4) ? args.in[I_WGROUP][(size_t)l * D * 4 + k * 4 + o] : args.in[I_WEXPERT][(size_t)l * D * 32 + k * 32 + (o - 4)]; }
    }
    SEAM(0);
    if (IN(1)) { FRESH_WS();
        { pg8::Gemm gm{XN, (const bf16_t*)(ws + WS_W_EVIN), M, EV_INP, D}; pg8::StaticOrder S; S.init(M, EV_INP, G, bid); EpiPlainBf16<EV_INP, 13> E{Z};
          pg8::gemm_phase<EpiPlainBf16<EV_INP, 13>, pg8::StaticOrder>(lds, gm, S, E, nullptr); }
        __syncthreads();
        { pg8::Gemm gm{PB, (const bf16_t*)(ws + WS_W_PLEUP), M, D, PLE}; pg8::StaticOrder S; S.init(M, D, G, bid); EpiPlainBf16<D, 4> E{ERAW};
          pg8::gemm_phase<EpiPlainBf16<D, 4>, pg8::StaticOrder>(lds, gm, S, E, nullptr); }
    }
    SEAM(1);
    if (IN(2)) { FRESH_WS();
        for (int u = bid; u < 256; u += G)
            lru_local_unit(Z, args.in[I_CONVW], args.in[I_CONVB], (const bf16_t*)(ws + WS_WGT), args.in[I_BA], args.in[I_BX], args.in[I_LAM],
                           (float*)(ws + WS_HLOC), (float*)(ws + WS_PCUM), (float*)(ws + MS_SUMA), (float*)(ws + MS_SUMH), lds, u >> 6, u & 63, tid);
        if (!(args.flags & 1)) for (int m = gw; m < M; m += 4 * ngw) dsa_prep_tokens<4>(Z, args.in[I_QG], args.in[I_KG], m, ngw, lane);
    }
    __syncthreads();
    if (IN(3)) { FRESH_WS();
        for (int idx = bid; idx < 1024; idx += G) { const int r = idx >> 8, v = idx & 255; const int qt = (r & 1) ? 255 - v : v;
            dsa_select_unit(Z, (unsigned*)(ws + ((args.flags & 1) ? WS_Y + 32 * MiB : WS_MASK)), ws + WS_Y + 32 * MiB, lds, r, qt, tid, args.flags); }
    }
    SEAM(3);
    if (IN(4)) { FRESH_WS();
        for (int idx = bid; idx < 512; idx += G) { const int r = idx >> 8, v = idx & 255; const int bh = v >> 3; const int qt = r ? 15 - (v & 7) : (v & 7);
            dsa_attn_unit(Z, (const unsigned*)(ws + WS_MASK), args.in[I_RELB], Y, lds, bh >> 3, bh & 7, qt, tid); }
        __syncthreads();
        for (int u = bid; u < 256; u += G)
            lru_fix_unit(Z, (const float*)(ws + WS_HLOC), (const float*)(ws + WS_PCUM), (const float*)(ws + MS_SUMA), (const float*)(ws + MS_SUMH), Y, u >> 6, u & 63, tid);
    }
    SEAM(4);
    if (IN(5)) { FRESH_WS();
        __syncthreads();
        pg8::Gemm gm{Y, (const bf16_t*)(ws + WS_W_EVOUT), M, D, D}; pg8::StaticOrder S; S.init(M, D, G, bid); EpiResid<true> E{x, H_A};
        pg8::gemm_phase<EpiResid<true>, pg8::StaticOrder>(lds, gm, S, E, nullptr);
    }
    SEAM(5);
    if (IN(6 + 0)) { FRESH_WS();
        __syncthreads();
        if (false) convert_moe_layer(args.in[I_WGATE] + (size_t)NEXP * D * FF, args.in[I_WUP] + (size_t)NEXP * D * FF, args.in[I_WDOWN] + (size_t)NEXP * FF * D, W_GU, W_DN, scr, lane, gw, ngw);
        for (int vb = bid; vb < 256; vb += G)
            moe_route_block(H_A, args.in[I_FFNG] + 0 * D, RT + (size_t)0 * 36 * D, XN, (unsigned*)(ws + MS_RE), (f32x2*)(ws + MS_RW), (unsigned*)(ws + MS_CNT), lds, vb, tid);
    }
    SEAM(6 + 0);
    if (IN(6 + 1)) { FRESH_WS(); for (int vb = bid; vb < 256; vb += G) moe_scatter_block((const unsigned*)(ws + MS_RE), (const unsigned*)(ws + MS_CNT), XN, (bf16_t*)(ws + WS_XS), (unsigned*)(ws + MS_SLOT), (int*)(ws + MS_TILEE), lds, vb, tid); }
    SEAM(6 + 1);
    if (IN(6 + 2)) { FRESH_WS();
        __syncthreads();
        pg8::Gemm gm{(const bf16_t*)(ws + WS_XS), W_GU, MOE_ROWS, NEXP * 1024, D}; MoeOrder S; S.init((const int*)(ws + MS_TILEE), G, bid); EpiSwiglu E{Y};
        pg8::gemm_phase<EpiSwiglu, MoeOrder>(lds, gm, S, E, nullptr);
    }
    SEAM(6 + 2);
    if (IN(6 + 3)) { FRESH_WS();
        __syncthreads();
        pg8::Gemm gm{Y, W_DN, MOE_ROWS, NEXP * 1024, FF}; MoeOrder S; S.init((const int*)(ws + MS_TILEE), G, bid); EpiPlainBf16<D, 4> E{(bf16_t*)(ws + WS_YD)};
        pg8::gemm_phase<EpiPlainBf16<D, 4>, MoeOrder>(lds, gm, S, E, nullptr);
    }
    SEAM(6 + 3);
    if (IN(6 + 4)) { FRESH_WS(); for (int m = gw; m < M; m += 2 * ngw) moe_combine_tokens<2>(H_A, (const bf16_t*)(ws + WS_YD), (const unsigned*)(ws + MS_SLOT), (const f32x2*)(ws + MS_RW), H_B, ERAW, ERSTD, m, ngw, lane); }
    SEAM(6 + 4);
    if (IN(6 + 5)) { FRESH_WS();
        __syncthreads();
        pg8::Gemm gm{H_B, (const bf16_t*)(ws + WS_W_PLEGATE) + (size_t)0 * D * D, M, D, D}; pg8::StaticOrder S; S.init(M, D, G, bid); EpiPleGate<false> E{H_B, H_A, ERAW, ERSTD, args.in[I_PLEG] + 0 * D};
        pg8::gemm_phase<EpiPleGate<false>, pg8::StaticOrder>(lds, gm, S, E, nullptr);
    }
    SEAM(11);
        if (IN(12)) { FRESH_WS(); for (int m = gw; m < M; m += 4 * ngw) rms_rows_to_bf16<4, false>(H_A, args.in[I_MIXG] + D, XN, m, ngw, lane); }
        SEAM(12);
        if (IN(13)) { FRESH_WS();
            __syncthreads();
            { pg8::Gemm gm{XN, (const bf16_t*)(ws + WS_W_ODIN), M, OD_IN, D}; pg8::StaticOrder S; S.init(M, OD_IN, G, bid); EpiRet E{Z, ROPE};
              pg8::gemm_phase<EpiRet, pg8::StaticOrder>(lds, gm, S, E, nullptr); }
            __syncthreads();
            { pg8::Gemm gm{PB + (size_t)M * PLE, (const bf16_t*)(ws + WS_W_PLEUP) + (size_t)D * PLE, M, D, PLE}; pg8::StaticOrder S; S.init(M, D, G, bid); EpiPlainBf16<D, 4> E{ERAW};
              pg8::gemm_phase<EpiPlainBf16<D, 4>, pg8::StaticOrder>(lds, gm, S, E, nullptr); }
        }
        SEAM(13);
        if (IN(14)) { FRESH_WS(); for (int u = bid; u < 512; u += G) ret_kv_unit(Z, (float*)(ws + WS_W_GU), lds, u >> 7, (u >> 4) & 7, u & 15, tid); }
        SEAM(14);
        if (IN(15)) { FRESH_WS();
            const float* SKV = (const float*)(ws + WS_W_GU); bf16_t* SST = (bf16_t*)(ws + WS_W_DN);
            for (int i = bid * 512 + tid; i < 32 * 32768; i += G * 512) { const int bh = i >> 15, el = i & 32767; const float g256 = exp2f(ret_log2g(bh & 7) * 256.0f); float run = 0.f;
                float v[16];
#pragma unroll
                for (int sc = 0; sc < 16; ++sc) v[sc] = SKV[((size_t)(bh * 16 + sc)) * 32768 + el];
#pragma unroll
                for (int sc = 0; sc < 16; ++sc) { SST[((size_t)(bh * 16 + sc)) * 32768 + el] = (bf16_t)(cvt_pk_bf16(run, 0.f) & 0xffffu); run = run * g256 + v[sc]; } }
        }
        SEAM(15);
        if (IN(16)) { FRESH_WS();
            for (int u = bid; u < 512; u += G) ret_out_unit(Z, (const bf16_t*)(ws + WS_W_DN), args.in[I_GNG], (args.flags & 1) ? (bf16_t*)(ws + WS_W_GU) : Y, lds, u >> 7, (u >> 4) & 7, u & 15, tid, args.flags);
            __syncthreads();
        }
        SEAM(16);
        if (IN(17)) { FRESH_WS();
            __syncthreads();
            pg8::Gemm gm{Y, (const bf16_t*)(ws + WS_W_ODOUT), M, D, 2048}; pg8::StaticOrder S; S.init(M, D, G, bid); EpiResid<false> E{H_A, H_B};
            pg8::gemm_phase<EpiResid<false>, pg8::StaticOrder>(lds, gm, S, E, nullptr);
        }
        SEAM(17);
    if (IN(18 + 0)) { FRESH_WS();
        __syncthreads();
        convert_moe_layer(args.in[I_WGATE] + (size_t)NEXP * D * FF, args.in[I_WUP] + (size_t)NEXP * D * FF, args.in[I_WDOWN] + (size_t)NEXP * FF * D, W_GU, W_DN, scr, lane, gw, ngw);
        for (int vb = bid; vb < 256; vb += G)
            moe_route_block(H_B, args.in[I_FFNG] + 1 * D, RT + (size_t)1 * 36 * D, XN, (unsigned*)(ws + MS_RE), (f32x2*)(ws + MS_RW), (unsigned*)(ws + MS_CNT), lds, vb, tid);
    }
    SEAM(18 + 0);
    if (IN(18 + 1)) { FRESH_WS(); for (int vb = bid; vb < 256; vb += G) moe_scatter_block((const unsigned*)(ws + MS_RE), (const unsigned*)(ws + MS_CNT), XN, (bf16_t*)(ws + WS_XS), (unsigned*)(ws + MS_SLOT), (int*)(ws + MS_TILEE), lds, vb, tid); }
    SEAM(18 + 1);
    if (IN(18 + 2)) { FRESH_WS();
        __syncthreads();
        pg8::Gemm gm{(const bf16_t*)(ws + WS_XS), W_GU, MOE_ROWS, NEXP * 1024, D}; MoeOrder S; S.init((const int*)(ws + MS_TILEE), G, bid); EpiSwiglu E{Y};
        pg8::gemm_phase<EpiSwiglu, MoeOrder>(lds, gm, S, E, nullptr);
    }
    SEAM(18 + 2);
    if (IN(18 + 3)) { FRESH_WS();
        __syncthreads();
        pg8::Gemm gm{Y, W_DN, MOE_ROWS, NEXP * 1024, FF}; MoeOrder S; S.init((const int*)(ws + MS_TILEE), G, bid); EpiPlainBf16<D, 4> E{(bf16_t*)(ws + WS_YD)};
        pg8::gemm_phase<EpiPlainBf16<D, 4>, MoeOrder>(lds, gm, S, E, nullptr);
    }
    SEAM(18 + 3);
    if (IN(18 + 4)) { FRESH_WS(); for (int m = gw; m < M; m += 2 * ngw) moe_combine_tokens<2>(H_B, (const bf16_t*)(ws + WS_YD), (const unsigned*)(ws + MS_SLOT), (const f32x2*)(ws + MS_RW), H_A, ERAW, ERSTD, m, ngw, lane); }
    SEAM(18 + 4);
    if (IN(18 + 5)) { FRESH_WS();
        __syncthreads();
        pg8::Gemm gm{H_A, (const bf16_t*)(ws + WS_W_PLEGATE) + (size_t)1 * D * D, M, D, D}; pg8::StaticOrder S; S.init(M, D, G, bid); EpiPleGate<true> E{H_A, args.out, ERAW, ERSTD, args.in[I_PLEG] + 1 * D};
        pg8::gemm_phase<EpiPleGate<true>, pg8::StaticOrder>(lds, gm, S, E, nullptr);
    }
}

extern "C" void kernel_launch(void* const* d_in, const int* in_sizes, int n_in, void* d_out, int out_size, void* d_ws, size_t ws_size, hipStream_t stream) {
    static int grid = 0;
    if (grid == 0) {
        if (n_in != N_IN || out_size != M * D || ws_size < WS_END) { fprintf(stderr, "kernel_launch: unexpected problem (n_in %d, out %d, ws %zu)\n", n_in, out_size, ws_size); grid = -1; return; }
        int dev = 0, cus = 0, per_cu = 0;
        if (hipGetDevice(&dev) != hipSuccess || hipDeviceGetAttribute(&cus, hipDeviceAttributeMultiprocessorCount, dev) != hipSuccess) { grid = -1; return; }
        if (hipFuncSetAttribute((const void*)mk_fwd, hipFuncAttributeMaxDynamicSharedMemorySize, LDS_BYTES) != hipSuccess) { fprintf(stderr, "kernel_launch: hipFuncSetAttribute failed\n"); grid = -1; return; }
        if (hipOccupancyMaxActiveBlocksPerMultiprocessor(&per_cu, (const void*)mk_fwd, 512, LDS_BYTES) != hipSuccess || per_cu < 1) fprintf(stderr, "kernel_launch: occupancy query reports %d\n", per_cu);
        (void)hipGetLastError();
        grid = cus;
    }
    if (grid < 0) return;
    (void)hipMemsetAsync((char*)d_ws + WS_CTL, 0, CTL_ZERO_BYTES, stream);
    Args a{};
    for (int i = 0; i < N_IN; ++i) a.in[i] = (const float*)d_in[i];
    a.out = (float*)d_out; a.ws = (unsigned char*)d_ws;
#if MK_N_LAUNCHES == 1
    a.ph_lo = 0; a.ph_hi = N_PHASES;
    hipLaunchKernelGGL(mk_fwd, dim3(grid), dim3(512), LDS_BYTES, stream, a);
#else
    for (int p = 0; p < N_PHASES; ++p) { a.ph_lo = p; a.ph_hi = p + 1; a.flags = 0; hipLaunchKernelGGL(mk_fwd, dim3(grid), dim3(512), LDS_BYTES, stream, a);
#if defined(PROBE_PHASE)
#ifndef PROBE_FLAGS
#define PROBE_FLAGS 0
#endif
        if (p == PROBE_PHASE) { a.flags = 1 | PROBE_FLAGS; for (int r = 0; r < PROBE_REPS; ++r) hipLaunchKernelGGL(mk_fwd, dim3(grid), dim3(512), LDS_BYTES, stream, a); }
#endif
    }
#endif
}
```
